# Optimizing an MI355X kernel written in HIP

```python
import jax, jax.numpy as jnp
from jax import lax
import numpy as np

D_MODEL = 1024
BATCH = 16
SEQ = 4096
DEPTH = 2
DEC_BATCH = 32
DEC_SEQ = 64
PAST_LEN = 1024

CHUNK = 64
N_A = DEPTH // 2
N_B = DEPTH - N_A
RET_HEADS = 4
RET_DK = D_MODEL // RET_HEADS
RET_DV = 2 * RET_DK
RET_V = RET_HEADS * RET_DV
FOX_HEADS = 16
FOX_DH = D_MODEL // FOX_HEADS
FOX_W = FOX_HEADS * FOX_DH
D_FF = 2816
Q_BLOCK = 128
ROPE_BASE = 10000.0
EPS = 1e-6

kernel_name = "yoco_retention_fox_macaron_stream"


def rmsnorm(x, g):
    xf = x.astype(jnp.float32)
    y = xf * lax.rsqrt(jnp.mean(xf * xf, axis=-1, keepdims=True) + EPS) * g.astype(jnp.float32)
    return y.astype(x.dtype)


def swiglu_ffn(h, g, w_in, w_out):
    gate, up = jnp.split(rmsnorm(h, g) @ w_in, 2, axis=-1)
    return (jax.nn.silu(gate) * up) @ w_out


def rope(x, pos):
    half = x.shape[-1] // 2
    inv = ROPE_BASE ** (-jnp.arange(half, dtype=jnp.float32) / half)
    ang = pos.astype(jnp.float32)[:, None] * inv[None, :]
    cos, sin = jnp.cos(ang)[None, :, None, :], jnp.sin(ang)[None, :, None, :]
    xf = x.astype(jnp.float32)
    x1, x2 = xf[..., :half], xf[..., half:]
    return jnp.concatenate([x1 * cos - x2 * sin, x1 * sin + x2 * cos], axis=-1)


def retention_log_gamma():
    return jnp.log1p(-jnp.exp2(-5.0 - jnp.arange(RET_HEADS, dtype=jnp.float32)))


def retention_chunk(S, q, k, v, log_gamma):
    c = q.shape[1]
    pos = jnp.arange(c, dtype=jnp.float32)
    dist = jnp.abs(pos[:, None] - pos[None, :])
    decay_intra = jnp.exp(log_gamma[:, None, None] * dist)
    scores = jnp.einsum('bchd,bshd->bhcs', q, k) * decay_intra[None]
    intra = jnp.einsum('bhcs,bshe->bche', scores, v)
    q_decay = jnp.exp(log_gamma[None, :] * (pos[:, None] + 1.0))
    inter = jnp.einsum('bchd,bhde->bche', q, S) * q_decay[None, :, :, None]
    k_decay = jnp.exp(log_gamma[None, :] * (c - 1.0 - pos[:, None]))
    S_new = jnp.exp(log_gamma * c)[None, :, None, None] * S + jnp.einsum(
        'bchd,bche->bhde', k * k_decay[None, :, :, None], v)
    return S_new, intra + inter


def retention_mixer(h, S0, pos, chunk_len, w_in, gn_g, w_out):
    B, L, _ = h.shape
    q, k, v, g = jnp.split(h @ w_in, [D_MODEL, 2 * D_MODEL, 2 * D_MODEL + RET_V], axis=-1)
    q = rope(q.reshape(B, L, RET_HEADS, RET_DK), pos) * (RET_DK ** -0.5)
    k = rope(k.reshape(B, L, RET_HEADS, RET_DK), pos)
    v = v.reshape(B, L, RET_HEADS, RET_DV).astype(jnp.float32)
    n = L // chunk_len
    to_chunks = lambda t: jnp.moveaxis(t.reshape(B, n, chunk_len, *t.shape[2:]), 1, 0)
    log_gamma = retention_log_gamma()
    S_fin, o = lax.scan(lambda S, qkv: retention_chunk(S, qkv[0], qkv[1], qkv[2], log_gamma),
                        S0.astype(jnp.float32), (to_chunks(q), to_chunks(k), to_chunks(v)))
    o = jnp.moveaxis(o, 0, 1).reshape(B, L, RET_HEADS, RET_DV)
    mu = jnp.mean(o, axis=-1, keepdims=True)
    var = jnp.mean(jnp.square(o - mu), axis=-1, keepdims=True)
    o = ((o - mu) * lax.rsqrt(var + EPS)).reshape(B, L, RET_V) * gn_g.astype(jnp.float32)
    o = (jax.nn.silu(g.astype(jnp.float32)) * o).astype(h.dtype)
    return o @ w_out, S_fin


def fox_kv(h, kv_g, w_kvf, b_f):
    B, L, _ = h.shape
    k, v, fl = jnp.split(rmsnorm(h, kv_g) @ w_kvf, [FOX_W, 2 * FOX_W], axis=-1)
    logf = jax.nn.log_sigmoid(fl.astype(jnp.float32) + b_f.astype(jnp.float32))
    return (k.reshape(B, L, FOX_HEADS, FOX_DH), v.reshape(B, L, FOX_HEADS, FOX_DH), logf)


def fox_block(q_blk, c_blk, qpos, k, v, cumf, kpos):
    s = jnp.einsum('bqhd,bkhd->bhqk', q_blk, k).astype(jnp.float32) * (FOX_DH ** -0.5)
    s = s + jnp.swapaxes(c_blk, 1, 2)[..., None] - jnp.swapaxes(cumf, 1, 2)[:, :, None, :]
    s = jnp.where((qpos[:, None] >= kpos[None, :])[None, None], s, -jnp.inf)
    p = jax.nn.softmax(s, axis=-1)
    return jnp.einsum('bhqk,bkhd->bqhd', p.astype(v.dtype), v)


def fox_mixer(h, w_q, w_out, k, v, cumf, kpos, qpos, c_q):
    B, L, _ = h.shape
    q = (h @ w_q).reshape(B, L, FOX_HEADS, FOX_DH)
    nb = max(L // Q_BLOCK, 1)
    qb = L // nb
    blocks = (jnp.moveaxis(q.reshape(B, nb, qb, FOX_HEADS, FOX_DH), 1, 0),
              jnp.moveaxis(c_q.reshape(B, nb, qb, FOX_HEADS), 1, 0),
              qpos.reshape(nb, qb))
    o = lax.map(lambda a: fox_block(a[0], a[1], a[2], k, v, cumf, kpos), blocks)
    o = jnp.moveaxis(o, 0, 1).reshape(B, L, FOX_W)
    return o @ w_out


def trunk(x, pos, chunk_len, ret_S0, past, p):
    h = x
    L = x.shape[1]
    ret_states = []
    k_new = v_new = logf_new = None
    k_all = v_all = cumf_all = kpos = c_q = None
    for layer in range(DEPTH):
        h = h + 0.5 * swiglu_ffn(h, p['ffn1_g'][layer], p['ffn1_w_in'][layer], p['ffn1_w_out'][layer])
        hn = rmsnorm(h, p['mix_g'][layer])
        if layer < N_A:
            y, S = retention_mixer(hn, ret_S0[layer], pos, chunk_len,
                                   p['ret_w_in'][layer], p['ret_gn_g'][layer], p['ret_w_out'][layer])
            ret_states.append(S)
        else:
            j = layer - N_A
            y = fox_mixer(hn, p['fox_w_q'][j], p['fox_w_out'][j], k_all, v_all, cumf_all, kpos, pos, c_q)
        h = h + y
        h = h + 0.5 * swiglu_ffn(h, p['ffn2_g'][layer], p['ffn2_w_in'][layer], p['ffn2_w_out'][layer])
        if layer == N_A - 1:
            k_new, v_new, logf_new = fox_kv(h, p['kv_g'], p['fox_w_kvf'], p['fox_b_f'])
            if past is None:
                k_all, v_all, logf_all = k_new, v_new, logf_new
            else:
                k_all = jnp.concatenate([past[0].astype(k_new.dtype), k_new], axis=1)
                v_all = jnp.concatenate([past[1].astype(v_new.dtype), v_new], axis=1)
                logf_all = jnp.concatenate([past[2].astype(jnp.float32), logf_new], axis=1)
            cumf_all = jnp.cumsum(logf_all, axis=1)
            n_keys = k_all.shape[1]
            kpos = jnp.arange(n_keys)
            c_q = cumf_all[:, n_keys - L:]
    return (rmsnorm(h, p['final_g']), jnp.stack(ret_states), k_new, v_new, logf_new)


def setup_inputs(seed: int = 0) -> dict:
    key = jax.random.key(seed)
    ks = jax.random.split(key, 24)
    nrm = lambda k, shape, scale: jax.random.normal(k, shape, jnp.float32) * scale
    gain = lambda k, shape: 1.0 + 0.05 * jax.random.normal(k, shape, jnp.float32)
    return {
        'x_prompt': nrm(ks[0], (BATCH, SEQ, D_MODEL), 1.0),
        'x_sample': nrm(ks[1], (DEC_BATCH, DEC_SEQ, D_MODEL), 1.0),
        'state_ret': nrm(ks[2], (N_A, DEC_BATCH, RET_HEADS, RET_DK, RET_DV), 0.1),
        'cache_k': nrm(ks[3], (DEC_BATCH, PAST_LEN, FOX_HEADS, FOX_DH), 1.0),
        'cache_v': nrm(ks[4], (DEC_BATCH, PAST_LEN, FOX_HEADS, FOX_DH), 1.0),
        'cache_logf': jax.nn.log_sigmoid(3.0 + nrm(ks[5], (DEC_BATCH, PAST_LEN, FOX_HEADS), 1.0)),
        'ffn1_g': gain(ks[6], (DEPTH, D_MODEL)),
        'ffn1_w_in': nrm(ks[7], (DEPTH, D_MODEL, 2 * D_FF), D_MODEL ** -0.5),
        'ffn1_w_out': nrm(ks[8], (DEPTH, D_FF, D_MODEL), D_FF ** -0.5),
        'mix_g': gain(ks[9], (DEPTH, D_MODEL)),
        'ffn2_g': gain(ks[10], (DEPTH, D_MODEL)),
        'ffn2_w_in': nrm(ks[11], (DEPTH, D_MODEL, 2 * D_FF), D_MODEL ** -0.5),
        'ffn2_w_out': nrm(ks[12], (DEPTH, D_FF, D_MODEL), D_FF ** -0.5),
        'ret_w_in': nrm(ks[13], (N_A, D_MODEL, 2 * D_MODEL + 2 * RET_V), D_MODEL ** -0.5),
        'ret_gn_g': gain(ks[14], (N_A, RET_V)),
        'ret_w_out': nrm(ks[15], (N_A, RET_V, D_MODEL), RET_V ** -0.5),
        'kv_g': gain(ks[16], (D_MODEL,)),
        'fox_w_kvf': nrm(ks[17], (D_MODEL, 2 * FOX_W + FOX_HEADS), D_MODEL ** -0.5),
        'fox_b_f': jnp.linspace(1.0, 5.0, FOX_HEADS, dtype=jnp.float32) + nrm(ks[18], (FOX_HEADS,), 0.1),
        'fox_w_q': nrm(ks[19], (N_B, D_MODEL, FOX_W), D_MODEL ** -0.5),
        'fox_w_out': nrm(ks[20], (N_B, FOX_W, D_MODEL), FOX_W ** -0.5),
        'final_g': gain(ks[21], (D_MODEL,)),
    }


def reference(x_prompt, x_sample, state_ret, cache_k, cache_v, cache_logf,
              ffn1_g, ffn1_w_in, ffn1_w_out, mix_g, ffn2_g, ffn2_w_in, ffn2_w_out,
              ret_w_in, ret_gn_g, ret_w_out, kv_g, fox_w_kvf, fox_b_f, fox_w_q, fox_w_out, final_g):
    p = {'ffn1_g': ffn1_g, 'ffn1_w_in': ffn1_w_in, 'ffn1_w_out': ffn1_w_out, 'mix_g': mix_g,
         'ffn2_g': ffn2_g, 'ffn2_w_in': ffn2_w_in, 'ffn2_w_out': ffn2_w_out,
         'ret_w_in': ret_w_in, 'ret_gn_g': ret_gn_g, 'ret_w_out': ret_w_out,
         'kv_g': kv_g, 'fox_w_kvf': fox_w_kvf, 'fox_b_f': fox_b_f,
         'fox_w_q': fox_w_q, 'fox_w_out': fox_w_out, 'final_g': final_g}
    b_p, l_p = x_prompt.shape[0], x_prompt.shape[1]
    l_s = x_sample.shape[1]
    past_len = cache_k.shape[1]
    S0_prompt = jnp.zeros((N_A, b_p, RET_HEADS, RET_DK, RET_DV), jnp.float32)
    y_prompt, state_ret_prompt, k_prompt, v_prompt, logf_prompt = trunk(
        x_prompt, jnp.arange(l_p), CHUNK, S0_prompt, None, p)
    y_sample, state_ret_sample, k_sample, v_sample, logf_sample = trunk(
        x_sample, past_len + jnp.arange(l_s), l_s, state_ret, (cache_k, cache_v, cache_logf), p)
    return (y_prompt, y_sample, state_ret_prompt, k_prompt, v_prompt, logf_prompt,
            state_ret_sample, k_sample, v_sample, logf_sample)
```

```cpp
#include <hip/hip_runtime.h>
#include <cstdio>
#include <cstdint>
namespace pg8 {
#define PG8_LAS __attribute__((address_space(3)))
typedef unsigned short bf16_t;
typedef short bf16x8 __attribute__((ext_vector_type(8)));
typedef float f32x4 __attribute__((ext_vector_type(4)));
typedef unsigned u32x4 __attribute__((ext_vector_type(4)));
constexpr int BM = 256, BK = 64, HALF = 128, HTB = HALF * BK * 2  , STAGE_BYTES = 8 * HTB, NXCD = 8, WGM = 8;

__host__ __device__ __forceinline__ int lds_byte(int r, int c) { const int st = (r >> 4) * 2 + (c >> 5), rr = r & 15, cc = c & 31, ob = rr * 64 + cc * 2; return st * 1024 + (ob ^ (((ob >> 9) & 1) << 5)); }
__host__ __device__ __forceinline__ void stage_rc(int b, int& R, int& C) { const int st = b / 1024, sb = b % 1024, swz = sb ^ (((sb >> 9) & 1) << 5); R = (st >> 1) * 16 + swz / 64; C = (st & 1) * 32 + (swz % 64) / 2; }
__host__ __device__ __forceinline__ int perm32(int rho) { const int n = rho >> 4, i = rho & 15; return 8 * (i >> 2) + 4 * n + (i & 3); }

struct Unit { int pm, pn; };
struct Gemm { const bf16_t* A; const bf16_t* Bt; int M, N, K; };

struct StaticOrder {
    int nM, nN, nwg, G, c;
    __host__ __device__ void init(int M, int N, int G_, int c_) { nM = M / BM; nN = N / BM; nwg = nM * nN; G = G_; c = c_; }
    __host__ __device__ bool next(int i, Unit& u) const {
        const long L = (long)i * G + c; if (L >= nwg) return false;
        int wgid = (int)L; { const int q = nwg / NXCD, r = nwg % NXCD, xcd = wgid % NXCD, off = wgid / NXCD; wgid = (xcd < r ? xcd * (q + 1) : r * (q + 1) + (xcd - r) * q) + off; }
        const int nig = WGM * nN, gid = wgid / nig, fm = gid * WGM, gsz = (nM - fm) < WGM ? (nM - fm) : WGM;
        u.pm = fm + ((wgid % nig) % gsz); u.pn = (wgid % nig) / gsz; return true;
    }
    __device__ __forceinline__ void a_ready(const Unit&) const {}
    __device__ __forceinline__ void done(const Unit&) const {}
};

__device__ __forceinline__ unsigned cvt_pk_bf16(float lo, float hi) { unsigned r; asm volatile("v_cvt_pk_bf16_f32 %0, %1, %2" : "=v"(r) : "v"(lo), "v"(hi)); return r; }
typedef float f32x2 __attribute__((ext_vector_type(2)));
template <class Epi, class Sched, bool ALIGN_EPI = false, bool SP2 = false>
__device__ __forceinline__ void gemm_phase(PG8_LAS unsigned char* lds, const Gemm g, const Sched& S, const Epi& E) {
    int tid_ = threadIdx.x; asm volatile("" : "+v"(tid_));
    const int tid = tid_, wid = __builtin_amdgcn_readfirstlane(tid >> 6), lane = tid & 63, wr = wid >> 2, wc = wid & 3, fr = lane & 15, fq = lane >> 4;
    const int K = g.K, nt = K / BK;
    unsigned voffA[2], voffB[2];
#pragma unroll
    for (int i = 0; i < 2; ++i) { int R, C; stage_rc(tid * 16 + i * 8192, R, C); const int Rb = Epi::PERM ? ((R & ~31) + perm32(R & 31)) : R;
        voffA[i] = (unsigned)(R * K + C) * 2u; voffB[i] = (unsigned)(Rb * K + C) * 2u; }
    const size_t kstep = (size_t)(BK * 2);
    const size_t hstep = (size_t)HALF * K * 2;
    const size_t tstep = 2 * hstep;
    const unsigned ldsw = (unsigned)wid * 1024u;
    const int aoff = lds_byte(wr * 64 + fr, fq * 8), boff = lds_byte(wc * 32 + fr, fq * 8);
#define PG8_SA(b, h) (((b) * 2 + (h)) * HTB)
#define PG8_SB(b, h) ((4 + (b) * 2 + (h)) * HTB)
#define PG8_STAGE(bufoff, gbase, voff) do { _Pragma("unroll") for (int _i = 0; _i < 2; ++_i) \
        __builtin_amdgcn_global_load_lds((const unsigned*)((const char*)(gbase) + (voff)[_i]), (PG8_LAS unsigned*)(lds + (bufoff) + ldsw + _i * 8192), 16, 0, 0); } while (0)
#define PG8_LDA(dst, b, h) do { _Pragma("unroll") for (int m = 0; m < 4; ++m) _Pragma("unroll") for (int k = 0; k < 2; ++k) dst[m][k] = *(const PG8_LAS bf16x8*)(lds + PG8_SA(b, h) + aoff + m * 2048 + k * 1024); } while (0)
#define PG8_LDB(dst, b, h) do { _Pragma("unroll") for (int n = 0; n < 2; ++n) _Pragma("unroll") for (int k = 0; k < 2; ++k) dst[n][k] = *(const PG8_LAS bf16x8*)(lds + PG8_SB(b, h) + boff + n * 2048 + k * 1024); } while (0)
#define PG8_MMA(ai, bj, At, Bt) do { __builtin_amdgcn_s_setprio(1); _Pragma("unroll") for (int m = 0; m < 4; ++m) _Pragma("unroll") for (int n = 0; n < 2; ++n) _Pragma("unroll") for (int k = 0; k < 2; ++k) \
        acc[ai][bj][m][n] = __builtin_amdgcn_mfma_f32_16x16x32_bf16(Bt[n][k], At[m][k], acc[ai][bj][m][n], 0, 0, 0); __builtin_amdgcn_s_setprio(0); } while (0)
#define PG8_WAIT_V(n) asm volatile("s_waitcnt vmcnt(" #n ")" ::: "memory")
#define PG8_WAIT_L(n) asm volatile("s_waitcnt lgkmcnt(" #n ")" ::: "memory")
#define PG8_BAR __builtin_amdgcn_s_barrier()
#define PG8_SCHED __builtin_amdgcn_sched_barrier(0)
    Unit cur, nxt; int ui = 0;
    if (!S.next(0, cur)) return;
    f32x4 acc[2][2][4][2];
#pragma unroll
    for (int a = 0; a < 2; ++a)
#pragma unroll
        for (int b = 0; b < 2; ++b)
#pragma unroll
            for (int m = 0; m < 4; ++m)
#pragma unroll
                for (int n = 0; n < 2; ++n) acc[a][b][m][n] = (f32x4){0.f, 0.f, 0.f, 0.f};
    bf16x8 At[4][2], B0[2][2], B1[2][2];
    const char* cA = (const char*)g.A + (size_t)cur.pm * tstep; const char* cB = (const char*)g.Bt + (size_t)cur.pn * tstep;
    S.a_ready(cur);
    if constexpr (SP2) {
        PG8_STAGE(PG8_SB(0, 0), cB, voffB); PG8_STAGE(PG8_SB(0, 1), cB + hstep, voffB); PG8_STAGE(PG8_SA(0, 0), cA, voffA); PG8_STAGE(PG8_SA(0, 1), cA + hstep, voffA);
        if (wr == 1) PG8_BAR;
        PG8_WAIT_V(2); PG8_BAR;
        PG8_STAGE(PG8_SB(1, 0), cB + kstep, voffB); PG8_STAGE(PG8_SA(1, 0), cA + kstep, voffA); PG8_STAGE(PG8_SB(1, 1), cB + hstep + kstep, voffB);
        PG8_WAIT_V(6); PG8_BAR;
    } else {
        PG8_STAGE(PG8_SB(0, 0), cB, voffB); PG8_STAGE(PG8_SA(0, 0), cA, voffA); PG8_STAGE(PG8_SB(0, 1), cB + hstep, voffB); PG8_STAGE(PG8_SA(0, 1), cA + hstep, voffA);
        if (wr == 1) PG8_BAR;
        PG8_WAIT_V(4); PG8_BAR;
        PG8_STAGE(PG8_SB(1, 0), cB + kstep, voffB); PG8_STAGE(PG8_SA(1, 0), cA + kstep, voffA); PG8_STAGE(PG8_SB(1, 1), cB + hstep + kstep, voffB);
        PG8_WAIT_V(6); PG8_BAR;
    }
    for (;;) {
        const bool has_next = S.next(ui + 1, nxt);
        const char* nA = has_next ? (const char*)g.A + (size_t)nxt.pm * tstep : cA; const char* nB = has_next ? (const char*)g.Bt + (size_t)nxt.pn * tstep : cB;
        for (int t = 0; t < nt; t += 2) {
            const bool last = (t == nt - 2);
            const char* a1 = cA + (size_t)(t + 1) * kstep;
            const char* a2 = last ? nA : cA + (size_t)(t + 2) * kstep; const char* b2 = last ? nB : cB + (size_t)(t + 2) * kstep;
            const char* a3 = a2 + kstep; const char* b3 = b2 + kstep;
            if (last && has_next) S.a_ready(nxt);
            if constexpr (SP2) {
            PG8_LDB(B0, 0, 0); PG8_LDB(B1, 0, 1); PG8_SCHED; PG8_LDA(At, 0, 0); PG8_STAGE(PG8_SA(1, 1), a1 + hstep, voffA);
            PG8_WAIT_V(8); PG8_WAIT_L(0); PG8_BAR; PG8_MMA(0, 0, At, B0); PG8_MMA(0, 1, At, B1); PG8_BAR; PG8_SCHED;
            PG8_LDA(At, 0, 1); PG8_STAGE(PG8_SB(0, 0), b2, voffB); PG8_STAGE(PG8_SB(0, 1), b2 + hstep, voffB); PG8_STAGE(PG8_SA(0, 0), a2, voffA);
            PG8_WAIT_V(8); PG8_WAIT_L(0); PG8_BAR; PG8_MMA(1, 0, At, B0); PG8_MMA(1, 1, At, B1); PG8_BAR; PG8_SCHED;
            PG8_LDB(B0, 1, 0); PG8_LDB(B1, 1, 1); PG8_SCHED; PG8_LDA(At, 1, 0); PG8_STAGE(PG8_SA(0, 1), a2 + hstep, voffA);
            PG8_WAIT_V(8); PG8_WAIT_L(0); PG8_BAR; PG8_MMA(0, 0, At, B0); PG8_MMA(0, 1, At, B1); PG8_BAR; PG8_SCHED;
            PG8_LDA(At, 1, 1); PG8_STAGE(PG8_SB(1, 0), b3, voffB); PG8_STAGE(PG8_SB(1, 1), b3 + hstep, voffB); PG8_STAGE(PG8_SA(1, 0), a3, voffA);
            PG8_WAIT_V(8); PG8_WAIT_L(0); PG8_BAR; PG8_MMA(1, 0, At, B0); PG8_MMA(1, 1, At, B1); PG8_BAR; PG8_SCHED;
            } else {
            PG8_LDB(B0, 0, 0); PG8_SCHED; PG8_LDA(At, 0, 0); PG8_STAGE(PG8_SA(1, 1), a1 + hstep, voffA);
            PG8_WAIT_L(8); PG8_BAR; PG8_WAIT_L(0); PG8_MMA(0, 0, At, B0); PG8_BAR; PG8_SCHED;
            PG8_LDB(B1, 0, 1); PG8_STAGE(PG8_SB(0, 0), b2, voffB);
            PG8_BAR; PG8_WAIT_L(0); PG8_MMA(0, 1, At, B1); PG8_BAR;
            PG8_LDA(At, 0, 1); PG8_STAGE(PG8_SA(0, 0), a2, voffA);
            PG8_BAR; PG8_WAIT_L(0); PG8_MMA(1, 0, At, B0); PG8_BAR; PG8_SCHED;
            PG8_STAGE(PG8_SB(0, 1), b2 + hstep, voffB);
            PG8_WAIT_V(6); PG8_BAR; PG8_MMA(1, 1, At, B1); PG8_BAR;
            PG8_LDB(B0, 1, 0); PG8_SCHED; PG8_LDA(At, 1, 0); PG8_STAGE(PG8_SA(0, 1), a2 + hstep, voffA);
            PG8_WAIT_L(8); PG8_BAR; PG8_WAIT_L(0); PG8_MMA(0, 0, At, B0); PG8_BAR; PG8_SCHED;
            PG8_LDB(B1, 1, 1); PG8_STAGE(PG8_SB(1, 0), b3, voffB);
            PG8_BAR; PG8_WAIT_L(0); PG8_MMA(0, 1, At, B1); PG8_BAR;
            PG8_LDA(At, 1, 1); PG8_STAGE(PG8_SA(1, 0), a3, voffA);
            PG8_BAR; PG8_WAIT_L(0); PG8_MMA(1, 0, At, B0); PG8_BAR; PG8_SCHED;
            PG8_STAGE(PG8_SB(1, 1), b3 + hstep, voffB);
            PG8_WAIT_V(6); PG8_BAR; PG8_MMA(1, 1, At, B1); PG8_BAR;
            }
        }
        if constexpr (ALIGN_EPI) { if (wr == 0) PG8_BAR; }
        if constexpr (!Epi::AFTER_DRAIN) { E(acc, cur, wr, wc, fr, fq, ui); S.done(cur); }
        if (!has_next) break;
#pragma unroll
        for (int a = 0; a < 2; ++a)
#pragma unroll
            for (int b = 0; b < 2; ++b)
#pragma unroll
                for (int m = 0; m < 4; ++m)
#pragma unroll
                    for (int n = 0; n < 2; ++n) acc[a][b][m][n] = (f32x4){0.f, 0.f, 0.f, 0.f};
        cur = nxt; cA = nA; cB = nB; ++ui;
        if constexpr (ALIGN_EPI) { if (wr == 1) PG8_BAR; }
    }
    PG8_WAIT_V(0);
    if constexpr (!ALIGN_EPI) { if (wr == 0) PG8_BAR; }
    PG8_BAR;
    if constexpr (Epi::AFTER_DRAIN) { E.fused(acc, cur, wr, wc, fr, fq, lds, wid, lane); S.done(cur); }
#undef PG8_SA
#undef PG8_SB
#undef PG8_STAGE
#undef PG8_LDA
#undef PG8_LDB
#undef PG8_MMA
#undef PG8_WAIT_V
#undef PG8_WAIT_L
#undef PG8_BAR
#undef PG8_SCHED
}
}
static __device__ const double INVF[128] = {
  1.0, 0.930572040929699, 0.8659643233600653, 0.8058421877614819,
  0.7498942093324559, 0.6978305848598664, 0.6493816315762113, 0.6042963902381329,
  0.5623413251903491, 0.5232991146814947, 0.4869675251658631, 0.4531583637600818,
  0.4216965034285822, 0.3924189758484536, 0.3651741272548377, 0.33982083289425596,
  0.31622776601683794, 0.29427271762092816, 0.27384196342643613, 0.25482967479793467,
  0.23713737056616552, 0.220673406908459, 0.2053525026457146, 0.19109529749704404,
  0.1778279410038923, 0.16548170999431813, 0.1539926526059492, 0.14330125702369628,
  0.1333521432163324, 0.12409377607517195, 0.11547819846894582, 0.10746078283213174,
  0.1, 0.0930572040929699, 0.08659643233600653, 0.08058421877614819,
  0.07498942093324558, 0.06978305848598663, 0.06493816315762113, 0.060429639023813285,
  0.05623413251903491, 0.05232991146814947, 0.04869675251658631, 0.04531583637600818,
  0.042169650342858224, 0.03924189758484536, 0.03651741272548377, 0.03398208328942559,
  0.03162277660168379, 0.029427271762092817, 0.027384196342643614, 0.025482967479793464,
  0.023713737056616554, 0.0220673406908459, 0.02053525026457146, 0.019109529749704406,
  0.01778279410038923, 0.016548170999431813, 0.01539926526059492, 0.014330125702369627,
  0.01333521432163324, 0.012409377607517195, 0.011547819846894581, 0.010746078283213174,
  0.01, 0.00930572040929699, 0.008659643233600654, 0.008058421877614819,
  0.007498942093324558, 0.006978305848598663, 0.006493816315762113, 0.006042963902381328,
  0.005623413251903491, 0.005232991146814947, 0.004869675251658631, 0.004531583637600818,
  0.004216965034285823, 0.003924189758484536, 0.003651741272548377, 0.003398208328942559,
  0.0031622776601683794, 0.002942727176209282, 0.0027384196342643613, 0.0025482967479793467,
  0.0023713737056616554, 0.0022067340690845897, 0.002053525026457146, 0.0019109529749704406,
  0.0017782794100389228, 0.0016548170999431814, 0.001539926526059492, 0.0014330125702369627,
  0.001333521432163324, 0.0012409377607517195, 0.0011547819846894581, 0.0010746078283213176,
  0.001, 0.0009305720409296989, 0.0008659643233600654, 0.0008058421877614818,
  0.0007498942093324559, 0.0006978305848598664, 0.0006493816315762113, 0.0006042963902381329,
  0.0005623413251903491, 0.0005232991146814947, 0.0004869675251658631, 0.0004531583637600818,
  0.00042169650342858224, 0.0003924189758484536, 0.0003651741272548377, 0.00033982083289425596,
  0.00031622776601683794, 0.00029427271762092817, 0.0002738419634264361, 0.00025482967479793463,
  0.00023713737056616554, 0.00022067340690845897, 0.0002053525026457146, 0.00019109529749704405,
  0.00017782794100389227, 0.00016548170999431815, 0.0001539926526059492, 0.00014330125702369627,
  0.0001333521432163324, 0.00012409377607517196, 0.00011547819846894582, 0.00010746078283213175
};

#include <hip/hip_cooperative_groups.h>
namespace cg = cooperative_groups;
#define LAS __attribute__((address_space(3)))
#define DI __device__ __forceinline__
typedef unsigned short bf16;
typedef short bf16x8 __attribute__((ext_vector_type(8)));
typedef short s16x4 __attribute__((ext_vector_type(4)));
typedef short v4i16_t __attribute__((ext_vector_type(4)));
typedef float f32x4 __attribute__((ext_vector_type(4)));
typedef float f32x16 __attribute__((ext_vector_type(16)));
typedef unsigned u32x4 __attribute__((ext_vector_type(4)));
typedef unsigned u32x2 __attribute__((ext_vector_type(2)));
typedef float f32x2_t __attribute__((ext_vector_type(2)));
typedef __bf16 bf16x2_t __attribute__((ext_vector_type(2)));
typedef unsigned char uchar;

constexpr int NWAVES = 8, NTHR = 512;
constexpr int D = 1024, TP = 65536, TS = 2048, T = TP + TS, FF = 2816, SEQ = 4096, DSEQ = 64, PAST = 1024, KSAMP = PAST + DSEQ;
constexpr int NB_P = 16, NB_S = 32;
constexpr float EPS = 1e-6f;
constexpr float LOG2E = 1.4426950408889634f;
constexpr int LDS_BYTES = 159744;

constexpr size_t O_Y = 0, O_SRP = 69206016, O_KP = 77594624, O_VP = 144703488, O_LFP = 211812352, O_SRS = 212860928,
                 O_KS = 229638144, O_VS = 231735296, O_LFS = 233832448;
constexpr size_t SZ_WIN = (size_t)5632 * 1024 * 2, SZ_WOUT = (size_t)1024 * 2816 * 2, SZ_ACT = (size_t)T * 1024 * 2;
constexpr size_t WS_WIN = 1u << 20;
constexpr size_t WS_WOUT = WS_WIN + 4 * SZ_WIN;
constexpr size_t WS_RIN = WS_WOUT + 4 * SZ_WOUT;
constexpr size_t WS_ROUT = WS_RIN + (size_t)6144 * 1024 * 2;
constexpr size_t WS_KVF = WS_ROUT + (size_t)1024 * 2048 * 2;
constexpr size_t WS_WQ = WS_KVF + (size_t)2304 * 1024 * 2;
constexpr size_t WS_WO = WS_WQ + (size_t)1024 * 1024 * 2;
constexpr size_t WS_ROPE = WS_WO + (size_t)1024 * 1024 * 2;
constexpr size_t WS_SSQ = WS_ROPE + (size_t)4096 * 256 * 4;
constexpr size_t WS_BIASP = WS_SSQ + (size_t)T * 16 * 4;
constexpr size_t WS_BIASS = WS_BIASP + (size_t)256 * 4096 * 4;
constexpr size_t WS_HB = WS_BIASS + (size_t)512 * KSAMP * 4;
constexpr size_t WS_R = WS_HB + SZ_ACT;
constexpr size_t SZ_HID = (size_t)T * FF * 2, K2B_BYTES = (size_t)(TP + NB_S * KSAMP) * 1024 * 2;
constexpr size_t R_HID = 0, R_VO = 0, R_G = 2 * SZ_ACT, R_QF = 0, R_K2B = SZ_HID, R_V2B = R_K2B + K2B_BYTES;
constexpr size_t WS_END = WS_R + R_V2B + K2B_BYTES;
static_assert(R_G + 2 * SZ_ACT <= R_V2B + K2B_BYTES, "retention overlay");
static_assert(SZ_ACT <= SZ_HID && SZ_HID % 256 == 0, "qf overlay");
static_assert(WS_END <= (size_t)1073741824, "ws size");
static_assert(WS_HB % 256 == 0 && WS_R % 256 == 0 && WS_ROPE % 256 == 0 && WS_SSQ % 256 == 0, "align");

DI unsigned pk(float lo, float hi) { f32x2_t v = {lo, hi}; bf16x2_t b = __builtin_convertvector(v, bf16x2_t); return __builtin_bit_cast(unsigned, b); }
DI float bflo(unsigned w) { return __uint_as_float(w << 16); }
DI float bfhi(unsigned w) { return __uint_as_float(w & 0xffff0000u); }
DI float ex2(float x) { return __builtin_amdgcn_exp2f(x); }
DI float silu_f(float x) { return x * __builtin_amdgcn_rcpf(1.0f + __expf(-x)); }
DI float wave_sum(float v) {
#pragma unroll
    for (int o = 1; o < 64; o <<= 1) v += __shfl_xor(v, o);
    return v;
}
DI float row_rstd(const float* ssq, int row) {
    const f32x4* p = (const f32x4*)(ssq + (size_t)row * 16);
    const f32x4 a = p[0], b = p[1], c = p[2], d = p[3];
    const float s = (((a[0] + a[1]) + (a[2] + a[3])) + ((b[0] + b[1]) + (b[2] + b[3]))) + (((c[0] + c[1]) + (c[2] + c[3])) + ((d[0] + d[1]) + (d[2] + d[3])));
    return __builtin_amdgcn_rsqf(s * (1.0f / 1024.0f) + EPS);
}

namespace pg8 {
struct EpiSwiGLU {
    static constexpr bool PERM = true, AFTER_DRAIN = false;
    bf16_t* O; const LAS float* rl;
    __device__ __forceinline__ void operator()(const f32x4 (&acc)[2][2][4][2], const Unit& u, int wr, int wc, int fr, int fq, int ui) const {
        const int row0 = u.pm * BM + wr * 64 + fr, col0 = u.pn * 128 + wc * 32 + 8 * fq;
        const LAS float* rlu = rl + ui * 256 + wr * 64 + fr;
#pragma unroll
        for (int ai = 0; ai < 2; ++ai)
#pragma unroll
            for (int m = 0; m < 4; ++m) {
                const int row = row0 + ai * HALF + m * 16; const float rs = rlu[ai * HALF + m * 16];
                u32x4 w;
#pragma unroll
                for (int n = 0; n < 2; ++n) {
                    const f32x4 g = acc[ai][0][m][n] * rs, up = acc[ai][1][m][n] * rs;
                    const float h0 = silu_f(g[0]) * up[0], h1 = silu_f(g[1]) * up[1], h2 = silu_f(g[2]) * up[2], h3 = silu_f(g[3]) * up[3];
                    w[2 * n] = pk(h0, h1); w[2 * n + 1] = pk(h2, h3);
                }
                *(u32x4*)(O + (size_t)row * FF + col0) = w;
            }
    }
};
struct EpiRes {
    static constexpr bool PERM = true, AFTER_DRAIN = false;
    bf16_t* HB; float* ssq; float alpha;
    __device__ __forceinline__ void operator()(const f32x4 (&acc)[2][2][4][2], const Unit& u, int wr, int wc, int fr, int fq, int ui) const {
        const int row0 = u.pm * BM + wr * 64 + fr, col0 = u.pn * BM + wc * 32 + 8 * fq;
#pragma unroll
        for (int ai = 0; ai < 2; ++ai) {
            asm volatile("" ::: "memory");
            u32x4 pre[4][2];
#pragma unroll
            for (int m = 0; m < 4; ++m)
#pragma unroll
                for (int bj = 0; bj < 2; ++bj) pre[m][bj] = *(const u32x4*)(HB + (size_t)(row0 + ai * HALF + m * 16) * D + col0 + bj * HALF);
#pragma unroll
            for (int m = 0; m < 4; ++m) {
                const int row = row0 + ai * HALF + m * 16; float s = 0.f;
#pragma unroll
                for (int bj = 0; bj < 2; ++bj) {
                    const u32x4 pv = pre[m][bj];
                    const f32x4 h0 = {bflo(pv[0]), bfhi(pv[0]), bflo(pv[1]), bfhi(pv[1])}, h1 = {bflo(pv[2]), bfhi(pv[2]), bflo(pv[3]), bfhi(pv[3])};
                    const f32x4 o0 = h0 + acc[ai][bj][m][0] * alpha, o1 = h1 + acc[ai][bj][m][1] * alpha;
                    u32x4 w; w[0] = pk(o0[0], o0[1]); w[1] = pk(o0[2], o0[3]); w[2] = pk(o1[0], o1[1]); w[3] = pk(o1[2], o1[3]);
                    *(u32x4*)(HB + (size_t)row * D + col0 + bj * HALF) = w;
                    s += (o0[0] * o0[0] + o0[1] * o0[1]) + (o0[2] * o0[2] + o0[3] * o0[3]) + (o1[0] * o1[0] + o1[1] * o1[1]) + (o1[2] * o1[2] + o1[3] * o1[3]);
                }
                s += __shfl_xor(s, 16); s += __shfl_xor(s, 32);
                if (fq == 0) ssq[(size_t)row * 16 + u.pn * 4 + wc] = s;
            }
        }
    }
};
struct EpiRetIn {
    static constexpr bool PERM = true, AFTER_DRAIN = false;
    bf16_t *Q, *K, *V, *G; const LAS float* rl; const float* rope;
    __device__ __forceinline__ void operator()(const f32x4 (&acc)[2][2][4][2], const Unit& u, int wr, int wc, int fr, int fq, int ui) const {
        const int row0 = u.pm * BM + wr * 64 + fr, d0 = wc * 32 + 8 * fq;
        const int pn = u.pn;
        const LAS float* rlu = rl + ui * 256 + wr * 64 + fr;
#pragma unroll
        for (int ai = 0; ai < 2; ++ai)
#pragma unroll
            for (int m = 0; m < 4; ++m) {
                if (pn < 8 && (m & 1) == 0) asm volatile("" ::: "memory");
                const int row = row0 + ai * HALF + m * 16; const float rs = rlu[ai * HALF + m * 16];
                if (pn < 8) {
                    const int pos = row < TP ? (row & (SEQ - 1)) : PAST + ((row - TP) & (DSEQ - 1));
                    const float* cs = rope + (size_t)pos * 256 + d0;
                    const float sc = pn < 4 ? rs * 0.0625f : rs;
                    bf16_t* dst = (pn < 4 ? Q : K) + (size_t)row * D + (pn & 3) * 256 + d0;
                    u32x4 w1, w2;
#pragma unroll
                    for (int n = 0; n < 2; ++n) {
                        const f32x4 c = *(const f32x4*)(cs + 4 * n), s = *(const f32x4*)(cs + 128 + 4 * n);
                        const f32x4 x1 = acc[ai][0][m][n] * sc, x2 = acc[ai][1][m][n] * sc;
                        const f32x4 y1 = x1 * c - x2 * s, y2 = x1 * s + x2 * c;
                        w1[2 * n] = pk(y1[0], y1[1]); w1[2 * n + 1] = pk(y1[2], y1[3]);
                        w2[2 * n] = pk(y2[0], y2[1]); w2[2 * n + 1] = pk(y2[2], y2[3]);
                    }
                    *(u32x4*)dst = w1; *(u32x4*)(dst + 128) = w2;
                } else {
                    const bool isg = pn >= 16;
                    bf16_t* dst = (isg ? G : V) + (size_t)row * 2048 + ((pn - 8) & 7) * 256 + d0;
#pragma unroll
                    for (int bj = 0; bj < 2; ++bj) {
                        f32x4 a = acc[ai][bj][m][0] * rs, b = acc[ai][bj][m][1] * rs;
                        if (isg) { a = (f32x4){silu_f(a[0]), silu_f(a[1]), silu_f(a[2]), silu_f(a[3])}; b = (f32x4){silu_f(b[0]), silu_f(b[1]), silu_f(b[2]), silu_f(b[3])}; }
                        u32x4 w; w[0] = pk(a[0], a[1]); w[1] = pk(a[2], a[3]); w[2] = pk(b[0], b[1]); w[3] = pk(b[2], b[3]);
                        *(u32x4*)(dst + bj * HALF) = w;
                    }
                }
            }
    }
};
struct EpiKVF {
    static constexpr bool PERM = true, AFTER_DRAIN = false;
    float* out; bf16_t *K2B, *V2B; const LAS float* rl; const float* bf;
    __device__ __forceinline__ void operator()(const f32x4 (&acc)[2][2][4][2], const Unit& u, int wr, int wc, int fr, int fq, int ui) const {
        const int row0 = u.pm * BM + wr * 64 + fr, d0 = wc * 32 + 8 * fq;
        const int pn = u.pn; const bool samp = u.pm >= TP / BM;
        const LAS float* rlu = rl + ui * 256 + wr * 64 + fr;
        if (pn < 8) {
            const bool isv = pn >= 4;
            float* fbase = out + (samp ? (isv ? O_VS : O_KS) - (size_t)TP * D : (isv ? O_VP : O_KP)) + (pn & 3) * 256 + d0;
            bf16_t* bbase = (isv ? V2B : K2B) + (pn & 3) * 256 + d0;
#pragma unroll
            for (int ai = 0; ai < 2; ++ai)
#pragma unroll
                for (int m = 0; m < 4; ++m) {
                    const int row = row0 + ai * HALF + m * 16; const float rs = rlu[ai * HALF + m * 16];
                    const int brow = row + (samp ? (((row - TP) >> 6) + 1) * 1024 : 0);
                    float* fo = fbase + (size_t)row * D; bf16_t* bo = bbase + (size_t)brow * D;
#pragma unroll
                    for (int bj = 0; bj < 2; ++bj) {
                        const f32x4 a = acc[ai][bj][m][0] * rs, b = acc[ai][bj][m][1] * rs;
                        *(f32x4*)(fo + bj * HALF) = a; *(f32x4*)(fo + bj * HALF + 4) = b;
                        u32x4 w; w[0] = pk(a[0], a[1]); w[1] = pk(a[2], a[3]); w[2] = pk(b[0], b[1]); w[3] = pk(b[2], b[3]);
                        *(u32x4*)(bo + bj * HALF) = w;
                    }
                }
        } else if (wc == 0 && fq < 2) {
            float* lbase = out + (samp ? O_LFS - (size_t)TP * 16 : O_LFP) + 8 * fq;
            const f32x4 bb0 = *(const f32x4*)(bf + 8 * fq), bb1 = *(const f32x4*)(bf + 8 * fq + 4);
#pragma unroll
            for (int ai = 0; ai < 2; ++ai)
#pragma unroll
                for (int m = 0; m < 4; ++m) {
                    const int row = row0 + ai * HALF + m * 16; const float rs = rlu[ai * HALF + m * 16];
                    float* lo = lbase + (size_t)row * 16;
#pragma unroll
                    for (int n = 0; n < 2; ++n) {
                        const f32x4 x = acc[ai][0][m][n] * rs + (n ? bb1 : bb0); f32x4 y;
#pragma unroll
                        for (int j = 0; j < 4; ++j) y[j] = fminf(x[j], 0.f) - __logf(1.0f + __expf(-fabsf(x[j])));
                        *(f32x4*)(lo + 4 * n) = y;
                    }
                }
        }
    }
};
struct EpiQ {
    static constexpr bool PERM = true, AFTER_DRAIN = false;
    bf16_t* O; const LAS float* rl;
    __device__ __forceinline__ void operator()(const f32x4 (&acc)[2][2][4][2], const Unit& u, int wr, int wc, int fr, int fq, int ui) const {
        const int row0 = u.pm * BM + wr * 64 + fr, col0 = u.pn * BM + wc * 32 + 8 * fq;
        const LAS float* rlu = rl + ui * 256 + wr * 64 + fr;
#pragma unroll
        for (int ai = 0; ai < 2; ++ai)
#pragma unroll
            for (int m = 0; m < 4; ++m) {
                const int row = row0 + ai * HALF + m * 16; const float rs = rlu[ai * HALF + m * 16] * (0.125f * LOG2E);
#pragma unroll
                for (int bj = 0; bj < 2; ++bj) {
                    const f32x4 a = acc[ai][bj][m][0] * rs, b = acc[ai][bj][m][1] * rs;
                    u32x4 w; w[0] = pk(a[0], a[1]); w[1] = pk(a[2], a[3]); w[2] = pk(b[0], b[1]); w[3] = pk(b[2], b[3]);
                    *(u32x4*)(O + (size_t)row * D + col0 + bj * HALF) = w;
                }
            }
    }
};
}

DI void tr_item(const float* W, int K, int N, bf16* WT, int drow0, const float* g, LAS float* scr, int k0, int n0, int lane) {
    const int n = n0 + 4 * (lane & 7);
    f32x4 v[8];
#pragma unroll
    for (int i = 0; i < 8; ++i) { const int kk = 8 * i + (lane >> 3); v[i] = (n < N) ? *(const f32x4*)(W + (size_t)(k0 + kk) * N + n) : (f32x4){0.f, 0.f, 0.f, 0.f}; }
#pragma unroll
    for (int i = 0; i < 8; ++i) { const int kk = 8 * i + (lane >> 3); const float gs = g ? g[k0 + kk] : 1.0f; LAS float* d = scr + kk * 33 + 4 * (lane & 7);
        d[0] = v[i][0] * gs; d[1] = v[i][1] * gs; d[2] = v[i][2] * gs; d[3] = v[i][3] * gs; }
    asm volatile("s_waitcnt lgkmcnt(0)" ::: "memory");
    const int c = lane & 7;
#pragma unroll
    for (int j = 0; j < 4; ++j) { const int nn = (lane >> 3) + 8 * j; const LAS float* s = scr + (8 * c) * 33 + nn;
        u32x4 o; o[0] = pk(s[0 * 33], s[1 * 33]); o[1] = pk(s[2 * 33], s[3 * 33]); o[2] = pk(s[4 * 33], s[5 * 33]); o[3] = pk(s[6 * 33], s[7 * 33]);
        *(u32x4*)(WT + (size_t)(drow0 + nn) * K + k0 + 8 * c) = o; }
    asm volatile("s_waitcnt lgkmcnt(0)" ::: "memory");
}
DI bool tr_matrix(int& r, const float* W, int K, int N, int nblk, bf16* WT, const float* g, int mode, LAS float* scr, int lane) {
    const int items = (K / 64) * nblk;
    if (r >= items) { r -= items; return false; }
    const int kb = r / nblk, nb = r % nblk, n0 = 32 * nb;
    int drow0 = n0;
    if (mode == 1) { const int bj = n0 / FF, rem = n0 % FF; drow0 = 256 * (rem / 128) + 128 * bj + (rem % 128); }
    tr_item(W, K, N, WT, drow0, g, scr, 64 * kb, n0, lane);
    return true;
}
DI void sincos_d(double x, float& s, float& c) {
    const double n = __builtin_rint(x * 0.63661977236758134308);
    double r = __builtin_fma(-n, 1.57079632679489655800e+00, x); r = __builtin_fma(-n, 6.12323399573676603587e-17, r);
    const double r2 = r * r;
    double sp = -1.0 / 1307674368000.0; sp = sp * r2 + 1.0 / 6227020800.0; sp = sp * r2 - 1.0 / 39916800.0; sp = sp * r2 + 1.0 / 362880.0; sp = sp * r2 - 1.0 / 5040.0; sp = sp * r2 + 1.0 / 120.0; sp = sp * r2 - 1.0 / 6.0; sp = sp * r2 * r + r;
    double cp = 1.0 / 20922789888000.0; cp = cp * r2 - 1.0 / 87178291200.0; cp = cp * r2 + 1.0 / 479001600.0; cp = cp * r2 - 1.0 / 3628800.0; cp = cp * r2 + 1.0 / 40320.0; cp = cp * r2 - 1.0 / 720.0; cp = cp * r2 + 1.0 / 24.0; cp = cp * r2 - 0.5; cp = cp * r2 + 1.0;
    const int q = ((int)n) & 3;
    const double ss = (q == 0) ? sp : (q == 1) ? cp : (q == 2) ? -sp : -cp;
    const double cc = (q == 0) ? cp : (q == 1) ? -sp : (q == 2) ? -cp : sp;
    s = (float)ss; c = (float)cc;
}

constexpr int RL_OFF = 131072;
static_assert(RL_OFF + 25 * 1024 <= LDS_BYTES, "rstd table");
DI void rstd_prepass(LAS uchar* lds, const float* ssq, const pg8::StaticOrder& S, int tid) {
    LAS float* rl = (LAS float*)(lds + RL_OFF);
    pg8::Unit u; int nun = 0;
    while (nun < 25 && S.next(nun, u)) ++nun;
#pragma unroll 4
    for (int e = tid; e < nun * 256; e += NTHR) { S.next(e >> 8, u); rl[e] = row_rstd(ssq, u.pm * 256 + (e & 255)); }
    __syncthreads();
}
#define KSEL(k) (ONLY < 0 || ONLY == (k))
struct Params { const float* in[22]; float* out; unsigned char* ws; int ph_lo, ph_hi; unsigned char prog[32]; };

DI void phase_prologue(const Params& P, uchar* ws, float* out, LAS uchar* lds, int gw, int NGW, int wave, int lane) {
    LAS float* scr = (LAS float*)(lds + wave * 16384);
    constexpr int I_IN = 16 * 176, I_OUT = 44 * 32;
    constexpr int NITEMS = 4 * I_IN + 4 * I_OUT + 16 * 192 + 32 * 32 + 16 * 72 + 2 * 16 * 32;
    for (int it = gw; it < NITEMS; it += NGW) {
        int r = it; bool done = false;
#pragma unroll
        for (int f = 0; f < 4; ++f) {
            if (done) break;
            const int l = f >> 1; const bool second = f & 1;
            done = tr_matrix(r, P.in[second ? 11 : 7] + (size_t)l * 1024 * 5632, 1024, 5632, 176, (bf16*)(ws + WS_WIN + f * SZ_WIN), P.in[second ? 10 : 6] + l * 1024, 1, scr, lane);
        }
#pragma unroll
        for (int f = 0; f < 4; ++f) {
            if (done) break;
            const int l = f >> 1; const bool second = f & 1;
            done = tr_matrix(r, P.in[second ? 12 : 8] + (size_t)l * 2816 * 1024, 2816, 1024, 32, (bf16*)(ws + WS_WOUT + f * SZ_WOUT), nullptr, 0, scr, lane);
        }
        if (!done) done = tr_matrix(r, P.in[13], 1024, 6144, 192, (bf16*)(ws + WS_RIN), P.in[9], 0, scr, lane);
        if (!done) done = tr_matrix(r, P.in[15], 2048, 1024, 32, (bf16*)(ws + WS_ROUT), P.in[14], 0, scr, lane);
        if (!done) done = tr_matrix(r, P.in[17], 1024, 2064, 72, (bf16*)(ws + WS_KVF), P.in[16], 0, scr, lane);
        if (!done) done = tr_matrix(r, P.in[19], 1024, 1024, 32, (bf16*)(ws + WS_WQ), P.in[9] + 1024, 0, scr, lane);
        if (!done) done = tr_matrix(r, P.in[20], 1024, 1024, 32, (bf16*)(ws + WS_WO), nullptr, 0, scr, lane);
    }
    {
        bf16* HB = (bf16*)(ws + WS_HB); float* ssq = (float*)(ws + WS_SSQ);
        constexpr int NR = 4;
        for (int m0 = gw; m0 < T; m0 += NR * NGW) {
            f32x4 v[NR][4];
#pragma unroll
            for (int u = 0; u < NR; ++u) { const int m = m0 + u * NGW < T ? m0 + u * NGW : m0;
                const float* src = m < TP ? P.in[0] + (size_t)m * D : P.in[1] + (size_t)(m - TP) * D;
#pragma unroll
                for (int j = 0; j < 4; ++j) v[u][j] = ((const f32x4*)src)[lane + 64 * j]; }
#pragma unroll
            for (int u = 0; u < NR; ++u) {
                const int m = m0 + u * NGW; if (m >= T) break;
                float s = 0.f;
#pragma unroll
                for (int j = 0; j < 4; ++j) s += (v[u][j][0] * v[u][j][0] + v[u][j][1] * v[u][j][1]) + (v[u][j][2] * v[u][j][2] + v[u][j][3] * v[u][j][3]);
                s = wave_sum(s);
#pragma unroll
                for (int j = 0; j < 4; ++j) { u32x2 w; w[0] = pk(v[u][j][0], v[u][j][1]); w[1] = pk(v[u][j][2], v[u][j][3]); ((u32x2*)(HB + (size_t)m * D))[lane + 64 * j] = w; }
                if (lane < 16) ssq[(size_t)m * 16 + lane] = lane == 0 ? s : 0.f;
            }
        }
    }
}

DI void rope_table(uchar* ws, int gw, int NGW, int lane) {
    {
        const int gt = gw * 64 + lane, NGT = NGW * 64; float* rope = (float*)(ws + WS_ROPE);
        for (int e = gt; e < 4096 * 128; e += NGT) { const int pos = e >> 7, j = e & 127; float s, c; sincos_d((double)pos * INVF[j], s, c); rope[(size_t)pos * 256 + j] = c; rope[(size_t)pos * 256 + 128 + j] = s; }
    }
}

DI f32x16 mfma32(bf16x8 a, bf16x8 b, f32x16 c) { return __builtin_amdgcn_mfma_f32_32x32x16_bf16(a, b, c, 0, 0, 0); }
DI int crow(int i, int hh) { return (i & 3) + 8 * (i >> 2) + 4 * hh; }
DI s16x4 vtr(const LAS uchar* p) { return __builtin_bit_cast(s16x4, __builtin_amdgcn_ds_read_tr16_b64_v4i16((LAS v4i16_t*)p)); }
DI bf16x8 cat8(s16x4 lo, s16x4 hi) { return __builtin_shufflevector(lo, hi, 0, 1, 2, 3, 4, 5, 6, 7); }
DI bf16x8 ldsv(const LAS uchar* p) { return *(const LAS bf16x8*)p; }
template <int S> DI bf16x8 pack8(const f32x16& x) { u32x4 p; p[0] = pk(x[8 * S], x[8 * S + 1]); p[1] = pk(x[8 * S + 2], x[8 * S + 3]); p[2] = pk(x[8 * S + 4], x[8 * S + 5]); p[3] = pk(x[8 * S + 6], x[8 * S + 7]); return __builtin_bit_cast(bf16x8, p); }
DI s16x4 scale4(s16x4 v, float f0, float f1, float f2, float f3) {
    const u32x2 w = __builtin_bit_cast(u32x2, v); u32x2 o;
    o[0] = pk(bflo(w[0]) * f0, bfhi(w[0]) * f1); o[1] = pk(bflo(w[1]) * f2, bfhi(w[1]) * f3);
    return __builtin_bit_cast(s16x4, o);
}
namespace ret {
constexpr int QP = 528, KP = 528, VP = 320, SP = 528;
constexpr int OFF_Q = 0, OFF_K = 64 * QP, OFF_V = OFF_K + 64 * KP, OFF_ST = OFF_V + 64 * VP, END = OFF_ST + 128 * SP;
static_assert(END <= LDS_BYTES, "retention LDS");
}
DI void ret_item(LAS uchar* lds, const bf16* Qg, const bf16* Kg, bf16* Vg, size_t rowbase, int h, int sl, int nch, const float* S0, float* Sout, float lg2) {
    using namespace ret;
    int tid_ = threadIdx.x; asm volatile("" : "+v"(tid_));
    const int tid = tid_, lane = tid & 63, w = __builtin_amdgcn_readfirstlane(tid >> 6), r = lane & 31, hh = lane >> 5;
    const int ci = w >> 2, ei = w & 3, dq = w >> 1, eh = w & 1;
    const int q4 = (lane & 15) >> 2, p4 = lane & 3, blk = (lane >> 4) & 1;
    f32x16 S[2][2];
    if (S0) {
#pragma unroll
        for (int ti = 0; ti < 2; ++ti)
#pragma unroll
            for (int tj = 0; tj < 2; ++tj)
#pragma unroll
                for (int i = 0; i < 16; ++i) S[ti][tj][i] = S0[(size_t)(64 * dq + 32 * ti + crow(i, hh)) * 512 + 128 * sl + 64 * eh + 32 * tj + r];
    } else {
#pragma unroll
        for (int ti = 0; ti < 2; ++ti)
#pragma unroll
            for (int tj = 0; tj < 2; ++tj)
#pragma unroll
                for (int i = 0; i < 16; ++i) S[ti][tj][i] = 0.f;
    }
    const float g64 = ex2(lg2 * 64.f);
    const bf16* qsrc = Qg + (rowbase + (tid >> 5)) * D + h * 256 + (tid & 31) * 8;
    const bf16* ksrc = Kg + (rowbase + (tid >> 5)) * D + h * 256 + (tid & 31) * 8;
    bf16* vsrc = Vg + (rowbase + (tid >> 4)) * 2048 + h * 512 + sl * 128 + (tid & 15) * 8;
    const int qdst = (tid >> 5) * QP + (tid & 31) * 16, vdst = (tid >> 4) * VP + (tid & 15) * 16;
    const float lg2_inv = lg2;
#pragma unroll 1
    for (int n = 0; n < nch; ++n) {
        float lg2 = lg2_inv; asm volatile("" : "+v"(lg2));
        u32x4 rq[4], rk[4], rv[2];
        {
            const size_t adv = (size_t)64 * n;
#pragma unroll
            for (int i = 0; i < 4; ++i) { rq[i] = *(const u32x4*)(qsrc + (adv + 16 * i) * D); rk[i] = *(const u32x4*)(ksrc + (adv + 16 * i) * D); }
#pragma unroll
            for (int i = 0; i < 2; ++i) rv[i] = *(const u32x4*)(vsrc + (adv + 32 * i) * 2048);
        }
        __syncthreads();
#pragma unroll
        for (int i = 0; i < 4; ++i) { *(LAS u32x4*)(lds + OFF_Q + qdst + 16 * i * QP) = rq[i]; *(LAS u32x4*)(lds + OFF_K + qdst + 16 * i * KP) = rk[i]; }
        asm volatile("" ::: "memory");
#pragma unroll
        for (int i = 0; i < 2; ++i) {
            const float f = ex2(lg2 * (float)(63 - 32 * i - (tid >> 4))); u32x4 w;
#pragma unroll
            for (int j = 0; j < 4; ++j) w[j] = pk(bflo(rv[i][j]) * f, bfhi(rv[i][j]) * f);
            *(LAS u32x4*)(lds + OFF_V + vdst + 32 * i * VP) = w;
        }
        asm volatile("" ::: "memory");
#pragma unroll
        for (int ti = 0; ti < 2; ++ti)
#pragma unroll
            for (int tj = 0; tj < 2; ++tj)
#pragma unroll
                for (int g = 0; g < 4; ++g) { u32x2 v; v[0] = pk(S[ti][tj][4 * g], S[ti][tj][4 * g + 1]); v[1] = pk(S[ti][tj][4 * g + 2], S[ti][tj][4 * g + 3]);
                    *(LAS u32x2*)(lds + OFF_ST + (64 * eh + 32 * tj + r) * SP + (64 * dq + 32 * ti + 8 * g + 4 * hh) * 2) = v; }
        __syncthreads();
        f32x16 sc0, sc1;
#pragma unroll
        for (int i = 0; i < 16; ++i) { sc0[i] = 0.f; sc1[i] = 0.f; }
        const LAS uchar* qrow = lds + OFF_Q + (32 * ci + r) * QP + hh * 16;
        {
            const LAS uchar* krow = lds + OFF_K + r * KP + hh * 16;
#pragma unroll
            for (int kk = 0; kk < 16; ++kk) { const bf16x8 qf = ldsv(qrow + kk * 32); sc0 = mfma32(ldsv(krow + kk * 32), qf, sc0); sc1 = mfma32(ldsv(krow + 32 * KP + kk * 32), qf, sc1);
                if ((kk & 3) == 3) asm volatile("" ::: "memory"); }
        }
        {
            const float a0 = (float)(32 * ci + r - 4 * hh), a1 = a0 - 32.f;
#pragma unroll
            for (int i = 0; i < 16; ++i) { const float cc = (float)((i & 3) + 8 * (i >> 2)); const float sm = cc + (float)(4 * hh - 63);
                sc0[i] *= ex2(lg2 * (fabsf(a0 - cc) + sm)); sc1[i] *= ex2(lg2 * (fabsf(a1 - cc) + sm + 32.f)); }
        }
        f32x16 o;
#pragma unroll
        for (int i = 0; i < 16; ++i) o[i] = 0.f;
        {
            const LAS uchar* vb = lds + OFF_V + (4 * hh + q4) * VP + (32 * ei + 16 * blk + 4 * p4) * 2;
            o = mfma32(pack8<0>(sc0), cat8(vtr(vb), vtr(vb + 8 * VP)), o);
            o = mfma32(pack8<1>(sc0), cat8(vtr(vb + 16 * VP), vtr(vb + 24 * VP)), o);
            o = mfma32(pack8<0>(sc1), cat8(vtr(vb + 32 * VP), vtr(vb + 40 * VP)), o);
            o = mfma32(pack8<1>(sc1), cat8(vtr(vb + 48 * VP), vtr(vb + 56 * VP)), o);
        }
        f32x16 o2;
#pragma unroll
        for (int i = 0; i < 16; ++i) o2[i] = 0.f;
        {
            const LAS uchar* strow = lds + OFF_ST + (32 * ei + r) * SP + hh * 16;
#pragma unroll
            for (int kk = 0; kk < 16; ++kk) { o2 = mfma32(ldsv(qrow + kk * 32), ldsv(strow + kk * 32), o2); if ((kk & 3) == 3) asm volatile("" ::: "memory"); }
        }
        {
            bf16* op = Vg + (rowbase + (size_t)64 * n + 32 * ci) * 2048 + h * 512 + sl * 128 + 32 * ei + r;
#pragma unroll
            for (int i = 0; i < 16; ++i) { const int c = crow(i, hh); const float val = o[i] + o2[i] * ex2(lg2 * (float)(32 * ci + c + 1));
                op[(size_t)c * 2048] = (bf16)(pk(val, 0.f) & 0xffffu); }
        }
        asm volatile("" ::: "memory");
#pragma unroll
        for (int ti = 0; ti < 2; ++ti)
#pragma unroll
            for (int tj = 0; tj < 2; ++tj) S[ti][tj] = S[ti][tj] * g64;
        {
            const LAS uchar* ka = lds + OFF_K + (8 * hh + q4) * KP + (64 * dq + 16 * blk + 4 * p4) * 2;
            const LAS uchar* va = lds + OFF_V + (8 * hh + q4) * VP + (64 * eh + 16 * blk + 4 * p4) * 2;
#pragma unroll
            for (int kk = 0; kk < 4; ++kk) {
                bf16x8 A[2], B[2];
#pragma unroll
                for (int ti = 0; ti < 2; ++ti) A[ti] = cat8(vtr(ka + kk * 16 * KP + ti * 64), vtr(ka + kk * 16 * KP + 4 * KP + ti * 64));
#pragma unroll
                for (int tj = 0; tj < 2; ++tj) B[tj] = cat8(vtr(va + kk * 16 * VP + tj * 64), vtr(va + kk * 16 * VP + 4 * VP + tj * 64));
#pragma unroll
                for (int ti = 0; ti < 2; ++ti)
#pragma unroll
                    for (int tj = 0; tj < 2; ++tj) S[ti][tj] = mfma32(A[ti], B[tj], S[ti][tj]);
                asm volatile("" ::: "memory");
            }
        }
    }
#pragma unroll
    for (int ti = 0; ti < 2; ++ti)
#pragma unroll
        for (int tj = 0; tj < 2; ++tj)
#pragma unroll
            for (int i = 0; i < 16; ++i) Sout[(size_t)(64 * dq + 32 * ti + crow(i, hh)) * 512 + 128 * sl + 64 * eh + 32 * tj + r] = S[ti][tj][i];
    __syncthreads();
}

namespace fox {
constexpr int KPI = 144, VPI = 192, KB = 64 * KPI, VB = 64 * VPI;
constexpr int OFF_K = 0, OFF_V = 3 * KB, OFF_BIAS = OFF_V + 3 * VB, OFF_SCR = OFF_BIAS + 4096 * 4, END = OFF_SCR + 8 * 256;
static_assert(END <= LDS_BYTES, "attention LDS");
}
DI float max3f(float a, float b, float c) { float r; asm("v_max3_f32 %0, %1, %2, %3" : "=v"(r) : "v"(a), "v"(b), "v"(c)); return r; }
DI float fadd_s(float a, float b) { float r; asm("v_add_f32_e32 %0, %1, %2" : "=v"(r) : "v"(a), "v"(b)); return r; }
DI float fsub_s(float a, float b) { float r; asm("v_sub_f32_e32 %0, %1, %2" : "=v"(r) : "v"(a), "v"(b)); return r; }
#define SBAR() __builtin_amdgcn_sched_barrier(0)
DI void fox_init(f32x16& n0, f32x16& n1, const LAS f32x4* bp, float m) {
#pragma unroll
    for (int g = 0; g < 4; ++g) { const f32x4 b0 = bp[2 * g], b1 = bp[2 * g + 8];
#pragma unroll
        for (int j = 0; j < 4; ++j) { n0[4 * g + j] = b0[j] - m; n1[4 * g + j] = b1[j] - m; }
        SBAR(); }
}
DI void fox_qk_plain(f32x16& n0, f32x16& n1, const LAS uchar* kb, const bf16x8 (&qf)[4]) {
#pragma unroll
    for (int kk = 0; kk < 4; ++kk) { n0 = mfma32(ldsv(kb + kk * 32), qf[kk], n0); n1 = mfma32(ldsv(kb + 32 * fox::KPI + kk * 32), qf[kk], n1); }
}
DI void fox_hot(f32x16& c0, f32x16& c1, f32x16& n0, f32x16& n1, f32x16& o0, f32x16& o1, float& l, float m,
                const LAS uchar* kb, const LAS uchar* vb, const LAS f32x4* bpn, const bf16x8 (&qf)[4], bf16x8 x0, bf16x8 x1, bf16x8 x2) {
    using namespace fox;
#define FOX_KF(i) ldsv(kb + ((i) & 1) * 32 * KPI + ((i) >> 1) * 32)
#define FOX_VFR(i) cat8(vtr(vb + (16 * ((i) >> 1)) * VPI + ((i) & 1) * 64), vtr(vb + (16 * ((i) >> 1) + 8) * VPI + ((i) & 1) * 64))
#define FOX_EX4(P, B) do { P[B] = ex2(P[B]); P[B + 1] = ex2(P[B + 1]); P[B + 2] = ex2(P[B + 2]); P[B + 3] = ex2(P[B + 3]); } while (0)
#define FOX_SUM4(P, B) do { sacc = fadd_s(sacc, P[B]); sacc = fadd_s(sacc, P[B + 1]); sacc = fadd_s(sacc, P[B + 2]); sacc = fadd_s(sacc, P[B + 3]); } while (0)
    fox_init(n0, n1, bpn, m);
    n0 = mfma32(x0, qf[0], n0); FOX_EX4(c0, 0);  x0 = FOX_KF(3); SBAR();
    n1 = mfma32(x1, qf[0], n1); FOX_EX4(c0, 4);  x1 = FOX_KF(4); SBAR();
    n0 = mfma32(x2, qf[1], n0); FOX_EX4(c0, 8);  x2 = FOX_KF(5); SBAR();
    n1 = mfma32(x0, qf[1], n1); FOX_EX4(c0, 12); x0 = FOX_KF(6); SBAR();
    n0 = mfma32(x1, qf[2], n0); FOX_EX4(c1, 0);  x1 = FOX_KF(7); SBAR();
    n1 = mfma32(x2, qf[2], n1); FOX_EX4(c1, 4);  x2 = FOX_VFR(0); SBAR();
    n0 = mfma32(x0, qf[3], n0); FOX_EX4(c1, 8);  x0 = FOX_VFR(1); SBAR();
    n1 = mfma32(x1, qf[3], n1); FOX_EX4(c1, 12); x1 = FOX_VFR(2); SBAR();
    float sacc = fadd_s(c0[0], c0[1]);
    bf16x8 a0 = pack8<0>(c0), a1; SBAR();
#define FOX_MOV4(DST, SRC, B) do { DST[B] = SRC[B]; DST[B + 1] = SRC[B + 1]; DST[B + 2] = SRC[B + 2]; DST[B + 3] = SRC[B + 3]; } while (0)
    o0 = mfma32(a0, x2, o0); sacc = fadd_s(sacc, c0[2]); sacc = fadd_s(sacc, c0[3]); FOX_SUM4(c0, 4); a1 = pack8<1>(c0); x2 = FOX_VFR(3); SBAR();
    o1 = mfma32(a0, x0, o1); FOX_SUM4(c0, 8); FOX_SUM4(c0, 12); x0 = FOX_VFR(4); SBAR();
    o0 = mfma32(a1, x1, o0); a0 = pack8<0>(c1); FOX_MOV4(c0, n0, 0); FOX_MOV4(c0, n0, 4); x1 = FOX_VFR(5); SBAR();
    o1 = mfma32(a1, x2, o1); FOX_SUM4(c1, 0); FOX_SUM4(c1, 4); FOX_MOV4(c0, n0, 8); x2 = FOX_VFR(6); SBAR();
    o0 = mfma32(a0, x0, o0); a1 = pack8<1>(c1); FOX_SUM4(c1, 8); FOX_MOV4(c0, n0, 12); x0 = FOX_VFR(7); SBAR();
    o1 = mfma32(a0, x1, o1); FOX_SUM4(c1, 12); FOX_MOV4(c1, n1, 0); FOX_MOV4(c1, n1, 4); SBAR();
    o0 = mfma32(a1, x2, o0); FOX_MOV4(c1, n1, 8); FOX_MOV4(c1, n1, 12); SBAR();
    o1 = mfma32(a1, x0, o1); SBAR();
#undef FOX_MOV4
    l += sacc;
#undef FOX_KF
#undef FOX_VFR
#undef FOX_EX4
#undef FOX_SUM4
}
struct FoxCtx { int nt, qlim, qlim_min, hh, r; bool active; const LAS uchar *kb0, *vb0; const LAS float* biasl; LAS float* scr; LAS uchar* lds; int kdst, vdst; const bf16 *ksrc, *vsrc; };
DI void fox_ring(const FoxCtx& X, int t, int bwr, u32x4& rk, u32x4& rv) {
    using namespace fox;
    *(LAS u32x4*)(X.lds + X.kdst + bwr * KB) = rk; *(LAS u32x4*)(X.lds + X.vdst + bwr * VB) = rv;
    __syncthreads();
    const int tl = t - 3 > 0 ? t - 3 : 0;
    rk = *(const u32x4*)(X.ksrc + (size_t)64 * tl * D); rv = *(const u32x4*)(X.vsrc + (size_t)64 * tl * D);
}
DI void fox_step(const FoxCtx& X, int s, int bcur, int bnext, int bwr, f32x16& c0, f32x16& c1, f32x16& n0, f32x16& n1, f32x16& o0, f32x16& o1, float& l, float& m,
                 const bf16x8 (&qf)[4], u32x4& rk, u32x4& rv) {
    using namespace fox;
    const int nt = X.nt, t = nt - 1 - s, hh = X.hh;
    {
        const bool vis = 64 * t <= X.qlim_min, visn = 64 * (t - 1) <= X.qlim_min;
        const LAS f32x4* bpn = (const LAS f32x4*)(X.biasl + 64 * (t - 1) + 4 * hh);
        if (vis) {
            const LAS uchar* kbn = X.kb0 + bnext * KB;
            const bf16x8 x0 = ldsv(kbn), x1 = ldsv(kbn + 32 * KPI), x2 = ldsv(kbn + 32);
            if (64 * t + 63 > X.qlim_min) {
#pragma unroll
                for (int i = 0; i < 16; ++i) { const int key = 64 * t + crow(i, hh); if (key > X.qlim) c0[i] = -INFINITY; if (key + 32 > X.qlim) c1[i] = -INFINITY; }
            }
            asm volatile("s_nop 15\n\ts_nop 7" : "+v"(c0), "+v"(c1));
            float mx = max3f(c0[0], c1[0], c0[1]), mx2 = max3f(c1[1], c0[2], c1[2]);
#pragma unroll
            for (int i = 3; i < 15; i += 2) { mx = max3f(mx, c0[i], c1[i]); mx2 = max3f(mx2, c0[i + 1], c1[i + 1]); }
            mx = max3f(mx, c0[15], c1[15]); mx = max3f(mx, mx2, mx2);
            { auto rr = __builtin_amdgcn_permlane32_swap(__float_as_uint(mx), __float_as_uint(mx), false, false); mx = max3f(__uint_as_float(rr[0]), __uint_as_float(rr[1]), __uint_as_float(rr[1])); }
            if (__builtin_expect(__any(mx > 16.f), 0)) {
                const float d = fmaxf(mx, 0.f), f = ex2(-d); m += d; l *= f;
#pragma unroll
                for (int i = 0; i < 16; ++i) { c0[i] -= d; c1[i] -= d; }
                if (hh == 0) X.scr[X.r] = f;
                asm volatile("s_waitcnt lgkmcnt(0)" ::: "memory");
#pragma unroll
                for (int g = 0; g < 4; ++g) { const f32x4 fv = *(const LAS f32x4*)(X.scr + 8 * g + 4 * hh);
#pragma unroll
                    for (int j = 0; j < 4; ++j) { o0[4 * g + j] *= fv[j]; o1[4 * g + j] *= fv[j]; } }
                asm volatile("s_waitcnt lgkmcnt(0)" ::: "memory");
            }
            fox_hot(c0, c1, n0, n1, o0, o1, l, m, kbn, X.vb0 + bcur * VB, bpn, qf, x0, x1, x2);
        } else if (visn) {
            fox_init(n0, n1, bpn, m); fox_qk_plain(n0, n1, X.kb0 + bnext * KB, qf); c0 = n0; c1 = n1;
        }
    }
    fox_ring(X, t, bwr, rk, rv);
}
DI void fox_unit(LAS uchar* lds, const bf16* Qg, const bf16* K2B, const bf16* V2B, bf16* Og, size_t qrow0, int nq, size_t krow0, int nt, int qlim0, int h, const float* biasg) {
    using namespace fox;
    int tid_ = threadIdx.x; asm volatile("" : "+v"(tid_));
    const int tid = tid_, lane = tid & 63, w = __builtin_amdgcn_readfirstlane(tid >> 6), r = lane & 31, hh = lane >> 5;
    const int q4 = (lane & 15) >> 2, p4 = lane & 3, blk = (lane >> 4) & 1;
    FoxCtx X;
    X.nt = nt; X.hh = hh; X.r = r; X.lds = lds;
    X.active = 32 * w < nq;
    __syncthreads();
    const bool bp0 = tid < nt * 16, bp1 = tid + NTHR < nt * 16;
    const f32x4 bias0 = bp0 ? ((const f32x4*)biasg)[tid] : (f32x4){0.f, 0.f, 0.f, 0.f}, bias1 = bp1 ? ((const f32x4*)biasg)[tid + NTHR] : (f32x4){0.f, 0.f, 0.f, 0.f};
    X.ksrc = K2B + (krow0 + (tid >> 3)) * D + h * 64 + (tid & 7) * 8;
    X.vsrc = V2B + (krow0 + (tid >> 3)) * D + h * 64 + (tid & 7) * 8;
    X.kdst = OFF_K + (tid >> 3) * KPI + (tid & 7) * 16; X.vdst = OFF_V + (tid >> 3) * VPI + (tid & 7) * 16;
    u32x4 rk = *(const u32x4*)(X.ksrc + (size_t)64 * (nt - 1) * D), rv = *(const u32x4*)(X.vsrc + (size_t)64 * (nt - 1) * D);
    u32x4 rk1 = rk, rv1 = rv;
    if (nt > 1) { rk1 = *(const u32x4*)(X.ksrc + (size_t)64 * (nt - 2) * D); rv1 = *(const u32x4*)(X.vsrc + (size_t)64 * (nt - 2) * D); }
    bf16x8 qf[4];
    {
        const bf16* qp = Qg + (qrow0 + (X.active ? 32 * w + r : 0)) * D + h * 64 + hh * 8;
#pragma unroll
        for (int kk = 0; kk < 4; ++kk) qf[kk] = *(const bf16x8*)(qp + kk * 16);
    }
    if (bp0) *(LAS f32x4*)(lds + OFF_BIAS + tid * 16) = bias0;
    if (bp1) *(LAS f32x4*)(lds + OFF_BIAS + (tid + NTHR) * 16) = bias1;
    *(LAS u32x4*)(lds + X.kdst) = rk; *(LAS u32x4*)(lds + X.vdst) = rv;
    *(LAS u32x4*)(lds + X.kdst + KB) = rk1; *(LAS u32x4*)(lds + X.vdst + VB) = rv1;
    { const int tl = nt > 2 ? nt - 3 : 0; rk = *(const u32x4*)(X.ksrc + (size_t)64 * tl * D); rv = *(const u32x4*)(X.vsrc + (size_t)64 * tl * D); }
    float l = 0.f; f32x16 o0, o1;
#pragma unroll
    for (int i = 0; i < 16; ++i) { o0[i] = 0.f; o1[i] = 0.f; }
    X.qlim = X.active ? qlim0 + 32 * w + r : 0; X.qlim_min = qlim0 + 32 * w;
    X.scr = (LAS float*)(lds + OFF_SCR + w * 256);
    X.kb0 = lds + OFF_K + r * KPI + hh * 16;
    X.vb0 = lds + OFF_V + (4 * hh + q4) * VPI + (16 * blk + 4 * p4) * 2;
    X.biasl = (const LAS float*)(lds + OFF_BIAS);
    __syncthreads();
    float m = X.biasl[X.qlim];
    f32x16 pa0, pa1, pb0, pb1;
#pragma unroll
    for (int i = 0; i < 16; ++i) { pa0[i] = 0.f; pa1[i] = 0.f; pb0[i] = 0.f; pb1[i] = 0.f; }
    if (X.active && 64 * (nt - 1) <= X.qlim_min) { fox_init(pa0, pa1, (const LAS f32x4*)(X.biasl + 64 * (nt - 1) + 4 * hh), m); fox_qk_plain(pa0, pa1, X.kb0, qf); }
    int b0 = 0, b1 = 1, b2 = 2;
    if (w >= 4) __builtin_amdgcn_s_setprio(1);
    if (X.active) {
#pragma unroll 1
        for (int s = 0; s < nt; ++s) {
            fox_step(X, s, b0, b1, b2, pa0, pa1, pb0, pb1, o0, o1, l, m, qf, rk, rv);
            { const int tb = b0; b0 = b1; b1 = b2; b2 = tb; }
        }
    } else {
#pragma unroll 1
        for (int s = 0; s < nt; ++s) { fox_ring(X, nt - 1 - s, b2, rk, rv); { const int tb = b0; b0 = b1; b1 = b2; b2 = tb; } }
    }
    __builtin_amdgcn_s_setprio(0);
    if (X.active) {
        l += __shfl_xor(l, 32);
        if (hh == 0) X.scr[32 + r] = l;
        asm volatile("s_waitcnt lgkmcnt(0)" ::: "memory");
        bf16* op = Og + (qrow0 + 32 * w) * D + h * 64 + r;
#pragma unroll
        for (int g = 0; g < 4; ++g) { const f32x4 lv = *(const LAS f32x4*)(X.scr + 32 + 8 * g + 4 * hh);
#pragma unroll
            for (int j = 0; j < 4; ++j) { const float inv = 1.0f / lv[j]; const int c = 8 * g + 4 * hh + j;
                op[(size_t)c * D] = (bf16)(pk(o0[4 * g + j] * inv, 0.f) & 0xffffu); op[(size_t)c * D + 32] = (bf16)(pk(o1[4 * g + j] * inv, 0.f) & 0xffffu); } }
    }
}

#define XB_TMO      128
#define XB_XCNT(j)  (256  + 64 * (j))
#define XB_XSUB(j)  (1280 + 64 * (j))
#define XB_XGEN(j)  (2304 + 64 * (j))
#define XB_TOP      3328
#define XB_TOPGEN   3392
#define XCD_BAR_WORDS 3456
#define XB_SPIN_CAP (1u << 18)

__device__ __forceinline__ unsigned xb_ld(unsigned* p)              { return __hip_atomic_load(p, __ATOMIC_RELAXED, __HIP_MEMORY_SCOPE_AGENT); }
__device__ __forceinline__ unsigned xb_add(unsigned* p, unsigned v) { return __hip_atomic_fetch_add(p, v, __ATOMIC_RELAXED, __HIP_MEMORY_SCOPE_AGENT); }
__device__ __forceinline__ unsigned xb_xcc_id() { return (unsigned)__builtin_amdgcn_s_getreg((3 << 11) | 20) & 0xFu; }
#define XB_SPIN(cond, bar) do { unsigned _sp = 0; while (cond) { __builtin_amdgcn_s_sleep(1); \
    if ((++_sp & 255u) == 0u) { if (xb_ld(&(bar)[XB_TMO])) break; if (_sp > XB_SPIN_CAP) { atomicAdd(&(bar)[XB_TMO], 1u); break; } } } } while (0)

struct XcdBarrier {
    unsigned* bar; unsigned x;
    volatile LAS unsigned* st;
};

__device__ __forceinline__ XcdBarrier xcd_barrier_post(unsigned* bar, volatile LAS unsigned* st) {
    XcdBarrier b; b.bar = bar; b.x = xb_xcc_id(); b.st = st;
    if (threadIdx.x == 0) (void)xb_add(&bar[XB_XCNT(b.x)], 1u);
    return b;
}
__device__ __forceinline__ void xcd_barrier_complete(unsigned* bar, unsigned x, unsigned& nloc, unsigned& nx) {
    const unsigned G = gridDim.x * gridDim.y * gridDim.z;
    unsigned sum, cnt, mine, sp = 0u;
    for (;;) {
        sum = 0u; cnt = 0u; mine = 0u;
#pragma unroll
        for (unsigned j = 0; j < 16; ++j) { const unsigned c = xb_ld(&bar[XB_XCNT(j)]); sum += c; cnt += (c > 0u) ? 1u : 0u; mine = (j == x) ? c : mine; }
        if (sum == G) break;
        __builtin_amdgcn_s_sleep(1);
        if ((++sp & 255u) == 0u) { if (xb_ld(&bar[XB_TMO])) break; if (sp > XB_SPIN_CAP) { atomicAdd(&bar[XB_TMO], 1u); break; } }
    }
    nloc = mine > 0u ? mine : 1u; nx = cnt > 0u ? cnt : 1u;
}

__device__ __forceinline__ void xcd_barrier(const XcdBarrier& b) {
    asm volatile("s_waitcnt vmcnt(0)" ::: "memory");
    __syncthreads();
    if (threadIdx.x == 0) {
        unsigned* bar = b.bar;
        __builtin_amdgcn_s_waitcnt(0);
        unsigned nloc = b.st[0], nx = b.st[1];
        if (nloc == 0u) { xcd_barrier_complete(bar, b.x, nloc, nx); b.st[0] = nloc; b.st[1] = nx; }
        const unsigned old = xb_add(&bar[XB_XSUB(b.x)], 1u);
        const unsigned gen = old / nloc;
        if (old + 1u == (gen + 1u) * nloc) {
            __builtin_amdgcn_fence(__ATOMIC_RELEASE, "agent");
            asm volatile("s_waitcnt vmcnt(0)" ::: "memory");
            const unsigned og = xb_add(&bar[XB_TOP], 1u);
            const unsigned tg = og / nx;
            if (og + 1u == (tg + 1u) * nx) xb_add(&bar[XB_TOPGEN], 1u);
            else XB_SPIN(xb_ld(&bar[XB_TOPGEN]) == tg, bar);
            __builtin_amdgcn_fence(__ATOMIC_ACQUIRE, "agent");
            xb_add(&bar[XB_XGEN(b.x)], 1u);
            asm volatile("s_waitcnt vmcnt(0)" ::: "memory");
        } else {
            XB_SPIN(xb_ld(&bar[XB_XGEN(b.x)]) == gen, bar);
            __builtin_amdgcn_fence(__ATOMIC_ACQUIRE, "agent");
            asm volatile("s_waitcnt vmcnt(0)" ::: "memory");
        }
    }
    __syncthreads();
}

constexpr int XB_WS_OFF = 65536, XB_LDS_OFF = LDS_BYTES - 64, CTL_ZERO_BYTES = 262144;

template <int ONLY> __global__ void __launch_bounds__(NTHR, 2) yoco_fwd_t(Params P) {
    extern __shared__ __attribute__((aligned(16))) unsigned char lds_raw[];
    LAS uchar* lds = (LAS uchar*)lds_raw;
    if (threadIdx.x < 16) ((LAS unsigned*)(lds + XB_LDS_OFF))[threadIdx.x] = 0u;
    __syncthreads();
    if (P.ph_hi - P.ph_lo > 1) (void)xcd_barrier_post((unsigned*)(P.ws + XB_WS_OFF), (volatile LAS unsigned*)(lds + XB_LDS_OFF));
    if (P.ph_lo == 0) {
        const int lane0 = threadIdx.x & 63, wave0 = threadIdx.x >> 6;
        rope_table(P.ws, blockIdx.x * NWAVES + wave0, gridDim.x * NWAVES, lane0);
    }
    for (int step = P.ph_lo; step < P.ph_hi; ++step) {
        const int ph = P.prog[step];
        int tid_ = threadIdx.x; asm volatile("" : "+v"(tid_));
        const int tid = tid_;
#define LWG() const int lane = tid & 63, wave = __builtin_amdgcn_readfirstlane(tid >> 6); const int gw = bx * NWAVES + wave, NGW = G * NWAVES; (void)lane; (void)gw; (void)NGW
        int G_ = gridDim.x, bx_ = blockIdx.x; asm volatile("" : "+s"(G_), "+s"(bx_));
        const int G = G_, bx = bx_;
        uchar* ws = P.ws; float* out = P.out; int zz = 0;
        asm volatile("" : "+s"(ws), "+s"(out), "+s"(zz));
#define PIN(i) (P.in[(i) + zz])
        float* H = out + O_Y; bf16* HB = (bf16*)(ws + WS_HB); float* ssq = (float*)(ws + WS_SSQ);
        bf16* HID = (bf16*)(ws + WS_R + R_HID);
        bf16* RQ = (bf16*)(out + O_KP); bf16* RK = RQ + (size_t)T * D;
        bf16* VO = (bf16*)(ws + WS_R + R_VO); bf16* GG = (bf16*)(ws + WS_R + R_G);
        bf16* QF = (bf16*)(ws + WS_R + R_QF); bf16* K2B = (bf16*)(ws + WS_R + R_K2B); bf16* V2B = (bf16*)(ws + WS_R + R_V2B);
        float* biasP = (float*)(ws + WS_BIASP); float* biasS = (float*)(ws + WS_BIASS);
        const float* rope = (const float*)(ws + WS_ROPE);
        int kind, f = 0;
        switch (ph) {
            case 0: kind = 0; break;
            case 1: kind = 1; f = 0; break;   case 2: kind = 2; f = 0; break;
            case 3: kind = 3; break;          case 4: kind = 4; break;        case 5: kind = 5; break;
            case 6: kind = 2; f = 4; break;
            case 7: kind = 1; f = 1; break;   case 8: kind = 2; f = 1; break;
            case 9: kind = 6; break;          case 10: kind = 7; break;
            case 11: kind = 1; f = 2; break;  case 12: kind = 2; f = 2; break;
            case 13: kind = 8; break;         case 14: kind = 9; break;
            case 15: kind = 2; f = 5; break;
            case 16: kind = 1; f = 3; break;  case 17: kind = 2; f = 3; break;
            case 20: kind = 11; break;
            case 19: kind = 2; f = 8; break;
            default: kind = 10; break;
        }
        if (KSEL(0) && kind == 0) {
            LWG();
            phase_prologue(P, ws, out, lds, gw, NGW, wave, lane);
        } else if (KSEL(1) && kind == 1) {
            pg8::Gemm g{HB, (const bf16*)(ws + WS_WIN + f * SZ_WIN), T, 2 * FF, D}; pg8::StaticOrder S; S.init(T, 2 * FF, G, bx);
            rstd_prepass(lds, ssq, S, tid); pg8::EpiSwiGLU E{HID, (const LAS float*)(lds + RL_OFF)};
            pg8::gemm_phase<pg8::EpiSwiGLU, pg8::StaticOrder, true, true>(lds, g, S, E);
        } else if (KSEL(2) && kind == 2) {
            const bf16* A; const bf16* Bt; int K; float alpha;
            if (f == 8) { A = HID; Bt = (const bf16*)(ws + WS_WOUT); K = FF; alpha = 0.0f; }
            else if (f < 4) { A = HID; Bt = (const bf16*)(ws + WS_WOUT + f * SZ_WOUT); K = FF; alpha = 0.5f; }
            else if (f == 4) { A = VO; Bt = (const bf16*)(ws + WS_ROUT); K = 2048; alpha = 1.0f; }
            else { A = QF; Bt = (const bf16*)(ws + WS_WO); K = D; alpha = 1.0f; }
            pg8::Gemm g{A, Bt, T, D, K}; pg8::StaticOrder S; S.init(T, D, G, bx);
            pg8::EpiRes E{HB, ssq, alpha};
            pg8::gemm_phase<pg8::EpiRes, pg8::StaticOrder, true, true>(lds, g, S, E);
        } else if (KSEL(3) && kind == 3) {
            pg8::Gemm g{HB, (const bf16*)(ws + WS_RIN), T, 6144, D}; pg8::StaticOrder S; S.init(T, 6144, G, bx);
            rstd_prepass(lds, ssq, S, tid); pg8::EpiRetIn E{RQ, RK, VO, GG, (const LAS float*)(lds + RL_OFF), rope};
            pg8::gemm_phase<pg8::EpiRetIn, pg8::StaticOrder, true, true>(lds, g, S, E);
        } else if (KSEL(4) && kind == 4) {
            for (int it = bx; it < 256 + 512; it += G) {
                const bool samp = it >= 256; const int q = samp ? it - 256 : it;
                const int sl = q & 3, h = (q >> 2) & 3, b = q >> 4;
                const float lg2 = h == 0 ? -0.04580368961312479f : h == 1 ? -0.02272007650008353f : h == 2 ? -0.011315313227834146f : -0.005646563141142063f;
                const size_t rowbase = samp ? (size_t)TP + (size_t)b * DSEQ : (size_t)b * SEQ;
                const float* S0 = samp ? PIN(2) + (size_t)(b * 4 + h) * 256 * 512 : nullptr;
                float* Sout = out + (samp ? O_SRS : O_SRP) + (size_t)(b * 4 + h) * 256 * 512;
                ret_item(lds, RQ, RK, VO, rowbase, h, sl, samp ? 1 : 64, S0, Sout, lg2);
            }
        } else if (KSEL(5) && kind == 5) {
            LWG();
            const float* gn = PIN(14); (void)gn;
            constexpr int NR = 4;
            for (int row0 = gw; row0 < T; row0 += NR * NGW) {
                u32x4 ov[NR][4], gv[NR][4];
#pragma unroll
                for (int u = 0; u < NR; ++u) { const int row = row0 + u * NGW < T ? row0 + u * NGW : row0;
                    const u32x4* op = (const u32x4*)(VO + (size_t)row * 2048 + lane * 32); const u32x4* gp = (const u32x4*)(GG + (size_t)row * 2048 + lane * 32);
#pragma unroll
                    for (int i = 0; i < 4; ++i) { ov[u][i] = op[i]; gv[u][i] = gp[i]; } }
#pragma unroll
                for (int u = 0; u < NR; ++u) {
                    const int row = row0 + u * NGW; if (row >= T) break;
                    float s = 0.f, s2 = 0.f;
#pragma unroll
                    for (int i = 0; i < 4; ++i)
#pragma unroll
                        for (int j = 0; j < 4; ++j) { const float a = bflo(ov[u][i][j]), bq = bfhi(ov[u][i][j]); s += a + bq; s2 += a * a + bq * bq; }
#pragma unroll
                    for (int o = 1; o < 16; o <<= 1) { s += __shfl_xor(s, o); s2 += __shfl_xor(s2, o); }
                    const float mu = s * (1.f / 512.f), var = fmaxf(s2 * (1.f / 512.f) - mu * mu, 0.f), rstd = __builtin_amdgcn_rsqf(var + EPS);
                    u32x4* op = (u32x4*)(VO + (size_t)row * 2048 + lane * 32);
#pragma unroll
                    for (int i = 0; i < 4; ++i) { u32x4 w;
#pragma unroll
                        for (int j = 0; j < 4; ++j) w[j] = pk((bflo(ov[u][i][j]) - mu) * rstd * bflo(gv[u][i][j]), (bfhi(ov[u][i][j]) - mu) * rstd * bfhi(gv[u][i][j]));
                        op[i] = w; }
                }
            }
        } else if (KSEL(6) && kind == 6) {
            pg8::Gemm g{HB, (const bf16*)(ws + WS_KVF), T, 2304, D}; pg8::StaticOrder S; S.init(T, 2304, G, bx);
            rstd_prepass(lds, ssq, S, tid); pg8::EpiKVF E{out, K2B, V2B, (const LAS float*)(lds + RL_OFF), PIN(18)};
            pg8::gemm_phase<pg8::EpiKVF, pg8::StaticOrder, true, true>(lds, g, S, E);
        } else if (KSEL(7) && kind == 7) {
            LWG();
            {
                const int gt = gw * 64 + lane, NGT = NGW * 64;
                constexpr int NPIECE = NB_S * PAST * D / 8; const float* in3 = PIN(3); const float* in4 = PIN(4);
                for (int p0 = gt; p0 < 2 * NPIECE; p0 += 4 * NGT) {
                    f32x4 a[4], bq[4];
#pragma unroll
                    for (int u = 0; u < 4; ++u) { const int p = p0 + u * NGT < 2 * NPIECE ? p0 + u * NGT : p0; const bool isv = p >= NPIECE; const int q = isv ? p - NPIECE : p;
                        const float* src = (isv ? in4 : in3) + (size_t)(q >> 7) * D + (q & 127) * 8; a[u] = *(const f32x4*)src; bq[u] = *(const f32x4*)(src + 4); }
#pragma unroll
                    for (int u = 0; u < 4; ++u) { const int p = p0 + u * NGT; if (p >= 2 * NPIECE) break; const bool isv = p >= NPIECE; const int q = isv ? p - NPIECE : p;
                        const int row = q >> 7, c8 = q & 127; const int b_ = row >> 10, s = row & 1023;
                        u32x4 w; w[0] = pk(a[u][0], a[u][1]); w[1] = pk(a[u][2], a[u][3]); w[2] = pk(bq[u][0], bq[u][1]); w[3] = pk(bq[u][2], bq[u][3]);
                        *(u32x4*)((isv ? V2B : K2B) + ((size_t)TP + (size_t)b_ * KSAMP + s) * D + c8 * 8) = w; }
                }
            }

            for (int seq = bx; seq < 768; seq += G) {
                const bool samp = seq >= 256; const int ss = samp ? seq - 256 : seq; const int b_ = ss >> 4, h = ss & 15;
                const int L = samp ? KSAMP : SEQ, n = samp ? 3 : 8, s0 = tid * n;
                float* dst = samp ? biasS + (size_t)ss * KSAMP : biasP + (size_t)ss * SEQ;
                float v[8]; float sum = 0.f;
#pragma unroll
                for (int i = 0; i < 8; ++i) { const int s = s0 + i; float x = 0.f;
                    if (i < n && s < L) x = samp ? (s < PAST ? PIN(5)[((size_t)b_ * PAST + s) * 16 + h] : out[O_LFS + ((size_t)b_ * DSEQ + (s - PAST)) * 16 + h]) : out[O_LFP + ((size_t)b_ * SEQ + s) * 16 + h];
                    sum += x; v[i] = sum; }
                float inc = sum;
#pragma unroll
                for (int o = 1; o < 64; o <<= 1) { const float t = __shfl_up(inc, o); if (lane >= o) inc += t; }
                LAS float* wt = (LAS float*)lds;
                __syncthreads();
                if (lane == 63) wt[wave] = inc;
                __syncthreads();
                float base = inc - sum;
#pragma unroll
                for (int w2 = 0; w2 < 8; ++w2) if (w2 < wave) base += wt[w2];
#pragma unroll
                for (int i = 0; i < 8; ++i) { const int s = s0 + i; if (i < n && s < L) dst[s] = -(base + v[i]) * LOG2E; }
            }
        } else if (KSEL(8) && kind == 8) {
            pg8::Gemm g{HB, (const bf16*)(ws + WS_WQ), T, D, D}; pg8::StaticOrder S; S.init(T, D, G, bx);
            rstd_prepass(lds, ssq, S, tid); pg8::EpiQ E{QF, (const LAS float*)(lds + RL_OFF)};
            pg8::gemm_phase<pg8::EpiQ, pg8::StaticOrder, true, true>(lds, g, S, E);
        } else if (KSEL(9) && kind == 9) {
            for (int u = bx; u < 4096 + 512; u += G) {
                const bool samp = u >= 4096; const int us = u - 4096;
                int bh = samp ? us : (u & 255), qb = 15 - (u >> 8);
                if (!samp && G == 256) {
                    const int k = u >> 8, xcd = bx & 7, idx = bx >> 3, g = idx >> 2, mem = idx & 3, rr = k >> 2, kk = k & 3;
                    bh = xcd * 32 + rr * 8 + g; qb = kk == 0 ? 15 - mem : kk == 1 ? 11 - mem : kk == 2 ? mem + 4 : mem;
                }
                const int b_ = bh >> 4, h = bh & 15;
                const size_t qrow0 = samp ? (size_t)TP + b_ * DSEQ : (size_t)b_ * SEQ + qb * 256;
                const size_t krow0 = samp ? (size_t)TP + (size_t)b_ * KSAMP : (size_t)b_ * SEQ;
                fox_unit(lds, QF, K2B, V2B, QF, qrow0, samp ? 64 : 256, krow0, samp ? 17 : 4 * (qb + 1), samp ? PAST : qb * 256, h,
                         samp ? biasS + (size_t)us * KSAMP : biasP + (size_t)bh * SEQ);
            }
        } else if (KSEL(10) && kind == 10) {
            LWG();
            const float* fg = PIN(21);
            constexpr int NR = 4;
            for (int row0 = gw; row0 < T; row0 += NR * NGW) {
                u32x2 hv[NR][4]; float rsv[NR];
#pragma unroll
                for (int u = 0; u < NR; ++u) { const int row = row0 + u * NGW < T ? row0 + u * NGW : row0; const u32x2* bp = (const u32x2*)(HB + (size_t)row * D);
#pragma unroll
                    for (int j = 0; j < 4; ++j) hv[u][j] = bp[lane + 64 * j];
                    rsv[u] = row_rstd(ssq, row); }
#pragma unroll
                for (int u = 0; u < NR; ++u) {
                    const int row = row0 + u * NGW; if (row >= T) break;
                    f32x4* hp = (f32x4*)(H + (size_t)row * D); const float rs = rsv[u];
#pragma unroll
                    for (int j = 0; j < 4; ++j) { const u32x2 x = hv[u][j]; const f32x4 v = {bflo(x[0]), bfhi(x[0]), bflo(x[1]), bfhi(x[1])}, gq = ((const f32x4*)fg)[lane + 64 * j]; hp[lane + 64 * j] = v * rs * gq; }
                }
            }
        }
        if (step + 1 < P.ph_hi) { if (P.ph_lo < 0) cg::this_grid().sync(); else { XcdBarrier xb; xb.bar = (unsigned*)(ws + XB_WS_OFF); xb.x = xb_xcc_id(); xb.st = (volatile LAS unsigned*)(lds + XB_LDS_OFF); xcd_barrier(xb); } }
    }
}

#ifdef DIAG
template __global__ void yoco_fwd_t<0>(Params); template __global__ void yoco_fwd_t<1>(Params); template __global__ void yoco_fwd_t<2>(Params); template __global__ void yoco_fwd_t<3>(Params);
template __global__ void yoco_fwd_t<4>(Params); template __global__ void yoco_fwd_t<5>(Params); template __global__ void yoco_fwd_t<6>(Params); template __global__ void yoco_fwd_t<7>(Params);
template __global__ void yoco_fwd_t<8>(Params); template __global__ void yoco_fwd_t<9>(Params); template __global__ void yoco_fwd_t<10>(Params);
#endif
#define yoco_fwd yoco_fwd_t<-1>
#ifndef MK_ONE_LAUNCH
#define MK_ONE_LAUNCH 1
#endif
constexpr int N_PHASES = 19;
extern "C" void kernel_launch(void* const* d_in, const int* in_sizes, int n_in, void* d_out, int out_size, void* d_ws, size_t ws_size, hipStream_t stream) {
    static int grid = 0;
    if (grid == 0) {
        if (n_in != 22 || ws_size < WS_END) { fprintf(stderr, "kernel_launch: unexpected n_in %d / ws %zu\n", n_in, ws_size); grid = -1; return; }
        int dev = 0, cus = 0, per_cu = 0;
        hipGetDevice(&dev); hipDeviceGetAttribute(&cus, hipDeviceAttributeMultiprocessorCount, dev);
        if (hipFuncSetAttribute((const void*)yoco_fwd, hipFuncAttributeMaxDynamicSharedMemorySize, LDS_BYTES) != hipSuccess) { fprintf(stderr, "kernel_launch: hipFuncSetAttribute failed\n"); grid = -1; return; }
        if (hipOccupancyMaxActiveBlocksPerMultiprocessor(&per_cu, (const void*)yoco_fwd, NTHR, LDS_BYTES) != hipSuccess || per_cu < 1) { fprintf(stderr, "kernel_launch: occupancy query says %d\n", per_cu); per_cu = 1; }
        (void)hipGetLastError();
        grid = cus * 1;
    }
    if (grid < 0) return;
    Params p{};
    for (int i = 0; i < 22; ++i) p.in[i] = (const float*)d_in[i];
    p.out = (float*)d_out; p.ws = (unsigned char*)d_ws;
#ifndef MK_PROG
#define MK_PROG 0,1,2,3,4,5,6,7,8,9,10,11,12,13,14,15,16,17,18
#endif
    const unsigned char prog[] = {MK_PROG}; const int nprog = (int)sizeof(prog);
    for (int i = 0; i < nprog && i < 32; ++i) p.prog[i] = prog[i];
#if MK_ONE_LAUNCH
    if (hipMemsetAsync(d_ws, 0, CTL_ZERO_BYTES, stream) != hipSuccess) { fprintf(stderr, "kernel_launch: hipMemsetAsync failed\n"); return; }
    p.ph_lo = 0; p.ph_hi = nprog;
    void* args[] = {&p};
    hipError_t e = hipLaunchCooperativeKernel((const void*)yoco_fwd, dim3(grid), dim3(NTHR), args, LDS_BYTES, stream);
    if (e != hipSuccess) fprintf(stderr, "cooperative launch failed: %s (grid %d)\n", hipGetErrorString(e), grid);
#else
    for (int ph = 0; ph < nprog; ++ph) { p.ph_lo = ph; p.ph_hi = ph + 1; hipLaunchKernelGGL(yoco_fwd, dim3(grid), dim3(NTHR), LDS_BYTES, stream, p); }
#endif
}
```

```cpp
#include <hip/hip_runtime.h>
#include <cstdio>
#include <cstdint>
namespace pg8 {
#define PG8_LAS __attribute__((address_space(3)))
typedef unsigned short bf16_t;
typedef short bf16x8 __attribute__((ext_vector_type(8)));
typedef float f32x4 __attribute__((ext_vector_type(4)));
typedef unsigned u32x4 __attribute__((ext_vector_type(4)));
constexpr int BM = 256, BK = 64, HALF = 128, HTB = HALF * BK * 2  , STAGE_BYTES = 8 * HTB, NXCD = 8, WGM = 8;

__host__ __device__ __forceinline__ int lds_byte(int r, int c) { const int st = (r >> 4) * 2 + (c >> 5), rr = r & 15, cc = c & 31, ob = rr * 64 + cc * 2; return st * 1024 + (ob ^ (((ob >> 9) & 1) << 5)); }
__host__ __device__ __forceinline__ void stage_rc(int b, int& R, int& C) { const int st = b / 1024, sb = b % 1024, swz = sb ^ (((sb >> 9) & 1) << 5); R = (st >> 1) * 16 + swz / 64; C = (st & 1) * 32 + (swz % 64) / 2; }
__host__ __device__ __forceinline__ int perm32(int rho) { const int n = rho >> 4, i = rho & 15; return 8 * (i >> 2) + 4 * n + (i & 3); }

struct Unit { int pm, pn; };
struct Gemm { const bf16_t* A; const bf16_t* Bt; int M, N, K; };

struct StaticOrder {
    int nM, nN, nwg, G, c;
    __host__ __device__ void init(int M, int N, int G_, int c_) { nM = M / BM; nN = N / BM; nwg = nM * nN; G = G_; c = c_; }
    __host__ __device__ bool next(int i, Unit& u) const {
        const long L = (long)i * G + c; if (L >= nwg) return false;
        int wgid = (int)L; { const int q = nwg / NXCD, r = nwg % NXCD, xcd = wgid % NXCD, off = wgid / NXCD; wgid = (xcd < r ? xcd * (q + 1) : r * (q + 1) + (xcd - r) * q) + off; }
        const int nig = WGM * nN, gid = wgid / nig, fm = gid * WGM, gsz = (nM - fm) < WGM ? (nM - fm) : WGM;
        u.pm = fm + ((wgid % nig) % gsz); u.pn = (wgid % nig) / gsz; return true;
    }
    __device__ __forceinline__ void a_ready(const Unit&) const {}
    __device__ __forceinline__ void done(const Unit&) const {}
};

__device__ __forceinline__ unsigned cvt_pk_bf16(float lo, float hi) { unsigned r; asm volatile("v_cvt_pk_bf16_f32 %0, %1, %2" : "=v"(r) : "v"(lo), "v"(hi)); return r; }
typedef float f32x2 __attribute__((ext_vector_type(2)));
template <class Epi, class Sched, bool ALIGN_EPI = false, bool SP2 = false>
__device__ __forceinline__ void gemm_phase(PG8_LAS unsigned char* lds, const Gemm g, const Sched& S, const Epi& E) {
    int tid_ = threadIdx.x; asm volatile("" : "+v"(tid_));
    const int tid = tid_, wid = __builtin_amdgcn_readfirstlane(tid >> 6), lane = tid & 63, wr = wid >> 2, wc = wid & 3, fr = lane & 15, fq = lane >> 4;
    const int K = g.K, nt = K / BK;
    unsigned voffA[2], voffB[2];
#pragma unroll
    for (int i = 0; i < 2; ++i) { int R, C; stage_rc(tid * 16 + i * 8192, R, C); const int Rb = Epi::PERM ? ((R & ~31) + perm32(R & 31)) : R;
        voffA[i] = (unsigned)(R * K + C) * 2u; voffB[i] = (unsigned)(Rb * K + C) * 2u; }
    const size_t kstep = (size_t)(BK * 2);
    const size_t hstep = (size_t)HALF * K * 2;
    const size_t tstep = 2 * hstep;
    const unsigned ldsw = (unsigned)wid * 1024u;
    const int aoff = lds_byte(wr * 64 + fr, fq * 8), boff = lds_byte(wc * 32 + fr, fq * 8);
#define PG8_SA(b, h) (((b) * 2 + (h)) * HTB)
#define PG8_SB(b, h) ((4 + (b) * 2 + (h)) * HTB)
#define PG8_STAGE(bufoff, gbase, voff) do { _Pragma("unroll") for (int _i = 0; _i < 2; ++_i) \
        __builtin_amdgcn_global_load_lds((const unsigned*)((const char*)(gbase) + (voff)[_i]), (PG8_LAS unsigned*)(lds + (bufoff) + ldsw + _i * 8192), 16, 0, 0); } while (0)
#define PG8_LDA(dst, b, h) do { _Pragma("unroll") for (int m = 0; m < 4; ++m) _Pragma("unroll") for (int k = 0; k < 2; ++k) dst[m][k] = *(const PG8_LAS bf16x8*)(lds + PG8_SA(b, h) + aoff + m * 2048 + k * 1024); } while (0)
#define PG8_LDB(dst, b, h) do { _Pragma("unroll") for (int n = 0; n < 2; ++n) _Pragma("unroll") for (int k = 0; k < 2; ++k) dst[n][k] = *(const PG8_LAS bf16x8*)(lds + PG8_SB(b, h) + boff + n * 2048 + k * 1024); } while (0)
#define PG8_MMA(ai, bj, At, Bt) do { __builtin_amdgcn_s_setprio(1); _Pragma("unroll") for (int m = 0; m < 4; ++m) _Pragma("unroll") for (int n = 0; n < 2; ++n) _Pragma("unroll") for (int k = 0; k < 2; ++k) \
        acc[ai][bj][m][n] = __builtin_amdgcn_mfma_f32_16x16x32_bf16(Bt[n][k], At[m][k], acc[ai][bj][m][n], 0, 0, 0); __builtin_amdgcn_s_setprio(0); } while (0)
#define PG8_WAIT_V(n) asm volatile("s_waitcnt vmcnt(" #n ")" ::: "memory")
#define PG8_WAIT_L(n) asm volatile("s_waitcnt lgkmcnt(" #n ")" ::: "memory")
#define PG8_BAR __builtin_amdgcn_s_barrier()
#define PG8_SCHED __builtin_amdgcn_sched_barrier(0)
    Unit cur, nxt; int ui = 0;
    if (!S.next(0, cur)) return;
    f32x4 acc[2][2][4][2];
#pragma unroll
    for (int a = 0; a < 2; ++a)
#pragma unroll
        for (int b = 0; b < 2; ++b)
#pragma unroll
            for (int m = 0; m < 4; ++m)
#pragma unroll
                for (int n = 0; n < 2; ++n) acc[a][b][m][n] = (f32x4){0.f, 0.f, 0.f, 0.f};
    bf16x8 At[4][2], B0[2][2], B1[2][2];
    const char* cA = (const char*)g.A + (size_t)cur.pm * tstep; const char* cB = (const char*)g.Bt + (size_t)cur.pn * tstep;
    S.a_ready(cur);
    if constexpr (SP2) {
        PG8_STAGE(PG8_SB(0, 0), cB, voffB); PG8_STAGE(PG8_SB(0, 1), cB + hstep, voffB); PG8_STAGE(PG8_SA(0, 0), cA, voffA); PG8_STAGE(PG8_SA(0, 1), cA + hstep, voffA);
        if (wr == 1) PG8_BAR;
        PG8_WAIT_V(2); PG8_BAR;
        PG8_STAGE(PG8_SB(1, 0), cB + kstep, voffB); PG8_STAGE(PG8_SA(1, 0), cA + kstep, voffA); PG8_STAGE(PG8_SB(1, 1), cB + hstep + kstep, voffB);
        PG8_WAIT_V(6); PG8_BAR;
    } else {
        PG8_STAGE(PG8_SB(0, 0), cB, voffB); PG8_STAGE(PG8_SA(0, 0), cA, voffA); PG8_STAGE(PG8_SB(0, 1), cB + hstep, voffB); PG8_STAGE(PG8_SA(0, 1), cA + hstep, voffA);
        if (wr == 1) PG8_BAR;
        PG8_WAIT_V(4); PG8_BAR;
        PG8_STAGE(PG8_SB(1, 0), cB + kstep, voffB); PG8_STAGE(PG8_SA(1, 0), cA + kstep, voffA); PG8_STAGE(PG8_SB(1, 1), cB + hstep + kstep, voffB);
        PG8_WAIT_V(6); PG8_BAR;
    }
    for (;;) {
        const bool has_next = S.next(ui + 1, nxt);
        const char* nA = has_next ? (const char*)g.A + (size_t)nxt.pm * tstep : cA; const char* nB = has_next ? (const char*)g.Bt + (size_t)nxt.pn * tstep : cB;
        for (int t = 0; t < nt; t += 2) {
            const bool last = (t == nt - 2);
            const char* a1 = cA + (size_t)(t + 1) * kstep;
            const char* a2 = last ? nA : cA + (size_t)(t + 2) * kstep; const char* b2 = last ? nB : cB + (size_t)(t + 2) * kstep;
            const char* a3 = a2 + kstep; const char* b3 = b2 + kstep;
            if (last && has_next) S.a_ready(nxt);
            if constexpr (SP2) {
            PG8_LDB(B0, 0, 0); PG8_LDB(B1, 0, 1); PG8_SCHED; PG8_LDA(At, 0, 0); PG8_STAGE(PG8_SA(1, 1), a1 + hstep, voffA);
            PG8_WAIT_V(8); PG8_WAIT_L(0); PG8_BAR; PG8_MMA(0, 0, At, B0); PG8_MMA(0, 1, At, B1); PG8_BAR; PG8_SCHED;
            PG8_LDA(At, 0, 1); PG8_STAGE(PG8_SB(0, 0), b2, voffB); PG8_STAGE(PG8_SB(0, 1), b2 + hstep, voffB); PG8_STAGE(PG8_SA(0, 0), a2, voffA);
            PG8_WAIT_V(8); PG8_WAIT_L(0); PG8_BAR; PG8_MMA(1, 0, At, B0); PG8_MMA(1, 1, At, B1); PG8_BAR; PG8_SCHED;
            PG8_LDB(B0, 1, 0); PG8_LDB(B1, 1, 1); PG8_SCHED; PG8_LDA(At, 1, 0); PG8_STAGE(PG8_SA(0, 1), a2 + hstep, voffA);
            PG8_WAIT_V(8); PG8_WAIT_L(0); PG8_BAR; PG8_MMA(0, 0, At, B0); PG8_MMA(0, 1, At, B1); PG8_BAR; PG8_SCHED;
            PG8_LDA(At, 1, 1); PG8_STAGE(PG8_SB(1, 0), b3, voffB); PG8_STAGE(PG8_SB(1, 1), b3 + hstep, voffB); PG8_STAGE(PG8_SA(1, 0), a3, voffA);
            PG8_WAIT_V(8); PG8_WAIT_L(0); PG8_BAR; PG8_MMA(1, 0, At, B0); PG8_MMA(1, 1, At, B1); PG8_BAR; PG8_SCHED;
            } else {
            PG8_LDB(B0, 0, 0); PG8_SCHED; PG8_LDA(At, 0, 0); PG8_STAGE(PG8_SA(1, 1), a1 + hstep, voffA);
            PG8_WAIT_L(8); PG8_BAR; PG8_WAIT_L(0); PG8_MMA(0, 0, At, B0); PG8_BAR; PG8_SCHED;
            PG8_LDB(B1, 0, 1); PG8_STAGE(PG8_SB(0, 0), b2, voffB);
            PG8_BAR; PG8_WAIT_L(0); PG8_MMA(0, 1, At, B1); PG8_BAR;
            PG8_LDA(At, 0, 1); PG8_STAGE(PG8_SA(0, 0), a2, voffA);
            PG8_BAR; PG8_WAIT_L(0); PG8_MMA(1, 0, At, B0); PG8_BAR; PG8_SCHED;
            PG8_STAGE(PG8_SB(0, 1), b2 + hstep, voffB);
            PG8_WAIT_V(6); PG8_BAR; PG8_MMA(1, 1, At, B1); PG8_BAR;
            PG8_LDB(B0, 1, 0); PG8_SCHED; PG8_LDA(At, 1, 0); PG8_STAGE(PG8_SA(0, 1), a2 + hstep, voffA);
            PG8_WAIT_L(8); PG8_BAR; PG8_WAIT_L(0); PG8_MMA(0, 0, At, B0); PG8_BAR; PG8_SCHED;
            PG8_LDB(B1, 1, 1); PG8_STAGE(PG8_SB(1, 0), b3, voffB);
            PG8_BAR; PG8_WAIT_L(0); PG8_MMA(0, 1, At, B1); PG8_BAR;
            PG8_LDA(At, 1, 1); PG8_STAGE(PG8_SA(1, 0), a3, voffA);
            PG8_BAR; PG8_WAIT_L(0); PG8_MMA(1, 0, At, B0); PG8_BAR; PG8_SCHED;
            PG8_STAGE(PG8_SB(1, 1), b3 + hstep, voffB);
            PG8_WAIT_V(6); PG8_BAR; PG8_MMA(1, 1, At, B1); PG8_BAR;
            }
        }
        if constexpr (ALIGN_EPI) { if (wr == 0) PG8_BAR; }
        if constexpr (!Epi::AFTER_DRAIN) { E(acc, cur, wr, wc, fr, fq, ui); S.done(cur); }
        if (!has_next) break;
#pragma unroll
        for (int a = 0; a < 2; ++a)
#pragma unroll
            for (int b = 0; b < 2; ++b)
#pragma unroll
                for (int m = 0; m < 4; ++m)
#pragma unroll
                    for (int n = 0; n < 2; ++n) acc[a][b][m][n] = (f32x4){0.f, 0.f, 0.f, 0.f};
        cur = nxt; cA = nA; cB = nB; ++ui;
        if constexpr (ALIGN_EPI) { if (wr == 1) PG8_BAR; }
    }
    PG8_WAIT_V(0);
    if constexpr (!ALIGN_EPI) { if (wr == 0) PG8_BAR; }
    PG8_BAR;
    if constexpr (Epi::AFTER_DRAIN) { E.fused(acc, cur, wr, wc, fr, fq, lds, wid, lane); S.done(cur); }
#undef PG8_SA
#undef PG8_SB
#undef PG8_STAGE
#undef PG8_LDA
#undef PG8_LDB
#undef PG8_MMA
#undef PG8_WAIT_V
#undef PG8_WAIT_L
#undef PG8_BAR
#undef PG8_SCHED
}
}
static __device__ const double INVF[128] = {
  1.0, 0.930572040929699, 0.8659643233600653, 0.8058421877614819,
  0.7498942093324559, 0.6978305848598664, 0.6493816315762113, 0.6042963902381329,
  0.5623413251903491, 0.5232991146814947, 0.4869675251658631, 0.4531583637600818,
  0.4216965034285822, 0.3924189758484536, 0.3651741272548377, 0.33982083289425596,
  0.31622776601683794, 0.29427271762092816, 0.27384196342643613, 0.25482967479793467,
  0.23713737056616552, 0.220673406908459, 0.2053525026457146, 0.19109529749704404,
  0.1778279410038923, 0.16548170999431813, 0.1539926526059492, 0.14330125702369628,
  0.1333521432163324, 0.12409377607517195, 0.11547819846894582, 0.10746078283213174,
  0.1, 0.0930572040929699, 0.08659643233600653, 0.08058421877614819,
  0.07498942093324558, 0.06978305848598663, 0.06493816315762113, 0.060429639023813285,
  0.05623413251903491, 0.05232991146814947, 0.04869675251658631, 0.04531583637600818,
  0.042169650342858224, 0.03924189758484536, 0.03651741272548377, 0.03398208328942559,
  0.03162277660168379, 0.029427271762092817, 0.027384196342643614, 0.025482967479793464,
  0.023713737056616554, 0.0220673406908459, 0.02053525026457146, 0.019109529749704406,
  0.01778279410038923, 0.016548170999431813, 0.01539926526059492, 0.014330125702369627,
  0.01333521432163324, 0.012409377607517195, 0.011547819846894581, 0.010746078283213174,
  0.01, 0.00930572040929699, 0.008659643233600654, 0.008058421877614819,
  0.007498942093324558, 0.006978305848598663, 0.006493816315762113, 0.006042963902381328,
  0.005623413251903491, 0.005232991146814947, 0.004869675251658631, 0.004531583637600818,
  0.004216965034285823, 0.003924189758484536, 0.003651741272548377, 0.003398208328942559,
  0.0031622776601683794, 0.002942727176209282, 0.0027384196342643613, 0.0025482967479793467,
  0.0023713737056616554, 0.0022067340690845897, 0.002053525026457146, 0.0019109529749704406,
  0.0017782794100389228, 0.0016548170999431814, 0.001539926526059492, 0.0014330125702369627,
  0.001333521432163324, 0.0012409377607517195, 0.0011547819846894581, 0.0010746078283213176,
  0.001, 0.0009305720409296989, 0.0008659643233600654, 0.0008058421877614818,
  0.0007498942093324559, 0.0006978305848598664, 0.0006493816315762113, 0.0006042963902381329,
  0.0005623413251903491, 0.0005232991146814947, 0.0004869675251658631, 0.0004531583637600818,
  0.00042169650342858224, 0.0003924189758484536, 0.0003651741272548377, 0.00033982083289425596,
  0.00031622776601683794, 0.00029427271762092817, 0.0002738419634264361, 0.00025482967479793463,
  0.00023713737056616554, 0.00022067340690845897, 0.0002053525026457146, 0.00019109529749704405,
  0.00017782794100389227, 0.00016548170999431815, 0.0001539926526059492, 0.00014330125702369627,
  0.0001333521432163324, 0.00012409377607517196, 0.00011547819846894582, 0.00010746078283213175
};

#include <hip/hip_cooperative_groups.h>
namespace cg = cooperative_groups;
#define LAS __attribute__((address_space(3)))
#define DI __device__ __forceinline__
typedef unsigned short bf16;
typedef short bf16x8 __attribute__((ext_vector_type(8)));
typedef short s16x4 __attribute__((ext_vector_type(4)));
typedef short v4i16_t __attribute__((ext_vector_type(4)));
typedef float f32x4 __attribute__((ext_vector_type(4)));
typedef float f32x16 __attribute__((ext_vector_type(16)));
typedef unsigned u32x4 __attribute__((ext_vector_type(4)));
typedef unsigned u32x2 __attribute__((ext_vector_type(2)));
typedef float f32x2_t __attribute__((ext_vector_type(2)));
typedef __bf16 bf16x2_t __attribute__((ext_vector_type(2)));
typedef unsigned char uchar;

constexpr int NWAVES = 8, NTHR = 512;
constexpr int D = 1024, TP = 65536, TS = 2048, T = TP + TS, FF = 2816, SEQ = 4096, DSEQ = 64, PAST = 1024, KSAMP = PAST + DSEQ;
constexpr int NB_P = 16, NB_S = 32;
constexpr float EPS = 1e-6f;
constexpr float LOG2E = 1.4426950408889634f;
constexpr int LDS_BYTES = 159744;

constexpr size_t O_Y = 0, O_SRP = 69206016, O_KP = 77594624, O_VP = 144703488, O_LFP = 211812352, O_SRS = 212860928,
                 O_KS = 229638144, O_VS = 231735296, O_LFS = 233832448;
constexpr size_t SZ_WIN = (size_t)5632 * 1024 * 2, SZ_WOUT = (size_t)1024 * 2816 * 2, SZ_ACT = (size_t)T * 1024 * 2;
constexpr size_t WS_WIN = 1u << 20;
constexpr size_t WS_WOUT = WS_WIN + 4 * SZ_WIN;
constexpr size_t WS_RIN = WS_WOUT + 4 * SZ_WOUT;
constexpr size_t WS_ROUT = WS_RIN + (size_t)6144 * 1024 * 2;
constexpr size_t WS_KVF = WS_ROUT + (size_t)1024 * 2048 * 2;
constexpr size_t WS_WQ = WS_KVF + (size_t)2304 * 1024 * 2;
constexpr size_t WS_WO = WS_WQ + (size_t)1024 * 1024 * 2;
constexpr size_t WS_ROPE = WS_WO + (size_t)1024 * 1024 * 2;
constexpr size_t WS_SSQ = WS_ROPE + (size_t)4096 * 256 * 4;
constexpr size_t WS_BIASP = WS_SSQ + (size_t)T * 16 * 4;
constexpr size_t WS_BIASS = WS_BIASP + (size_t)256 * 4096 * 4;
constexpr size_t WS_HB = WS_BIASS + (size_t)512 * KSAMP * 4;
constexpr size_t WS_R = WS_HB + SZ_ACT;
constexpr size_t SZ_HID = (size_t)T * FF * 2, K2B_BYTES = (size_t)(TP + NB_S * KSAMP) * 1024 * 2;
constexpr size_t R_HID = 0, R_VO = 0, R_G = 2 * SZ_ACT, R_QF = 0, R_K2B = SZ_HID, R_V2B = R_K2B + K2B_BYTES;
constexpr size_t WS_END = WS_R + R_V2B + K2B_BYTES;
static_assert(R_G + 2 * SZ_ACT <= R_V2B + K2B_BYTES, "retention overlay");
static_assert(SZ_ACT <= SZ_HID && SZ_HID % 256 == 0, "qf overlay");
static_assert(WS_END <= (size_t)1073741824, "ws size");
static_assert(WS_HB % 256 == 0 && WS_R % 256 == 0 && WS_ROPE % 256 == 0 && WS_SSQ % 256 == 0, "align");

DI unsigned pk(float lo, float hi) { f32x2_t v = {lo, hi}; bf16x2_t b = __builtin_convertvector(v, bf16x2_t); return __builtin_bit_cast(unsigned, b); }
DI float bflo(unsigned w) { return __uint_as_float(w << 16); }
DI float bfhi(unsigned w) { return __uint_as_float(w & 0xffff0000u); }
DI float ex2(float x) { return __builtin_amdgcn_exp2f(x); }
DI float silu_f(float x) { return x * __builtin_amdgcn_rcpf(1.0f + __expf(-x)); }
DI float wave_sum(float v) {
#pragma unroll
    for (int o = 1; o < 64; o <<= 1) v += __shfl_xor(v, o);
    return v;
}
DI float row_rstd(const float* ssq, int row) {
    const f32x4* p = (const f32x4*)(ssq + (size_t)row * 16);
    const f32x4 a = p[0], b = p[1], c = p[2], d = p[3];
    const float s = (((a[0] + a[1]) + (a[2] + a[3])) + ((b[0] + b[1]) + (b[2] + b[3]))) + (((c[0] + c[1]) + (c[2] + c[3])) + ((d[0] + d[1]) + (d[2] + d[3])));
    return __builtin_amdgcn_rsqf(s * (1.0f / 1024.0f) + EPS);
}

namespace pg8 {
struct EpiSwiGLU {
    static constexpr bool PERM = true, AFTER_DRAIN = false;
    bf16_t* O; const LAS float* rl;
    __device__ __forceinline__ void operator()(const f32x4 (&acc)[2][2][4][2], const Unit& u, int wr, int wc, int fr, int fq, int ui) const {
        const int row0 = u.pm * BM + wr * 64 + fr, col0 = u.pn * 128 + wc * 32 + 8 * fq;
        const LAS float* rlu = rl + ui * 256 + wr * 64 + fr;
#pragma unroll
        for (int ai = 0; ai < 2; ++ai)
#pragma unroll
            for (int m = 0; m < 4; ++m) {
                const int row = row0 + ai * HALF + m * 16; const float rs = rlu[ai * HALF + m * 16];
                u32x4 w;
#pragma unroll
                for (int n = 0; n < 2; ++n) {
                    const f32x4 g = acc[ai][0][m][n] * rs, up = acc[ai][1][m][n] * rs;
                    const float h0 = silu_f(g[0]) * up[0], h1 = silu_f(g[1]) * up[1], h2 = silu_f(g[2]) * up[2], h3 = silu_f(g[3]) * up[3];
                    w[2 * n] = pk(h0, h1); w[2 * n + 1] = pk(h2, h3);
                }
                *(u32x4*)(O + (size_t)row * FF + col0) = w;
            }
    }
};
struct EpiRes {
    static constexpr bool PERM = true, AFTER_DRAIN = false;
    bf16_t* HB; float* ssq; float alpha;
    __device__ __forceinline__ void operator()(const f32x4 (&acc)[2][2][4][2], const Unit& u, int wr, int wc, int fr, int fq, int ui) const {
        const int row0 = u.pm * BM + wr * 64 + fr, col0 = u.pn * BM + wc * 32 + 8 * fq;
#pragma unroll
        for (int ai = 0; ai < 2; ++ai) {
            asm volatile("" ::: "memory");
            u32x4 pre[4][2];
#pragma unroll
            for (int m = 0; m < 4; ++m)
#pragma unroll
                for (int bj = 0; bj < 2; ++bj) pre[m][bj] = *(const u32x4*)(HB + (size_t)(row0 + ai * HALF + m * 16) * D + col0 + bj * HALF);
#pragma unroll
            for (int m = 0; m < 4; ++m) {
                const int row = row0 + ai * HALF + m * 16; float s = 0.f;
#pragma unroll
                for (int bj = 0; bj < 2; ++bj) {
                    const u32x4 pv = pre[m][bj];
                    const f32x4 h0 = {bflo(pv[0]), bfhi(pv[0]), bflo(pv[1]), bfhi(pv[1])}, h1 = {bflo(pv[2]), bfhi(pv[2]), bflo(pv[3]), bfhi(pv[3])};
                    const f32x4 o0 = h0 + acc[ai][bj][m][0] * alpha, o1 = h1 + acc[ai][bj][m][1] * alpha;
                    u32x4 w; w[0] = pk(o0[0], o0[1]); w[1] = pk(o0[2], o0[3]); w[2] = pk(o1[0], o1[1]); w[3] = pk(o1[2], o1[3]);
                    *(u32x4*)(HB + (size_t)row * D + col0 + bj * HALF) = w;
                    s += (o0[0] * o0[0] + o0[1] * o0[1]) + (o0[2] * o0[2] + o0[3] * o0[3]) + (o1[0] * o1[0] + o1[1] * o1[1]) + (o1[2] * o1[2] + o1[3] * o1[3]);
                }
                s += __shfl_xor(s, 16); s += __shfl_xor(s, 32);
                if (fq == 0) ssq[(size_t)row * 16 + u.pn * 4 + wc] = s;
            }
        }
    }
};
struct EpiRetIn {
    static constexpr bool PERM = true, AFTER_DRAIN = false;
    bf16_t *Q, *K, *V, *G; const LAS float* rl; const float* rope;
    __device__ __forceinline__ void operator()(const f32x4 (&acc)[2][2][4][2], const Unit& u, int wr, int wc, int fr, int fq, int ui) const {
        const int row0 = u.pm * BM + wr * 64 + fr, d0 = wc * 32 + 8 * fq;
        const int pn = u.pn;
        const LAS float* rlu = rl + ui * 256 + wr * 64 + fr;
#pragma unroll
        for (int ai = 0; ai < 2; ++ai)
#pragma unroll
            for (int m = 0; m < 4; ++m) {
                if (pn < 8 && (m & 1) == 0) asm volatile("" ::: "memory");
                const int row = row0 + ai * HALF + m * 16; const float rs = rlu[ai * HALF + m * 16];
                if (pn < 8) {
                    const int pos = row < TP ? (row & (SEQ - 1)) : PAST + ((row - TP) & (DSEQ - 1));
                    const float* cs = rope + (size_t)pos * 256 + d0;
                    const float sc = pn < 4 ? rs * 0.0625f : rs;
                    bf16_t* dst = (pn < 4 ? Q : K) + (size_t)row * D + (pn & 3) * 256 + d0;
                    u32x4 w1, w2;
#pragma unroll
                    for (int n = 0; n < 2; ++n) {
                        const f32x4 c = *(const f32x4*)(cs + 4 * n), s = *(const f32x4*)(cs + 128 + 4 * n);
                        const f32x4 x1 = acc[ai][0][m][n] * sc, x2 = acc[ai][1][m][n] * sc;
                        const f32x4 y1 = x1 * c - x2 * s, y2 = x1 * s + x2 * c;
                        w1[2 * n] = pk(y1[0], y1[1]); w1[2 * n + 1] = pk(y1[2], y1[3]);
                        w2[2 * n] = pk(y2[0], y2[1]); w2[2 * n + 1] = pk(y2[2], y2[3]);
                    }
                    *(u32x4*)dst = w1; *(u32x4*)(dst + 128) = w2;
                } else {
                    const bool isg = pn >= 16;
                    bf16_t* dst = (isg ? G : V) + (size_t)row * 2048 + ((pn - 8) & 7) * 256 + d0;
#pragma unroll
                    for (int bj = 0; bj < 2; ++bj) {
                        f32x4 a = acc[ai][bj][m][0] * rs, b = acc[ai][bj][m][1] * rs;
                        if (isg) { a = (f32x4){silu_f(a[0]), silu_f(a[1]), silu_f(a[2]), silu_f(a[3])}; b = (f32x4){silu_f(b[0]), silu_f(b[1]), silu_f(b[2]), silu_f(b[3])}; }
                        u32x4 w; w[0] = pk(a[0], a[1]); w[1] = pk(a[2], a[3]); w[2] = pk(b[0], b[1]); w[3] = pk(b[2], b[3]);
                        *(u32x4*)(dst + bj * HALF) = w;
                    }
                }
            }
    }
};
struct EpiKVF {
    static constexpr bool PERM = true, AFTER_DRAIN = false;
    float* out; bf16_t *K2B, *V2B; const LAS float* rl; const float* bf;
    __device__ __forceinline__ void operator()(const f32x4 (&acc)[2][2][4][2], const Unit& u, int wr, int wc, int fr, int fq, int ui) const {
        const int row0 = u.pm * BM + wr * 64 + fr, d0 = wc * 32 + 8 * fq;
        const int pn = u.pn; const bool samp = u.pm >= TP / BM;
        const LAS float* rlu = rl + ui * 256 + wr * 64 + fr;
        if (pn < 8) {
            const bool isv = pn >= 4;
            float* fbase = out + (samp ? (isv ? O_VS : O_KS) - (size_t)TP * D : (isv ? O_VP : O_KP)) + (pn & 3) * 256 + d0;
            bf16_t* bbase = (isv ? V2B : K2B) + (pn & 3) * 256 + d0;
#pragma unroll
            for (int ai = 0; ai < 2; ++ai)
#pragma unroll
                for (int m = 0; m < 4; ++m) {
                    const int row = row0 + ai * HALF + m * 16; const float rs = rlu[ai * HALF + m * 16];
                    const int brow = row + (samp ? (((row - TP) >> 6) + 1) * 1024 : 0);
                    float* fo = fbase + (size_t)row * D; bf16_t* bo = bbase + (size_t)brow * D;
#pragma unroll
                    for (int bj = 0; bj < 2; ++bj) {
                        const f32x4 a = acc[ai][bj][m][0] * rs, b = acc[ai][bj][m][1] * rs;
                        __builtin_nontemporal_store(a, (f32x4*)(fo + bj * HALF)); __builtin_nontemporal_store(b, (f32x4*)(fo + bj * HALF + 4));
                        u32x4 w; w[0] = pk(a[0], a[1]); w[1] = pk(a[2], a[3]); w[2] = pk(b[0], b[1]); w[3] = pk(b[2], b[3]);
                        *(u32x4*)(bo + bj * HALF) = w;
                    }
                }
        } else if (wc == 0 && fq < 2) {
            float* lbase = out + (samp ? O_LFS - (size_t)TP * 16 : O_LFP) + 8 * fq;
            const f32x4 bb0 = *(const f32x4*)(bf + 8 * fq), bb1 = *(const f32x4*)(bf + 8 * fq + 4);
#pragma unroll
            for (int ai = 0; ai < 2; ++ai)
#pragma unroll
                for (int m = 0; m < 4; ++m) {
                    const int row = row0 + ai * HALF + m * 16; const float rs = rlu[ai * HALF + m * 16];
                    float* lo = lbase + (size_t)row * 16;
#pragma unroll
                    for (int n = 0; n < 2; ++n) {
                        const f32x4 x = acc[ai][0][m][n] * rs + (n ? bb1 : bb0); f32x4 y;
#pragma unroll
                        for (int j = 0; j < 4; ++j) y[j] = fminf(x[j], 0.f) - __logf(1.0f + __expf(-fabsf(x[j])));
                        *(f32x4*)(lo + 4 * n) = y;
                    }
                }
        }
    }
};
struct EpiQ {
    static constexpr bool PERM = true, AFTER_DRAIN = false;
    bf16_t* O; const LAS float* rl;
    __device__ __forceinline__ void operator()(const f32x4 (&acc)[2][2][4][2], const Unit& u, int wr, int wc, int fr, int fq, int ui) const {
        const int row0 = u.pm * BM + wr * 64 + fr, col0 = u.pn * BM + wc * 32 + 8 * fq;
        const LAS float* rlu = rl + ui * 256 + wr * 64 + fr;
#pragma unroll
        for (int ai = 0; ai < 2; ++ai)
#pragma unroll
            for (int m = 0; m < 4; ++m) {
                const int row = row0 + ai * HALF + m * 16; const float rs = rlu[ai * HALF + m * 16] * (0.125f * LOG2E);
#pragma unroll
                for (int bj = 0; bj < 2; ++bj) {
                    const f32x4 a = acc[ai][bj][m][0] * rs, b = acc[ai][bj][m][1] * rs;
                    u32x4 w; w[0] = pk(a[0], a[1]); w[1] = pk(a[2], a[3]); w[2] = pk(b[0], b[1]); w[3] = pk(b[2], b[3]);
                    *(u32x4*)(O + (size_t)row * D + col0 + bj * HALF) = w;
                }
            }
    }
};
}

DI void tr_item(const float* W, int K, int N, bf16* WT, int drow0, const float* g, LAS float* scr, int k0, int n0, int lane) {
    const int n = n0 + 4 * (lane & 7);
    f32x4 v[8];
#pragma unroll
    for (int i = 0; i < 8; ++i) { const int kk = 8 * i + (lane >> 3); v[i] = (n < N) ? __builtin_nontemporal_load((const f32x4*)(W + (size_t)(k0 + kk) * N + n)) : (f32x4){0.f, 0.f, 0.f, 0.f}; }
#pragma unroll
    for (int i = 0; i < 8; ++i) { const int kk = 8 * i + (lane >> 3); const float gs = g ? g[k0 + kk] : 1.0f; LAS float* d = scr + kk * 33 + 4 * (lane & 7);
        d[0] = v[i][0] * gs; d[1] = v[i][1] * gs; d[2] = v[i][2] * gs; d[3] = v[i][3] * gs; }
    asm volatile("s_waitcnt lgkmcnt(0)" ::: "memory");
    const int c = lane & 7;
#pragma unroll
    for (int j = 0; j < 4; ++j) { const int nn = (lane >> 3) + 8 * j; const LAS float* s = scr + (8 * c) * 33 + nn;
        u32x4 o; o[0] = pk(s[0 * 33], s[1 * 33]); o[1] = pk(s[2 * 33], s[3 * 33]); o[2] = pk(s[4 * 33], s[5 * 33]); o[3] = pk(s[6 * 33], s[7 * 33]);
        *(u32x4*)(WT + (size_t)(drow0 + nn) * K + k0 + 8 * c) = o; }
    asm volatile("s_waitcnt lgkmcnt(0)" ::: "memory");
}
DI bool tr_matrix(int& r, const float* W, int K, int N, int nblk, bf16* WT, const float* g, int mode, LAS float* scr, int lane) {
    const int items = (K / 64) * nblk;
    if (r >= items) { r -= items; return false; }
    const int kb = r / nblk, nb = r % nblk, n0 = 32 * nb;
    int drow0 = n0;
    if (mode == 1) { const int bj = n0 / FF, rem = n0 % FF; drow0 = 256 * (rem / 128) + 128 * bj + (rem % 128); }
    tr_item(W, K, N, WT, drow0, g, scr, 64 * kb, n0, lane);
    return true;
}
DI void sincos_d(double x, float& s, float& c) {
    const double n = __builtin_rint(x * 0.63661977236758134308);
    double r = __builtin_fma(-n, 1.57079632679489655800e+00, x); r = __builtin_fma(-n, 6.12323399573676603587e-17, r);
    const double r2 = r * r;
    double sp = -1.0 / 1307674368000.0; sp = sp * r2 + 1.0 / 6227020800.0; sp = sp * r2 - 1.0 / 39916800.0; sp = sp * r2 + 1.0 / 362880.0; sp = sp * r2 - 1.0 / 5040.0; sp = sp * r2 + 1.0 / 120.0; sp = sp * r2 - 1.0 / 6.0; sp = sp * r2 * r + r;
    double cp = 1.0 / 20922789888000.0; cp = cp * r2 - 1.0 / 87178291200.0; cp = cp * r2 + 1.0 / 479001600.0; cp = cp * r2 - 1.0 / 3628800.0; cp = cp * r2 + 1.0 / 40320.0; cp = cp * r2 - 1.0 / 720.0; cp = cp * r2 + 1.0 / 24.0; cp = cp * r2 - 0.5; cp = cp * r2 + 1.0;
    const int q = ((int)n) & 3;
    const double ss = (q == 0) ? sp : (q == 1) ? cp : (q == 2) ? -sp : -cp;
    const double cc = (q == 0) ? cp : (q == 1) ? -sp : (q == 2) ? -cp : sp;
    s = (float)ss; c = (float)cc;
}

constexpr int RL_OFF = 131072;
static_assert(RL_OFF + 25 * 1024 <= LDS_BYTES, "rstd table");
DI void rstd_prepass(LAS uchar* lds, const float* ssq, const pg8::StaticOrder& S, int tid) {
    LAS float* rl = (LAS float*)(lds + RL_OFF);
    pg8::Unit u; int nun = 0;
    while (nun < 25 && S.next(nun, u)) ++nun;
#pragma unroll 4
    for (int e = tid; e < nun * 256; e += NTHR) { S.next(e >> 8, u); rl[e] = row_rstd(ssq, u.pm * 256 + (e & 255)); }
    __syncthreads();
}
#define KSEL(k) (ONLY < 0 || ONLY == (k))
struct Params { const float* in[22]; float* out; unsigned char* ws; int ph_lo, ph_hi; unsigned char prog[32]; };

DI void phase_prologue(const Params& P, uchar* ws, float* out, LAS uchar* lds, int gw, int NGW, int wave, int lane) {
    LAS float* scr = (LAS float*)(lds + wave * 16384);
    constexpr int I_IN = 16 * 176, I_OUT = 44 * 32;
    constexpr int NITEMS = 4 * I_IN + 4 * I_OUT + 16 * 192 + 32 * 32 + 16 * 72 + 2 * 16 * 32;
    for (int it = gw; it < NITEMS; it += NGW) {
        int r = it; bool done = false;
#pragma unroll
        for (int f = 0; f < 4; ++f) {
            if (done) break;
            const int l = f >> 1; const bool second = f & 1;
            done = tr_matrix(r, P.in[second ? 11 : 7] + (size_t)l * 1024 * 5632, 1024, 5632, 176, (bf16*)(ws + WS_WIN + f * SZ_WIN), P.in[second ? 10 : 6] + l * 1024, 1, scr, lane);
        }
#pragma unroll
        for (int f = 0; f < 4; ++f) {
            if (done) break;
            const int l = f >> 1; const bool second = f & 1;
            done = tr_matrix(r, P.in[second ? 12 : 8] + (size_t)l * 2816 * 1024, 2816, 1024, 32, (bf16*)(ws + WS_WOUT + f * SZ_WOUT), nullptr, 0, scr, lane);
        }
        if (!done) done = tr_matrix(r, P.in[13], 1024, 6144, 192, (bf16*)(ws + WS_RIN), P.in[9], 0, scr, lane);
        if (!done) done = tr_matrix(r, P.in[15], 2048, 1024, 32, (bf16*)(ws + WS_ROUT), P.in[14], 0, scr, lane);
        if (!done) done = tr_matrix(r, P.in[17], 1024, 2064, 72, (bf16*)(ws + WS_KVF), P.in[16], 0, scr, lane);
        if (!done) done = tr_matrix(r, P.in[19], 1024, 1024, 32, (bf16*)(ws + WS_WQ), P.in[9] + 1024, 0, scr, lane);
        if (!done) done = tr_matrix(r, P.in[20], 1024, 1024, 32, (bf16*)(ws + WS_WO), nullptr, 0, scr, lane);
    }
    {
        bf16* HB = (bf16*)(ws + WS_HB); float* ssq = (float*)(ws + WS_SSQ);
        constexpr int NR = 4;
        for (int m0 = gw; m0 < T; m0 += NR * NGW) {
            f32x4 v[NR][4];
#pragma unroll
            for (int u = 0; u < NR; ++u) { const int m = m0 + u * NGW < T ? m0 + u * NGW : m0;
                const float* src = m < TP ? P.in[0] + (size_t)m * D : P.in[1] + (size_t)(m - TP) * D;
#pragma unroll
                for (int j = 0; j < 4; ++j) v[u][j] = __builtin_nontemporal_load((const f32x4*)src + lane + 64 * j); }
#pragma unroll
            for (int u = 0; u < NR; ++u) {
                const int m = m0 + u * NGW; if (m >= T) break;
                float s = 0.f;
#pragma unroll
                for (int j = 0; j < 4; ++j) s += (v[u][j][0] * v[u][j][0] + v[u][j][1] * v[u][j][1]) + (v[u][j][2] * v[u][j][2] + v[u][j][3] * v[u][j][3]);
                s = wave_sum(s);
#pragma unroll
                for (int j = 0; j < 4; ++j) { u32x2 w; w[0] = pk(v[u][j][0], v[u][j][1]); w[1] = pk(v[u][j][2], v[u][j][3]); ((u32x2*)(HB + (size_t)m * D))[lane + 64 * j] = w; }
                if (lane < 16) ssq[(size_t)m * 16 + lane] = lane == 0 ? s : 0.f;
            }
        }
    }
}

DI void rope_table(uchar* ws, int gw, int NGW, int lane) {
    {
        const int gt = gw * 64 + lane, NGT = NGW * 64; float* rope = (float*)(ws + WS_ROPE);
        for (int e = gt; e < 4096 * 128; e += NGT) { const int pos = e >> 7, j = e & 127; float s, c; sincos_d((double)pos * INVF[j], s, c); rope[(size_t)pos * 256 + j] = c; rope[(size_t)pos * 256 + 128 + j] = s; }
    }
}

DI f32x16 mfma32(bf16x8 a, bf16x8 b, f32x16 c) { return __builtin_amdgcn_mfma_f32_32x32x16_bf16(a, b, c, 0, 0, 0); }
DI int crow(int i, int hh) { return (i & 3) + 8 * (i >> 2) + 4 * hh; }
DI s16x4 vtr(const LAS uchar* p) { return __builtin_bit_cast(s16x4, __builtin_amdgcn_ds_read_tr16_b64_v4i16((LAS v4i16_t*)p)); }
DI bf16x8 cat8(s16x4 lo, s16x4 hi) { return __builtin_shufflevector(lo, hi, 0, 1, 2, 3, 4, 5, 6, 7); }
DI bf16x8 ldsv(const LAS uchar* p) { return *(const LAS bf16x8*)p; }
template <int S> DI bf16x8 pack8(const f32x16& x) { u32x4 p; p[0] = pk(x[8 * S], x[8 * S + 1]); p[1] = pk(x[8 * S + 2], x[8 * S + 3]); p[2] = pk(x[8 * S + 4], x[8 * S + 5]); p[3] = pk(x[8 * S + 6], x[8 * S + 7]); return __builtin_bit_cast(bf16x8, p); }
DI s16x4 scale4(s16x4 v, float f0, float f1, float f2, float f3) {
    const u32x2 w = __builtin_bit_cast(u32x2, v); u32x2 o;
    o[0] = pk(bflo(w[0]) * f0, bfhi(w[0]) * f1); o[1] = pk(bflo(w[1]) * f2, bfhi(w[1]) * f3);
    return __builtin_bit_cast(s16x4, o);
}
namespace ret {
constexpr int QP = 528, KP = 528, VP = 320, SP = 528;
constexpr int OFF_Q = 0, OFF_K = 64 * QP, OFF_V = OFF_K + 64 * KP, OFF_ST = OFF_V + 64 * VP, END = OFF_ST + 128 * SP;
static_assert(END <= LDS_BYTES, "retention LDS");
}
DI void ret_item(LAS uchar* lds, const bf16* Qg, const bf16* Kg, bf16* Vg, size_t rowbase, int h, int sl, int nch, const float* S0, float* Sout, float lg2) {
    using namespace ret;
    int tid_ = threadIdx.x; asm volatile("" : "+v"(tid_));
    const int tid = tid_, lane = tid & 63, w = __builtin_amdgcn_readfirstlane(tid >> 6), r = lane & 31, hh = lane >> 5;
    const int ci = w >> 2, ei = w & 3, dq = w >> 1, eh = w & 1;
    const int q4 = (lane & 15) >> 2, p4 = lane & 3, blk = (lane >> 4) & 1;
    f32x16 S[2][2];
    if (S0) {
#pragma unroll
        for (int ti = 0; ti < 2; ++ti)
#pragma unroll
            for (int tj = 0; tj < 2; ++tj)
#pragma unroll
                for (int i = 0; i < 16; ++i) S[ti][tj][i] = S0[(size_t)(64 * dq + 32 * ti + crow(i, hh)) * 512 + 128 * sl + 64 * eh + 32 * tj + r];
    } else {
#pragma unroll
        for (int ti = 0; ti < 2; ++ti)
#pragma unroll
            for (int tj = 0; tj < 2; ++tj)
#pragma unroll
                for (int i = 0; i < 16; ++i) S[ti][tj][i] = 0.f;
    }
    const float g64 = ex2(lg2 * 64.f);
    const bf16* qsrc = Qg + (rowbase + (tid >> 5)) * D + h * 256 + (tid & 31) * 8;
    const bf16* ksrc = Kg + (rowbase + (tid >> 5)) * D + h * 256 + (tid & 31) * 8;
    bf16* vsrc = Vg + (rowbase + (tid >> 4)) * 2048 + h * 512 + sl * 128 + (tid & 15) * 8;
    const int qdst = (tid >> 5) * QP + (tid & 31) * 16, vdst = (tid >> 4) * VP + (tid & 15) * 16;
    const float lg2_inv = lg2;
#pragma unroll 1
    for (int n = 0; n < nch; ++n) {
        float lg2 = lg2_inv; asm volatile("" : "+v"(lg2));
        u32x4 rq[4], rk[4], rv[2];
        {
            const size_t adv = (size_t)64 * n;
#pragma unroll
            for (int i = 0; i < 4; ++i) { rq[i] = *(const u32x4*)(qsrc + (adv + 16 * i) * D); rk[i] = *(const u32x4*)(ksrc + (adv + 16 * i) * D); }
#pragma unroll
            for (int i = 0; i < 2; ++i) rv[i] = *(const u32x4*)(vsrc + (adv + 32 * i) * 2048);
        }
        __syncthreads();
#pragma unroll
        for (int i = 0; i < 4; ++i) { *(LAS u32x4*)(lds + OFF_Q + qdst + 16 * i * QP) = rq[i]; *(LAS u32x4*)(lds + OFF_K + qdst + 16 * i * KP) = rk[i]; }
        asm volatile("" ::: "memory");
#pragma unroll
        for (int i = 0; i < 2; ++i) {
            const float f = ex2(lg2 * (float)(63 - 32 * i - (tid >> 4))); u32x4 w;
#pragma unroll
            for (int j = 0; j < 4; ++j) w[j] = pk(bflo(rv[i][j]) * f, bfhi(rv[i][j]) * f);
            *(LAS u32x4*)(lds + OFF_V + vdst + 32 * i * VP) = w;
        }
        asm volatile("" ::: "memory");
#pragma unroll
        for (int ti = 0; ti < 2; ++ti)
#pragma unroll
            for (int tj = 0; tj < 2; ++tj)
#pragma unroll
                for (int g = 0; g < 4; ++g) { u32x2 v; v[0] = pk(S[ti][tj][4 * g], S[ti][tj][4 * g + 1]); v[1] = pk(S[ti][tj][4 * g + 2], S[ti][tj][4 * g + 3]);
                    *(LAS u32x2*)(lds + OFF_ST + (64 * eh + 32 * tj + r) * SP + (64 * dq + 32 * ti + 8 * g + 4 * hh) * 2) = v; }
        __syncthreads();
        f32x16 sc0, sc1;
#pragma unroll
        for (int i = 0; i < 16; ++i) { sc0[i] = 0.f; sc1[i] = 0.f; }
        const LAS uchar* qrow = lds + OFF_Q + (32 * ci + r) * QP + hh * 16;
        {
            const LAS uchar* krow = lds + OFF_K + r * KP + hh * 16;
#pragma unroll
            for (int kk = 0; kk < 16; ++kk) { const bf16x8 qf = ldsv(qrow + kk * 32); sc0 = mfma32(ldsv(krow + kk * 32), qf, sc0); sc1 = mfma32(ldsv(krow + 32 * KP + kk * 32), qf, sc1);
                if ((kk & 3) == 3) asm volatile("" ::: "memory"); }
        }
        {
            const float a0 = (float)(32 * ci + r - 4 * hh), a1 = a0 - 32.f;
#pragma unroll
            for (int i = 0; i < 16; ++i) { const float cc = (float)((i & 3) + 8 * (i >> 2)); const float sm = cc + (float)(4 * hh - 63);
                sc0[i] *= ex2(lg2 * (fabsf(a0 - cc) + sm)); sc1[i] *= ex2(lg2 * (fabsf(a1 - cc) + sm + 32.f)); }
        }
        f32x16 o;
#pragma unroll
        for (int i = 0; i < 16; ++i) o[i] = 0.f;
        {
            const LAS uchar* vb = lds + OFF_V + (4 * hh + q4) * VP + (32 * ei + 16 * blk + 4 * p4) * 2;
            o = mfma32(pack8<0>(sc0), cat8(vtr(vb), vtr(vb + 8 * VP)), o);
            o = mfma32(pack8<1>(sc0), cat8(vtr(vb + 16 * VP), vtr(vb + 24 * VP)), o);
            o = mfma32(pack8<0>(sc1), cat8(vtr(vb + 32 * VP), vtr(vb + 40 * VP)), o);
            o = mfma32(pack8<1>(sc1), cat8(vtr(vb + 48 * VP), vtr(vb + 56 * VP)), o);
        }
        f32x16 o2;
#pragma unroll
        for (int i = 0; i < 16; ++i) o2[i] = 0.f;
        {
            const LAS uchar* strow = lds + OFF_ST + (32 * ei + r) * SP + hh * 16;
#pragma unroll
            for (int kk = 0; kk < 16; ++kk) { o2 = mfma32(ldsv(qrow + kk * 32), ldsv(strow + kk * 32), o2); if ((kk & 3) == 3) asm volatile("" ::: "memory"); }
        }
        {
            bf16* op = Vg + (rowbase + (size_t)64 * n + 32 * ci) * 2048 + h * 512 + sl * 128 + 32 * ei + r;
#pragma unroll
            for (int i = 0; i < 16; ++i) { const int c = crow(i, hh); const float val = o[i] + o2[i] * ex2(lg2 * (float)(32 * ci + c + 1));
                op[(size_t)c * 2048] = (bf16)(pk(val, 0.f) & 0xffffu); }
        }
        asm volatile("" ::: "memory");
#pragma unroll
        for (int ti = 0; ti < 2; ++ti)
#pragma unroll
            for (int tj = 0; tj < 2; ++tj) S[ti][tj] = S[ti][tj] * g64;
        {
            const LAS uchar* ka = lds + OFF_K + (8 * hh + q4) * KP + (64 * dq + 16 * blk + 4 * p4) * 2;
            const LAS uchar* va = lds + OFF_V + (8 * hh + q4) * VP + (64 * eh + 16 * blk + 4 * p4) * 2;
#pragma unroll
            for (int kk = 0; kk < 4; ++kk) {
                bf16x8 A[2], B[2];
#pragma unroll
                for (int ti = 0; ti < 2; ++ti) A[ti] = cat8(vtr(ka + kk * 16 * KP + ti * 64), vtr(ka + kk * 16 * KP + 4 * KP + ti * 64));
#pragma unroll
                for (int tj = 0; tj < 2; ++tj) B[tj] = cat8(vtr(va + kk * 16 * VP + tj * 64), vtr(va + kk * 16 * VP + 4 * VP + tj * 64));
#pragma unroll
                for (int ti = 0; ti < 2; ++ti)
#pragma unroll
                    for (int tj = 0; tj < 2; ++tj) S[ti][tj] = mfma32(A[ti], B[tj], S[ti][tj]);
                asm volatile("" ::: "memory");
            }
        }
    }
#pragma unroll
    for (int ti = 0; ti < 2; ++ti)
#pragma unroll
        for (int tj = 0; tj < 2; ++tj)
#pragma unroll
            for (int i = 0; i < 16; ++i) __builtin_nontemporal_store(S[ti][tj][i], Sout + (size_t)(64 * dq + 32 * ti + crow(i, hh)) * 512 + 128 * sl + 64 * eh + 32 * tj + r);
    __syncthreads();
}

namespace fox {
constexpr int KPI = 144, VPI = 192, KB = 64 * KPI, VB = 64 * VPI;
constexpr int OFF_K = 0, OFF_V = 3 * KB, OFF_BIAS = OFF_V + 3 * VB, OFF_SCR = OFF_BIAS + 4096 * 4, END = OFF_SCR + 8 * 256;
static_assert(END <= LDS_BYTES, "attention LDS");
}
DI float max3f(float a, float b, float c) { float r; asm("v_max3_f32 %0, %1, %2, %3" : "=v"(r) : "v"(a), "v"(b), "v"(c)); return r; }
DI float fadd_s(float a, float b) { float r; asm("v_add_f32_e32 %0, %1, %2" : "=v"(r) : "v"(a), "v"(b)); return r; }
DI float fsub_s(float a, float b) { float r; asm("v_sub_f32_e32 %0, %1, %2" : "=v"(r) : "v"(a), "v"(b)); return r; }
#define SBAR() __builtin_amdgcn_sched_barrier(0)
DI void fox_init(f32x16& n0, f32x16& n1, const LAS f32x4* bp, float m) {
#pragma unroll
    for (int g = 0; g < 4; ++g) { const f32x4 b0 = bp[2 * g], b1 = bp[2 * g + 8];
#pragma unroll
        for (int j = 0; j < 4; ++j) { n0[4 * g + j] = b0[j] - m; n1[4 * g + j] = b1[j] - m; }
        SBAR(); }
}
DI void fox_qk_plain(f32x16& n0, f32x16& n1, const LAS uchar* kb, const bf16x8 (&qf)[4]) {
#pragma unroll
    for (int kk = 0; kk < 4; ++kk) { n0 = mfma32(ldsv(kb + kk * 32), qf[kk], n0); n1 = mfma32(ldsv(kb + 32 * fox::KPI + kk * 32), qf[kk], n1); }
}
DI void fox_hot(f32x16& c0, f32x16& c1, f32x16& n0, f32x16& n1, f32x16& o0, f32x16& o1, float& l, float m,
                const LAS uchar* kb, const LAS uchar* vb, const LAS f32x4* bpn, const bf16x8 (&qf)[4], bf16x8 x0, bf16x8 x1, bf16x8 x2) {
    using namespace fox;
#define FOX_KF(i) ldsv(kb + ((i) & 1) * 32 * KPI + ((i) >> 1) * 32)
#define FOX_VFR(i) cat8(vtr(vb + (16 * ((i) >> 1)) * VPI + ((i) & 1) * 64), vtr(vb + (16 * ((i) >> 1) + 8) * VPI + ((i) & 1) * 64))
#define FOX_EX4(P, B) do { P[B] = ex2(P[B]); P[B + 1] = ex2(P[B + 1]); P[B + 2] = ex2(P[B + 2]); P[B + 3] = ex2(P[B + 3]); } while (0)
#define FOX_SUM4(P, B) do { sacc = fadd_s(sacc, P[B]); sacc = fadd_s(sacc, P[B + 1]); sacc = fadd_s(sacc, P[B + 2]); sacc = fadd_s(sacc, P[B + 3]); } while (0)
    fox_init(n0, n1, bpn, m);
    n0 = mfma32(x0, qf[0], n0); FOX_EX4(c0, 0);  x0 = FOX_KF(3); SBAR();
    n1 = mfma32(x1, qf[0], n1); FOX_EX4(c0, 4);  x1 = FOX_KF(4); SBAR();
    n0 = mfma32(x2, qf[1], n0); FOX_EX4(c0, 8);  x2 = FOX_KF(5); SBAR();
    n1 = mfma32(x0, qf[1], n1); FOX_EX4(c0, 12); x0 = FOX_KF(6); SBAR();
    n0 = mfma32(x1, qf[2], n0); FOX_EX4(c1, 0);  x1 = FOX_KF(7); SBAR();
    n1 = mfma32(x2, qf[2], n1); FOX_EX4(c1, 4);  x2 = FOX_VFR(0); SBAR();
    n0 = mfma32(x0, qf[3], n0); FOX_EX4(c1, 8);  x0 = FOX_VFR(1); SBAR();
    n1 = mfma32(x1, qf[3], n1); FOX_EX4(c1, 12); x1 = FOX_VFR(2); SBAR();
    float sacc = fadd_s(c0[0], c0[1]);
    bf16x8 a0 = pack8<0>(c0), a1; SBAR();
#define FOX_MOV4(DST, SRC, B) do { DST[B] = SRC[B]; DST[B + 1] = SRC[B + 1]; DST[B + 2] = SRC[B + 2]; DST[B + 3] = SRC[B + 3]; } while (0)
    o0 = mfma32(a0, x2, o0); sacc = fadd_s(sacc, c0[2]); sacc = fadd_s(sacc, c0[3]); FOX_SUM4(c0, 4); a1 = pack8<1>(c0); x2 = FOX_VFR(3); SBAR();
    o1 = mfma32(a0, x0, o1); FOX_SUM4(c0, 8); FOX_SUM4(c0, 12); x0 = FOX_VFR(4); SBAR();
    o0 = mfma32(a1, x1, o0); a0 = pack8<0>(c1); FOX_MOV4(c0, n0, 0); FOX_MOV4(c0, n0, 4); x1 = FOX_VFR(5); SBAR();
    o1 = mfma32(a1, x2, o1); FOX_SUM4(c1, 0); FOX_SUM4(c1, 4); FOX_MOV4(c0, n0, 8); x2 = FOX_VFR(6); SBAR();
    o0 = mfma32(a0, x0, o0); a1 = pack8<1>(c1); FOX_SUM4(c1, 8); FOX_MOV4(c0, n0, 12); x0 = FOX_VFR(7); SBAR();
    o1 = mfma32(a0, x1, o1); FOX_SUM4(c1, 12); FOX_MOV4(c1, n1, 0); FOX_MOV4(c1, n1, 4); SBAR();
    o0 = mfma32(a1, x2, o0); FOX_MOV4(c1, n1, 8); FOX_MOV4(c1, n1, 12); SBAR();
    o1 = mfma32(a1, x0, o1); SBAR();
#undef FOX_MOV4
    l += sacc;
#undef FOX_KF
#undef FOX_VFR
#undef FOX_EX4
#undef FOX_SUM4
}
struct FoxCtx { int nt, qlim, qlim_min, hh, r; bool active; const LAS uchar *kb0, *vb0; const LAS float* biasl; LAS float* scr; LAS uchar* lds; int kdst, vdst; const bf16 *ksrc, *vsrc; };
DI void fox_ring(const FoxCtx& X, int t, int bwr, u32x4& rk, u32x4& rv) {
    using namespace fox;
    *(LAS u32x4*)(X.lds + X.kdst + bwr * KB) = rk; *(LAS u32x4*)(X.lds + X.vdst + bwr * VB) = rv;
    __syncthreads();
    const int tl = t - 3 > 0 ? t - 3 : 0;
    rk = *(const u32x4*)(X.ksrc + (size_t)64 * tl * D); rv = *(const u32x4*)(X.vsrc + (size_t)64 * tl * D);
}
DI void fox_step(const FoxCtx& X, int s, int bcur, int bnext, int bwr, f32x16& c0, f32x16& c1, f32x16& n0, f32x16& n1, f32x16& o0, f32x16& o1, float& l, float& m,
                 const bf16x8 (&qf)[4], u32x4& rk, u32x4& rv) {
    using namespace fox;
    const int nt = X.nt, t = nt - 1 - s, hh = X.hh;
    {
        const bool vis = 64 * t <= X.qlim_min, visn = 64 * (t - 1) <= X.qlim_min;
        const LAS f32x4* bpn = (const LAS f32x4*)(X.biasl + 64 * (t - 1) + 4 * hh);
        if (vis) {
            const LAS uchar* kbn = X.kb0 + bnext * KB;
            const bf16x8 x0 = ldsv(kbn), x1 = ldsv(kbn + 32 * KPI), x2 = ldsv(kbn + 32);
            if (64 * t + 63 > X.qlim_min) {
#pragma unroll
                for (int i = 0; i < 16; ++i) { const int key = 64 * t + crow(i, hh); if (key > X.qlim) c0[i] = -INFINITY; if (key + 32 > X.qlim) c1[i] = -INFINITY; }
            }
            asm volatile("s_nop 15\n\ts_nop 7" : "+v"(c0), "+v"(c1));
            float mx = max3f(c0[0], c1[0], c0[1]), mx2 = max3f(c1[1], c0[2], c1[2]);
#pragma unroll
            for (int i = 3; i < 15; i += 2) { mx = max3f(mx, c0[i], c1[i]); mx2 = max3f(mx2, c0[i + 1], c1[i + 1]); }
            mx = max3f(mx, c0[15], c1[15]); mx = max3f(mx, mx2, mx2);
            { auto rr = __builtin_amdgcn_permlane32_swap(__float_as_uint(mx), __float_as_uint(mx), false, false); mx = max3f(__uint_as_float(rr[0]), __uint_as_float(rr[1]), __uint_as_float(rr[1])); }
            if (__builtin_expect(__any(mx > 16.f), 0)) {
                const float d = fmaxf(mx, 0.f), f = ex2(-d); m += d; l *= f;
#pragma unroll
                for (int i = 0; i < 16; ++i) { c0[i] -= d; c1[i] -= d; }
                if (hh == 0) X.scr[X.r] = f;
                asm volatile("s_waitcnt lgkmcnt(0)" ::: "memory");
#pragma unroll
                for (int g = 0; g < 4; ++g) { const f32x4 fv = *(const LAS f32x4*)(X.scr + 8 * g + 4 * hh);
#pragma unroll
                    for (int j = 0; j < 4; ++j) { o0[4 * g + j] *= fv[j]; o1[4 * g + j] *= fv[j]; } }
                asm volatile("s_waitcnt lgkmcnt(0)" ::: "memory");
            }
            fox_hot(c0, c1, n0, n1, o0, o1, l, m, kbn, X.vb0 + bcur * VB, bpn, qf, x0, x1, x2);
        } else if (visn) {
            fox_init(n0, n1, bpn, m); fox_qk_plain(n0, n1, X.kb0 + bnext * KB, qf); c0 = n0; c1 = n1;
        }
    }
    fox_ring(X, t, bwr, rk, rv);
}
DI void fox_unit(LAS uchar* lds, const bf16* Qg, const bf16* K2B, const bf16* V2B, bf16* Og, size_t qrow0, int nq, size_t krow0, int nt, int qlim0, int h, const float* biasg) {
    using namespace fox;
    int tid_ = threadIdx.x; asm volatile("" : "+v"(tid_));
    const int tid = tid_, lane = tid & 63, w = __builtin_amdgcn_readfirstlane(tid >> 6), r = lane & 31, hh = lane >> 5;
    const int q4 = (lane & 15) >> 2, p4 = lane & 3, blk = (lane >> 4) & 1;
    FoxCtx X;
    X.nt = nt; X.hh = hh; X.r = r; X.lds = lds;
    X.active = 32 * w < nq;
    __syncthreads();
    const bool bp0 = tid < nt * 16, bp1 = tid + NTHR < nt * 16;
    const f32x4 bias0 = bp0 ? ((const f32x4*)biasg)[tid] : (f32x4){0.f, 0.f, 0.f, 0.f}, bias1 = bp1 ? ((const f32x4*)biasg)[tid + NTHR] : (f32x4){0.f, 0.f, 0.f, 0.f};
    X.ksrc = K2B + (krow0 + (tid >> 3)) * D + h * 64 + (tid & 7) * 8;
    X.vsrc = V2B + (krow0 + (tid >> 3)) * D + h * 64 + (tid & 7) * 8;
    X.kdst = OFF_K + (tid >> 3) * KPI + (tid & 7) * 16; X.vdst = OFF_V + (tid >> 3) * VPI + (tid & 7) * 16;
    u32x4 rk = *(const u32x4*)(X.ksrc + (size_t)64 * (nt - 1) * D), rv = *(const u32x4*)(X.vsrc + (size_t)64 * (nt - 1) * D);
    u32x4 rk1 = rk, rv1 = rv;
    if (nt > 1) { rk1 = *(const u32x4*)(X.ksrc + (size_t)64 * (nt - 2) * D); rv1 = *(const u32x4*)(X.vsrc + (size_t)64 * (nt - 2) * D); }
    bf16x8 qf[4];
    {
        const bf16* qp = Qg + (qrow0 + (X.active ? 32 * w + r : 0)) * D + h * 64 + hh * 8;
#pragma unroll
        for (int kk = 0; kk < 4; ++kk) qf[kk] = *(const bf16x8*)(qp + kk * 16);
    }
    if (bp0) *(LAS f32x4*)(lds + OFF_BIAS + tid * 16) = bias0;
    if (bp1) *(LAS f32x4*)(lds + OFF_BIAS + (tid + NTHR) * 16) = bias1;
    *(LAS u32x4*)(lds + X.kdst) = rk; *(LAS u32x4*)(lds + X.vdst) = rv;
    *(LAS u32x4*)(lds + X.kdst + KB) = rk1; *(LAS u32x4*)(lds + X.vdst + VB) = rv1;
    { const int tl = nt > 2 ? nt - 3 : 0; rk = *(const u32x4*)(X.ksrc + (size_t)64 * tl * D); rv = *(const u32x4*)(X.vsrc + (size_t)64 * tl * D); }
    float l = 0.f; f32x16 o0, o1;
#pragma unroll
    for (int i = 0; i < 16; ++i) { o0[i] = 0.f; o1[i] = 0.f; }
    X.qlim = X.active ? qlim0 + 32 * w + r : 0; X.qlim_min = qlim0 + 32 * w;
    X.scr = (LAS float*)(lds + OFF_SCR + w * 256);
    X.kb0 = lds + OFF_K + r * KPI + hh * 16;
    X.vb0 = lds + OFF_V + (4 * hh + q4) * VPI + (16 * blk + 4 * p4) * 2;
    X.biasl = (const LAS float*)(lds + OFF_BIAS);
    __syncthreads();
    float m = X.biasl[X.qlim];
    f32x16 pa0, pa1, pb0, pb1;
#pragma unroll
    for (int i = 0; i < 16; ++i) { pa0[i] = 0.f; pa1[i] = 0.f; pb0[i] = 0.f; pb1[i] = 0.f; }
    if (X.active && 64 * (nt - 1) <= X.qlim_min) { fox_init(pa0, pa1, (const LAS f32x4*)(X.biasl + 64 * (nt - 1) + 4 * hh), m); fox_qk_plain(pa0, pa1, X.kb0, qf); }
    int b0 = 0, b1 = 1, b2 = 2;
    if (w >= 4) __builtin_amdgcn_s_setprio(1);
    if (X.active) {
#pragma unroll 1
        for (int s = 0; s < nt; ++s) {
            fox_step(X, s, b0, b1, b2, pa0, pa1, pb0, pb1, o0, o1, l, m, qf, rk, rv);
            { const int tb = b0; b0 = b1; b1 = b2; b2 = tb; }
        }
    } else {
#pragma unroll 1
        for (int s = 0; s < nt; ++s) { fox_ring(X, nt - 1 - s, b2, rk, rv); { const int tb = b0; b0 = b1; b1 = b2; b2 = tb; } }
    }
    __builtin_amdgcn_s_setprio(0);
    if (X.active) {
        l += __shfl_xor(l, 32);
        if (hh == 0) X.scr[32 + r] = l;
        asm volatile("s_waitcnt lgkmcnt(0)" ::: "memory");
        bf16* op = Og + (qrow0 + 32 * w) * D + h * 64 + r;
#pragma unroll
        for (int g = 0; g < 4; ++g) { const f32x4 lv = *(const LAS f32x4*)(X.scr + 32 + 8 * g + 4 * hh);
#pragma unroll
            for (int j = 0; j < 4; ++j) { const float inv = 1.0f / lv[j]; const int c = 8 * g + 4 * hh + j;
                op[(size_t)c * D] = (bf16)(pk(o0[4 * g + j] * inv, 0.f) & 0xffffu); op[(size_t)c * D + 32] = (bf16)(pk(o1[4 * g + j] * inv, 0.f) & 0xffffu); } }
    }
}

#define XB_TMO      128
#define XB_XCNT(j)  (256  + 64 * (j))
#define XB_XSUB(j)  (1280 + 64 * (j))
#define XB_XGEN(j)  (2304 + 64 * (j))
#define XB_TOP      3328
#define XB_TOPGEN   3392
#define XCD_BAR_WORDS 3456
#define XB_SPIN_CAP (1u << 18)

__device__ __forceinline__ unsigned xb_ld(unsigned* p)              { return __hip_atomic_load(p, __ATOMIC_RELAXED, __HIP_MEMORY_SCOPE_AGENT); }
__device__ __forceinline__ unsigned xb_add(unsigned* p, unsigned v) { return __hip_atomic_fetch_add(p, v, __ATOMIC_RELAXED, __HIP_MEMORY_SCOPE_AGENT); }
__device__ __forceinline__ unsigned xb_xcc_id() { return (unsigned)__builtin_amdgcn_s_getreg((3 << 11) | 20) & 0xFu; }
#define XB_SPIN(cond, bar) do { unsigned _sp = 0; while (cond) { __builtin_amdgcn_s_sleep(1); \
    if ((++_sp & 255u) == 0u) { if (xb_ld(&(bar)[XB_TMO])) break; if (_sp > XB_SPIN_CAP) { atomicAdd(&(bar)[XB_TMO], 1u); break; } } } } while (0)

struct XcdBarrier {
    unsigned* bar; unsigned x;
    volatile LAS unsigned* st;
};

__device__ __forceinline__ XcdBarrier xcd_barrier_post(unsigned* bar, volatile LAS unsigned* st) {
    XcdBarrier b; b.bar = bar; b.x = xb_xcc_id(); b.st = st;
    if (threadIdx.x == 0) (void)xb_add(&bar[XB_XCNT(b.x)], 1u);
    return b;
}
__device__ __forceinline__ void xcd_barrier_complete(unsigned* bar, unsigned x, unsigned& nloc, unsigned& nx) {
    const unsigned G = gridDim.x * gridDim.y * gridDim.z;
    unsigned sum, cnt, mine, sp = 0u;
    for (;;) {
        sum = 0u; cnt = 0u; mine = 0u;
#pragma unroll
        for (unsigned j = 0; j < 16; ++j) { const unsigned c = xb_ld(&bar[XB_XCNT(j)]); sum += c; cnt += (c > 0u) ? 1u : 0u; mine = (j == x) ? c : mine; }
        if (sum == G) break;
        __builtin_amdgcn_s_sleep(1);
        if ((++sp & 255u) == 0u) { if (xb_ld(&bar[XB_TMO])) break; if (sp > XB_SPIN_CAP) { atomicAdd(&bar[XB_TMO], 1u); break; } }
    }
    nloc = mine > 0u ? mine : 1u; nx = cnt > 0u ? cnt : 1u;
}

__device__ __forceinline__ void xcd_barrier(const XcdBarrier& b) {
    asm volatile("s_waitcnt vmcnt(0)" ::: "memory");
    __syncthreads();
    if (threadIdx.x == 0) {
        unsigned* bar = b.bar;
        __builtin_amdgcn_s_waitcnt(0);
        unsigned nloc = b.st[0], nx = b.st[1];
        if (nloc == 0u) { xcd_barrier_complete(bar, b.x, nloc, nx); b.st[0] = nloc; b.st[1] = nx; }
        const unsigned old = xb_add(&bar[XB_XSUB(b.x)], 1u);
        const unsigned gen = old / nloc;
        if (old + 1u == (gen + 1u) * nloc) {
            __builtin_amdgcn_fence(__ATOMIC_RELEASE, "agent");
            asm volatile("s_waitcnt vmcnt(0)" ::: "memory");
            const unsigned og = xb_add(&bar[XB_TOP], 1u);
            const unsigned tg = og / nx;
            if (og + 1u == (tg + 1u) * nx) xb_add(&bar[XB_TOPGEN], 1u);
            else XB_SPIN(xb_ld(&bar[XB_TOPGEN]) == tg, bar);
            __builtin_amdgcn_fence(__ATOMIC_ACQUIRE, "agent");
            xb_add(&bar[XB_XGEN(b.x)], 1u);
            asm volatile("s_waitcnt vmcnt(0)" ::: "memory");
        } else {
            XB_SPIN(xb_ld(&bar[XB_XGEN(b.x)]) == gen, bar);
            __builtin_amdgcn_fence(__ATOMIC_ACQUIRE, "agent");
            asm volatile("s_waitcnt vmcnt(0)" ::: "memory");
        }
    }
    __syncthreads();
}

constexpr int XB_WS_OFF = 65536, XB_LDS_OFF = LDS_BYTES - 64, CTL_ZERO_BYTES = 262144;

template <int ONLY> __global__ void __launch_bounds__(NTHR, 2) yoco_fwd_t(Params P) {
    extern __shared__ __attribute__((aligned(16))) unsigned char lds_raw[];
    LAS uchar* lds = (LAS uchar*)lds_raw;
    if (threadIdx.x < 16) ((LAS unsigned*)(lds + XB_LDS_OFF))[threadIdx.x] = 0u;
    __syncthreads();
    if (P.ph_hi - P.ph_lo > 1) (void)xcd_barrier_post((unsigned*)(P.ws + XB_WS_OFF), (volatile LAS unsigned*)(lds + XB_LDS_OFF));
    if (P.ph_lo == 0) {
        const int lane0 = threadIdx.x & 63, wave0 = threadIdx.x >> 6;
        rope_table(P.ws, blockIdx.x * NWAVES + wave0, gridDim.x * NWAVES, lane0);
    }
    for (int step = P.ph_lo; step < P.ph_hi; ++step) {
        const int ph = P.prog[step];
        int tid_ = threadIdx.x; asm volatile("" : "+v"(tid_));
        const int tid = tid_;
#define LWG() const int lane = tid & 63, wave = __builtin_amdgcn_readfirstlane(tid >> 6); const int gw = bx * NWAVES + wave, NGW = G * NWAVES; (void)lane; (void)gw; (void)NGW
        int G_ = gridDim.x, bx_ = blockIdx.x; asm volatile("" : "+s"(G_), "+s"(bx_));
        const int G = G_, bx = bx_;
        uchar* ws = P.ws; float* out = P.out; int zz = 0;
        asm volatile("" : "+s"(ws), "+s"(out), "+s"(zz));
#define PIN(i) (P.in[(i) + zz])
        float* H = out + O_Y; bf16* HB = (bf16*)(ws + WS_HB); float* ssq = (float*)(ws + WS_SSQ);
        bf16* HID = (bf16*)(ws + WS_R + R_HID);
        bf16* RQ = (bf16*)(out + O_KP); bf16* RK = RQ + (size_t)T * D;
        bf16* VO = (bf16*)(ws + WS_R + R_VO); bf16* GG = (bf16*)(ws + WS_R + R_G);
        bf16* QF = (bf16*)(ws + WS_R + R_QF); bf16* K2B = (bf16*)(ws + WS_R + R_K2B); bf16* V2B = (bf16*)(ws + WS_R + R_V2B);
        float* biasP = (float*)(ws + WS_BIASP); float* biasS = (float*)(ws + WS_BIASS);
        const float* rope = (const float*)(ws + WS_ROPE);
        int kind, f = 0;
        switch (ph) {
            case 0: kind = 0; break;
            case 1: kind = 1; f = 0; break;   case 2: kind = 2; f = 0; break;
            case 3: kind = 3; break;          case 4: kind = 4; break;        case 5: kind = 5; break;
            case 6: kind = 2; f = 4; break;
            case 7: kind = 1; f = 1; break;   case 8: kind = 2; f = 1; break;
            case 9: kind = 6; break;          case 10: kind = 7; break;
            case 11: kind = 1; f = 2; break;  case 12: kind = 2; f = 2; break;
            case 13: kind = 8; break;         case 14: kind = 9; break;
            case 15: kind = 2; f = 5; break;
            case 16: kind = 1; f = 3; break;  case 17: kind = 2; f = 3; break;
            case 20: kind = 11; break;
            case 19: kind = 2; f = 8; break;
            default: kind = 10; break;
        }
        if (KSEL(0) && kind == 0) {
            LWG();
            phase_prologue(P, ws, out, lds, gw, NGW, wave, lane);
        } else if (KSEL(1) && kind == 1) {
            pg8::Gemm g{HB, (const bf16*)(ws + WS_WIN + f * SZ_WIN), T, 2 * FF, D}; pg8::StaticOrder S; S.init(T, 2 * FF, G, bx);
            rstd_prepass(lds, ssq, S, tid); pg8::EpiSwiGLU E{HID, (const LAS float*)(lds + RL_OFF)};
            pg8::gemm_phase<pg8::EpiSwiGLU, pg8::StaticOrder, true, true>(lds, g, S, E);
        } else if (KSEL(2) && kind == 2) {
            const bf16* A; const bf16* Bt; int K; float alpha;
            if (f == 8) { A = HID; Bt = (const bf16*)(ws + WS_WOUT); K = FF; alpha = 0.0f; }
            else if (f < 4) { A = HID; Bt = (const bf16*)(ws + WS_WOUT + f * SZ_WOUT); K = FF; alpha = 0.5f; }
            else if (f == 4) { A = VO; Bt = (const bf16*)(ws + WS_ROUT); K = 2048; alpha = 1.0f; }
            else { A = QF; Bt = (const bf16*)(ws + WS_WO); K = D; alpha = 1.0f; }
            pg8::Gemm g{A, Bt, T, D, K}; pg8::StaticOrder S; S.init(T, D, G, bx);
            pg8::EpiRes E{HB, ssq, alpha};
            pg8::gemm_phase<pg8::EpiRes, pg8::StaticOrder, true, true>(lds, g, S, E);
        } else if (KSEL(3) && kind == 3) {
            pg8::Gemm g{HB, (const bf16*)(ws + WS_RIN), T, 6144, D}; pg8::StaticOrder S; S.init(T, 6144, G, bx);
            rstd_prepass(lds, ssq, S, tid); pg8::EpiRetIn E{RQ, RK, VO, GG, (const LAS float*)(lds + RL_OFF), rope};
            pg8::gemm_phase<pg8::EpiRetIn, pg8::StaticOrder, true, true>(lds, g, S, E);
        } else if (KSEL(4) && kind == 4) {
            for (int it = bx; it < 256 + 512; it += G) {
                const bool samp = it >= 256; const int q = samp ? it - 256 : it;
                const int sl = q & 3, h = (q >> 2) & 3, b = q >> 4;
                const float lg2 = h == 0 ? -0.04580368961312479f : h == 1 ? -0.02272007650008353f : h == 2 ? -0.011315313227834146f : -0.005646563141142063f;
                const size_t rowbase = samp ? (size_t)TP + (size_t)b * DSEQ : (size_t)b * SEQ;
                const float* S0 = samp ? PIN(2) + (size_t)(b * 4 + h) * 256 * 512 : nullptr;
                float* Sout = out + (samp ? O_SRS : O_SRP) + (size_t)(b * 4 + h) * 256 * 512;
                ret_item(lds, RQ, RK, VO, rowbase, h, sl, samp ? 1 : 64, S0, Sout, lg2);
            }
        } else if (KSEL(5) && kind == 5) {
            LWG();
            const float* gn = PIN(14); (void)gn;
            constexpr int NR = 4;
            for (int row0 = gw; row0 < T; row0 += NR * NGW) {
                u32x4 ov[NR][4], gv[NR][4];
#pragma unroll
                for (int u = 0; u < NR; ++u) { const int row = row0 + u * NGW < T ? row0 + u * NGW : row0;
                    const u32x4* op = (const u32x4*)(VO + (size_t)row * 2048 + lane * 32); const u32x4* gp = (const u32x4*)(GG + (size_t)row * 2048 + lane * 32);
#pragma unroll
                    for (int i = 0; i < 4; ++i) { ov[u][i] = op[i]; gv[u][i] = gp[i]; } }
#pragma unroll
                for (int u = 0; u < NR; ++u) {
                    const int row = row0 + u * NGW; if (row >= T) break;
                    float s = 0.f, s2 = 0.f;
#pragma unroll
                    for (int i = 0; i < 4; ++i)
#pragma unroll
                        for (int j = 0; j < 4; ++j) { const float a = bflo(ov[u][i][j]), bq = bfhi(ov[u][i][j]); s += a + bq; s2 += a * a + bq * bq; }
#pragma unroll
                    for (int o = 1; o < 16; o <<= 1) { s += __shfl_xor(s, o); s2 += __shfl_xor(s2, o); }
                    const float mu = s * (1.f / 512.f), var = fmaxf(s2 * (1.f / 512.f) - mu * mu, 0.f), rstd = __builtin_amdgcn_rsqf(var + EPS);
                    u32x4* op = (u32x4*)(VO + (size_t)row * 2048 + lane * 32);
#pragma unroll
                    for (int i = 0; i < 4; ++i) { u32x4 w;
#pragma unroll
                        for (int j = 0; j < 4; ++j) w[j] = pk((bflo(ov[u][i][j]) - mu) * rstd * bflo(gv[u][i][j]), (bfhi(ov[u][i][j]) - mu) * rstd * bfhi(gv[u][i][j]));
                        op[i] = w; }
                }
            }
        } else if (KSEL(6) && kind == 6) {
            pg8::Gemm g{HB, (const bf16*)(ws + WS_KVF), T, 2304, D}; pg8::StaticOrder S; S.init(T, 2304, G, bx);
            rstd_prepass(lds, ssq, S, tid); pg8::EpiKVF E{out, K2B, V2B, (const LAS float*)(lds + RL_OFF), PIN(18)};
            pg8::gemm_phase<pg8::EpiKVF, pg8::StaticOrder, true, true>(lds, g, S, E);
        } else if (KSEL(7) && kind == 7) {
            LWG();
            {
                const int gt = gw * 64 + lane, NGT = NGW * 64;
                constexpr int NPIECE = NB_S * PAST * D / 8; const float* in3 = PIN(3); const float* in4 = PIN(4);
                for (int p0 = gt; p0 < 2 * NPIECE; p0 += 4 * NGT) {
                    f32x4 a[4], bq[4];
#pragma unroll
                    for (int u = 0; u < 4; ++u) { const int p = p0 + u * NGT < 2 * NPIECE ? p0 + u * NGT : p0; const bool isv = p >= NPIECE; const int q = isv ? p - NPIECE : p;
                        const float* src = (isv ? in4 : in3) + (size_t)(q >> 7) * D + (q & 127) * 8; a[u] = __builtin_nontemporal_load((const f32x4*)src); bq[u] = __builtin_nontemporal_load((const f32x4*)(src + 4)); }
#pragma unroll
                    for (int u = 0; u < 4; ++u) { const int p = p0 + u * NGT; if (p >= 2 * NPIECE) break; const bool isv = p >= NPIECE; const int q = isv ? p - NPIECE : p;
                        const int row = q >> 7, c8 = q & 127; const int b_ = row >> 10, s = row & 1023;
                        u32x4 w; w[0] = pk(a[u][0], a[u][1]); w[1] = pk(a[u][2], a[u][3]); w[2] = pk(bq[u][0], bq[u][1]); w[3] = pk(bq[u][2], bq[u][3]);
                        *(u32x4*)((isv ? V2B : K2B) + ((size_t)TP + (size_t)b_ * KSAMP + s) * D + c8 * 8) = w; }
                }
            }

            for (int seq = bx; seq < 768; seq += G) {
                const bool samp = seq >= 256; const int ss = samp ? seq - 256 : seq; const int b_ = ss >> 4, h = ss & 15;
                const int L = samp ? KSAMP : SEQ, n = samp ? 3 : 8, s0 = tid * n;
                float* dst = samp ? biasS + (size_t)ss * KSAMP : biasP + (size_t)ss * SEQ;
                float v[8]; float sum = 0.f;
#pragma unroll
                for (int i = 0; i < 8; ++i) { const int s = s0 + i; float x = 0.f;
                    if (i < n && s < L) x = samp ? (s < PAST ? PIN(5)[((size_t)b_ * PAST + s) * 16 + h] : out[O_LFS + ((size_t)b_ * DSEQ + (s - PAST)) * 16 + h]) : out[O_LFP + ((size_t)b_ * SEQ + s) * 16 + h];
                    sum += x; v[i] = sum; }
                float inc = sum;
#pragma unroll
                for (int o = 1; o < 64; o <<= 1) { const float t = __shfl_up(inc, o); if (lane >= o) inc += t; }
                LAS float* wt = (LAS float*)lds;
                __syncthreads();
                if (lane == 63) wt[wave] = inc;
                __syncthreads();
                float base = inc - sum;
#pragma unroll
                for (int w2 = 0; w2 < 8; ++w2) if (w2 < wave) base += wt[w2];
#pragma unroll
                for (int i = 0; i < 8; ++i) { const int s = s0 + i; if (i < n && s < L) dst[s] = -(base + v[i]) * LOG2E; }
            }
        } else if (KSEL(8) && kind == 8) {
            pg8::Gemm g{HB, (const bf16*)(ws + WS_WQ), T, D, D}; pg8::StaticOrder S; S.init(T, D, G, bx);
            rstd_prepass(lds, ssq, S, tid); pg8::EpiQ E{QF, (const LAS float*)(lds + RL_OFF)};
            pg8::gemm_phase<pg8::EpiQ, pg8::StaticOrder, true, true>(lds, g, S, E);
        } else if (KSEL(9) && kind == 9) {
            for (int u = bx; u < 4096 + 512; u += G) {
                const bool samp = u >= 4096; const int us = u - 4096;
                int bh = samp ? us : (u & 255), qb = 15 - (u >> 8);
                if (!samp && G == 256) {
                    const int k = u >> 8, xcd = bx & 7, idx = bx >> 3, g = idx >> 2, mem = idx & 3, rr = k >> 2, kk = k & 3;
                    bh = xcd * 32 + rr * 8 + g; qb = kk == 0 ? 15 - mem : kk == 1 ? 11 - mem : kk == 2 ? mem + 4 : mem;
                }
                const int b_ = bh >> 4, h = bh & 15;
                const size_t qrow0 = samp ? (size_t)TP + b_ * DSEQ : (size_t)b_ * SEQ + qb * 256;
                const size_t krow0 = samp ? (size_t)TP + (size_t)b_ * KSAMP : (size_t)b_ * SEQ;
                fox_unit(lds, QF, K2B, V2B, QF, qrow0, samp ? 64 : 256, krow0, samp ? 17 : 4 * (qb + 1), samp ? PAST : qb * 256, h,
                         samp ? biasS + (size_t)us * KSAMP : biasP + (size_t)bh * SEQ);
            }
        } else if (KSEL(10) && kind == 10) {
            LWG();
            const float* fg = PIN(21);
            constexpr int NR = 4;
            for (int row0 = gw; row0 < T; row0 += NR * NGW) {
                u32x2 hv[NR][4]; float rsv[NR];
#pragma unroll
                for (int u = 0; u < NR; ++u) { const int row = row0 + u * NGW < T ? row0 + u * NGW : row0; const u32x2* bp = (const u32x2*)(HB + (size_t)row * D);
#pragma unroll
                    for (int j = 0; j < 4; ++j) hv[u][j] = bp[lane + 64 * j];
                    rsv[u] = row_rstd(ssq, row); }
#pragma unroll
                for (int u = 0; u < NR; ++u) {
                    const int row = row0 + u * NGW; if (row >= T) break;
                    f32x4* hp = (f32x4*)(H + (size_t)row * D); const float rs = rsv[u];
#pragma unroll
                    for (int j = 0; j < 4; ++j) { const u32x2 x = hv[u][j]; const f32x4 v = {bflo(x[0]), bfhi(x[0]), bflo(x[1]), bfhi(x[1])}, gq = ((const f32x4*)fg)[lane + 64 * j]; __builtin_nontemporal_store(v * rs * gq, hp + lane + 64 * j); }
                }
            }
        }
        if (step + 1 < P.ph_hi) { if (P.ph_lo < 0) cg::this_grid().sync(); else { XcdBarrier xb; xb.bar = (unsigned*)(ws + XB_WS_OFF); xb.x = xb_xcc_id(); xb.st = (volatile LAS unsigned*)(lds + XB_LDS_OFF); xcd_barrier(xb); } }
    }
}

#ifdef DIAG
template __global__ void yoco_fwd_t<0>(Params); template __global__ void yoco_fwd_t<1>(Params); template __global__ void yoco_fwd_t<2>(Params); template __global__ void yoco_fwd_t<3>(Params);
template __global__ void yoco_fwd_t<4>(Params); template __global__ void yoco_fwd_t<5>(Params); template __global__ void yoco_fwd_t<6>(Params); template __global__ void yoco_fwd_t<7>(Params);
template __global__ void yoco_fwd_t<8>(Params); template __global__ void yoco_fwd_t<9>(Params); template __global__ void yoco_fwd_t<10>(Params);
#endif
#define yoco_fwd yoco_fwd_t<-1>
#ifndef MK_ONE_LAUNCH
#define MK_ONE_LAUNCH 1
#endif
constexpr int N_PHASES = 19;
extern "C" void kernel_launch(void* const* d_in, const int* in_sizes, int n_in, void* d_out, int out_size, void* d_ws, size_t ws_size, hipStream_t stream) {
    static int grid = 0;
    if (grid == 0) {
        if (n_in != 22 || ws_size < WS_END) { fprintf(stderr, "kernel_launch: unexpected n_in %d / ws %zu\n", n_in, ws_size); grid = -1; return; }
        int dev = 0, cus = 0, per_cu = 0;
        hipGetDevice(&dev); hipDeviceGetAttribute(&cus, hipDeviceAttributeMultiprocessorCount, dev);
        if (hipFuncSetAttribute((const void*)yoco_fwd, hipFuncAttributeMaxDynamicSharedMemorySize, LDS_BYTES) != hipSuccess) { fprintf(stderr, "kernel_launch: hipFuncSetAttribute failed\n"); grid = -1; return; }
        if (hipOccupancyMaxActiveBlocksPerMultiprocessor(&per_cu, (const void*)yoco_fwd, NTHR, LDS_BYTES) != hipSuccess || per_cu < 1) { fprintf(stderr, "kernel_launch: occupancy query says %d\n", per_cu); per_cu = 1; }
        (void)hipGetLastError();
        grid = cus * 1;
    }
    if (grid < 0) return;
    Params p{};
    for (int i = 0; i < 22; ++i) p.in[i] = (const float*)d_in[i];
    p.out = (float*)d_out; p.ws = (unsigned char*)d_ws;
#ifndef MK_PROG
#define MK_PROG 0,1,2,3,4,5,6,7,8,9,10,11,12,13,14,15,16,17,18
#endif
    const unsigned char prog[] = {MK_PROG}; const int nprog = (int)sizeof(prog);
    for (int i = 0; i < nprog && i < 32; ++i) p.prog[i] = prog[i];
#if MK_ONE_LAUNCH
    if (hipMemsetAsync(d_ws, 0, CTL_ZERO_BYTES, stream) != hipSuccess) { fprintf(stderr, "kernel_launch: hipMemsetAsync failed\n"); return; }
    p.ph_lo = 0; p.ph_hi = nprog;
    void* args[] = {&p};
    hipError_t e = hipLaunchCooperativeKernel((const void*)yoco_fwd, dim3(grid), dim3(NTHR), args, LDS_BYTES, stream);
    if (e != hipSuccess) fprintf(stderr, "cooperative launch failed: %s (grid %d)\n", hipGetErrorString(e), grid);
#else
    for (int ph = 0; ph < nprog; ++ph) { p.ph_lo = ph; p.ph_hi = ph + 1; hipLaunchKernelGGL(yoco_fwd, dim3(grid), dim3(NTHR), LDS_BYTES, stream, p); }
#endif
}
```

```cpp
#include <hip/hip_runtime.h>
#include <cstdio>
#include <cstdint>
namespace pg8 {
#define PG8_LAS __attribute__((address_space(3)))
typedef unsigned short bf16_t;
typedef short bf16x8 __attribute__((ext_vector_type(8)));
typedef float f32x4 __attribute__((ext_vector_type(4)));
typedef unsigned u32x4 __attribute__((ext_vector_type(4)));
constexpr int BM = 256, BK = 64, HALF = 128, HTB = HALF * BK * 2  , STAGE_BYTES = 8 * HTB, NXCD = 8, WGM = 8;

__host__ __device__ __forceinline__ int lds_byte(int r, int c) { const int st = (r >> 4) * 2 + (c >> 5), rr = r & 15, cc = c & 31, ob = rr * 64 + cc * 2; return st * 1024 + (ob ^ (((ob >> 9) & 1) << 5)); }
__host__ __device__ __forceinline__ void stage_rc(int b, int& R, int& C) { const int st = b / 1024, sb = b % 1024, swz = sb ^ (((sb >> 9) & 1) << 5); R = (st >> 1) * 16 + swz / 64; C = (st & 1) * 32 + (swz % 64) / 2; }
__host__ __device__ __forceinline__ int perm32(int rho) { const int n = rho >> 4, i = rho & 15; return 8 * (i >> 2) + 4 * n + (i & 3); }

struct Unit { int pm, pn; };
struct Gemm { const bf16_t* A; const bf16_t* Bt; int M, N, K; };

struct StaticOrder {
    int nM, nN, nwg, G, c;
    __host__ __device__ void init(int M, int N, int G_, int c_) { nM = M / BM; nN = N / BM; nwg = nM * nN; G = G_; c = c_; }
    __host__ __device__ bool next(int i, Unit& u) const {
        const long L = (long)i * G + c; if (L >= nwg) return false;
        int wgid = (int)L; { const int q = nwg / NXCD, r = nwg % NXCD, xcd = wgid % NXCD, off = wgid / NXCD; wgid = (xcd < r ? xcd * (q + 1) : r * (q + 1) + (xcd - r) * q) + off; }
        const int nig = WGM * nN, gid = wgid / nig, fm = gid * WGM, gsz = (nM - fm) < WGM ? (nM - fm) : WGM;
        u.pm = fm + ((wgid % nig) % gsz); u.pn = (wgid % nig) / gsz; return true;
    }
    __device__ __forceinline__ void a_ready(const Unit&) const {}
    __device__ __forceinline__ void done(const Unit&) const {}
};

__device__ __forceinline__ unsigned cvt_pk_bf16(float lo, float hi) { unsigned r; asm volatile("v_cvt_pk_bf16_f32 %0, %1, %2" : "=v"(r) : "v"(lo), "v"(hi)); return r; }
typedef float f32x2 __attribute__((ext_vector_type(2)));
template <class Epi, class Sched, bool ALIGN_EPI = false, bool SP2 = false>
__device__ __forceinline__ void gemm_phase(PG8_LAS unsigned char* lds, const Gemm g, const Sched& S, const Epi& E) {
    int tid_ = threadIdx.x; asm volatile("" : "+v"(tid_));
    const int tid = tid_, wid = __builtin_amdgcn_readfirstlane(tid >> 6), lane = tid & 63, wr = wid >> 2, wc = wid & 3, fr = lane & 15, fq = lane >> 4;
    const int K = g.K, nt = K / BK;
    unsigned voffA[2], voffB[2];
#pragma unroll
    for (int i = 0; i < 2; ++i) { int R, C; stage_rc(tid * 16 + i * 8192, R, C); const int Rb = Epi::PERM ? ((R & ~31) + perm32(R & 31)) : R;
        voffA[i] = (unsigned)(R * K + C) * 2u; voffB[i] = (unsigned)(Rb * K + C) * 2u; }
    const size_t kstep = (size_t)(BK * 2);
    const size_t hstep = (size_t)HALF * K * 2;
    const size_t tstep = 2 * hstep;
    const unsigned ldsw = (unsigned)wid * 1024u;
    const int aoff = lds_byte(wr * 64 + fr, fq * 8), boff = lds_byte(wc * 32 + fr, fq * 8);
#define PG8_SA(b, h) (((b) * 2 + (h)) * HTB)
#define PG8_SB(b, h) ((4 + (b) * 2 + (h)) * HTB)
#define PG8_STAGE(bufoff, gbase, voff) do { _Pragma("unroll") for (int _i = 0; _i < 2; ++_i) \
        __builtin_amdgcn_global_load_lds((const unsigned*)((const char*)(gbase) + (voff)[_i]), (PG8_LAS unsigned*)(lds + (bufoff) + ldsw + _i * 8192), 16, 0, 0); } while (0)
#define PG8_LDA(dst, b, h) do { _Pragma("unroll") for (int m = 0; m < 4; ++m) _Pragma("unroll") for (int k = 0; k < 2; ++k) dst[m][k] = *(const PG8_LAS bf16x8*)(lds + PG8_SA(b, h) + aoff + m * 2048 + k * 1024); } while (0)
#define PG8_LDB(dst, b, h) do { _Pragma("unroll") for (int n = 0; n < 2; ++n) _Pragma("unroll") for (int k = 0; k < 2; ++k) dst[n][k] = *(const PG8_LAS bf16x8*)(lds + PG8_SB(b, h) + boff + n * 2048 + k * 1024); } while (0)
#define PG8_MMA(ai, bj, At, Bt) do { __builtin_amdgcn_s_setprio(1); _Pragma("unroll") for (int m = 0; m < 4; ++m) _Pragma("unroll") for (int n = 0; n < 2; ++n) _Pragma("unroll") for (int k = 0; k < 2; ++k) \
        acc[ai][bj][m][n] = __builtin_amdgcn_mfma_f32_16x16x32_bf16(Bt[n][k], At[m][k], acc[ai][bj][m][n], 0, 0, 0); __builtin_amdgcn_s_setprio(0); } while (0)
#define PG8_WAIT_V(n) asm volatile("s_waitcnt vmcnt(" #n ")" ::: "memory")
#define PG8_WAIT_L(n) asm volatile("s_waitcnt lgkmcnt(" #n ")" ::: "memory")
#define PG8_BAR __builtin_amdgcn_s_barrier()
#define PG8_SCHED __builtin_amdgcn_sched_barrier(0)
    Unit cur, nxt; int ui = 0;
    if (!S.next(0, cur)) return;
    f32x4 acc[2][2][4][2];
#pragma unroll
    for (int a = 0; a < 2; ++a)
#pragma unroll
        for (int b = 0; b < 2; ++b)
#pragma unroll
            for (int m = 0; m < 4; ++m)
#pragma unroll
                for (int n = 0; n < 2; ++n) acc[a][b][m][n] = (f32x4){0.f, 0.f, 0.f, 0.f};
    bf16x8 At[4][2], B0[2][2], B1[2][2];
    const char* cA = (const char*)g.A + (size_t)cur.pm * tstep; const char* cB = (const char*)g.Bt + (size_t)cur.pn * tstep;
    S.a_ready(cur);
    if constexpr (SP2) {
        PG8_STAGE(PG8_SB(0, 0), cB, voffB); PG8_STAGE(PG8_SB(0, 1), cB + hstep, voffB); PG8_STAGE(PG8_SA(0, 0), cA, voffA); PG8_STAGE(PG8_SA(0, 1), cA + hstep, voffA);
        if (wr == 1) PG8_BAR;
        PG8_WAIT_V(2); PG8_BAR;
        PG8_STAGE(PG8_SB(1, 0), cB + kstep, voffB); PG8_STAGE(PG8_SA(1, 0), cA + kstep, voffA); PG8_STAGE(PG8_SB(1, 1), cB + hstep + kstep, voffB);
        PG8_WAIT_V(6); PG8_BAR;
    } else {
        PG8_STAGE(PG8_SB(0, 0), cB, voffB); PG8_STAGE(PG8_SA(0, 0), cA, voffA); PG8_STAGE(PG8_SB(0, 1), cB + hstep, voffB); PG8_STAGE(PG8_SA(0, 1), cA + hstep, voffA);
        if (wr == 1) PG8_BAR;
        PG8_WAIT_V(4); PG8_BAR;
        PG8_STAGE(PG8_SB(1, 0), cB + kstep, voffB); PG8_STAGE(PG8_SA(1, 0), cA + kstep, voffA); PG8_STAGE(PG8_SB(1, 1), cB + hstep + kstep, voffB);
        PG8_WAIT_V(6); PG8_BAR;
    }
    for (;;) {
        const bool has_next = S.next(ui + 1, nxt);
        const char* nA = has_next ? (const char*)g.A + (size_t)nxt.pm * tstep : cA; const char* nB = has_next ? (const char*)g.Bt + (size_t)nxt.pn * tstep : cB;
        for (int t = 0; t < nt; t += 2) {
            const bool last = (t == nt - 2);
            const char* a1 = cA + (size_t)(t + 1) * kstep;
            const char* a2 = last ? nA : cA + (size_t)(t + 2) * kstep; const char* b2 = last ? nB : cB + (size_t)(t + 2) * kstep;
            const char* a3 = a2 + kstep; const char* b3 = b2 + kstep;
            if (last && has_next) S.a_ready(nxt);
            if constexpr (SP2) {
            PG8_LDB(B0, 0, 0); PG8_LDB(B1, 0, 1); PG8_SCHED; PG8_LDA(At, 0, 0); PG8_STAGE(PG8_SA(1, 1), a1 + hstep, voffA);
            PG8_WAIT_V(8); PG8_WAIT_L(0); PG8_BAR; PG8_MMA(0, 0, At, B0); PG8_MMA(0, 1, At, B1); PG8_BAR; PG8_SCHED;
            PG8_LDA(At, 0, 1); PG8_STAGE(PG8_SB(0, 0), b2, voffB); PG8_STAGE(PG8_SB(0, 1), b2 + hstep, voffB); PG8_STAGE(PG8_SA(0, 0), a2, voffA);
            PG8_WAIT_V(8); PG8_WAIT_L(0); PG8_BAR; PG8_MMA(1, 0, At, B0); PG8_MMA(1, 1, At, B1); PG8_BAR; PG8_SCHED;
            PG8_LDB(B0, 1, 0); PG8_LDB(B1, 1, 1); PG8_SCHED; PG8_LDA(At, 1, 0); PG8_STAGE(PG8_SA(0, 1), a2 + hstep, voffA);
            PG8_WAIT_V(8); PG8_WAIT_L(0); PG8_BAR; PG8_MMA(0, 0, At, B0); PG8_MMA(0, 1, At, B1); PG8_BAR; PG8_SCHED;
            PG8_LDA(At, 1, 1); PG8_STAGE(PG8_SB(1, 0), b3, voffB); PG8_STAGE(PG8_SB(1, 1), b3 + hstep, voffB); PG8_STAGE(PG8_SA(1, 0), a3, voffA);
            PG8_WAIT_V(8); PG8_WAIT_L(0); PG8_BAR; PG8_MMA(1, 0, At, B0); PG8_MMA(1, 1, At, B1); PG8_BAR; PG8_SCHED;
            } else {
            PG8_LDB(B0, 0, 0); PG8_SCHED; PG8_LDA(At, 0, 0); PG8_STAGE(PG8_SA(1, 1), a1 + hstep, voffA);
            PG8_WAIT_L(8); PG8_BAR; PG8_WAIT_L(0); PG8_MMA(0, 0, At, B0); PG8_BAR; PG8_SCHED;
            PG8_LDB(B1, 0, 1); PG8_STAGE(PG8_SB(0, 0), b2, voffB);
            PG8_BAR; PG8_WAIT_L(0); PG8_MMA(0, 1, At, B1); PG8_BAR;
            PG8_LDA(At, 0, 1); PG8_STAGE(PG8_SA(0, 0), a2, voffA);
            PG8_BAR; PG8_WAIT_L(0); PG8_MMA(1, 0, At, B0); PG8_BAR; PG8_SCHED;
            PG8_STAGE(PG8_SB(0, 1), b2 + hstep, voffB);
            PG8_WAIT_V(6); PG8_BAR; PG8_MMA(1, 1, At, B1); PG8_BAR;
            PG8_LDB(B0, 1, 0); PG8_SCHED; PG8_LDA(At, 1, 0); PG8_STAGE(PG8_SA(0, 1), a2 + hstep, voffA);
            PG8_WAIT_L(8); PG8_BAR; PG8_WAIT_L(0); PG8_MMA(0, 0, At, B0); PG8_BAR; PG8_SCHED;
            PG8_LDB(B1, 1, 1); PG8_STAGE(PG8_SB(1, 0), b3, voffB);
            PG8_BAR; PG8_WAIT_L(0); PG8_MMA(0, 1, At, B1); PG8_BAR;
            PG8_LDA(At, 1, 1); PG8_STAGE(PG8_SA(1, 0), a3, voffA);
            PG8_BAR; PG8_WAIT_L(0); PG8_MMA(1, 0, At, B0); PG8_BAR; PG8_SCHED;
            PG8_STAGE(PG8_SB(1, 1), b3 + hstep, voffB);
            PG8_WAIT_V(6); PG8_BAR; PG8_MMA(1, 1, At, B1); PG8_BAR;
            }
        }
        if constexpr (ALIGN_EPI) { if (wr == 0) PG8_BAR; }
        if constexpr (!Epi::AFTER_DRAIN) { E(acc, cur, wr, wc, fr, fq, ui); S.done(cur); }
        if (!has_next) break;
#pragma unroll
        for (int a = 0; a < 2; ++a)
#pragma unroll
            for (int b = 0; b < 2; ++b)
#pragma unroll
                for (int m = 0; m < 4; ++m)
#pragma unroll
                    for (int n = 0; n < 2; ++n) acc[a][b][m][n] = (f32x4){0.f, 0.f, 0.f, 0.f};
        cur = nxt; cA = nA; cB = nB; ++ui;
        if constexpr (ALIGN_EPI) { if (wr == 1) PG8_BAR; }
    }
    PG8_WAIT_V(0);
    if constexpr (!ALIGN_EPI) { if (wr == 0) PG8_BAR; }
    PG8_BAR;
    if constexpr (Epi::AFTER_DRAIN) { E.fused(acc, cur, wr, wc, fr, fq, lds, wid, lane); S.done(cur); }
#undef PG8_SA
#undef PG8_SB
#undef PG8_STAGE
#undef PG8_LDA
#undef PG8_LDB
#undef PG8_MMA
#undef PG8_WAIT_V
#undef PG8_WAIT_L
#undef PG8_BAR
#undef PG8_SCHED
}
}
static __device__ const double INVF[128] = {
  1.0, 0.930572040929699, 0.8659643233600653, 0.8058421877614819,
  0.7498942093324559, 0.6978305848598664, 0.6493816315762113, 0.6042963902381329,
  0.5623413251903491, 0.5232991146814947, 0.4869675251658631, 0.4531583637600818,
  0.4216965034285822, 0.3924189758484536, 0.3651741272548377, 0.33982083289425596,
  0.31622776601683794, 0.29427271762092816, 0.27384196342643613, 0.25482967479793467,
  0.23713737056616552, 0.220673406908459, 0.2053525026457146, 0.19109529749704404,
  0.1778279410038923, 0.16548170999431813, 0.1539926526059492, 0.14330125702369628,
  0.1333521432163324, 0.12409377607517195, 0.11547819846894582, 0.10746078283213174,
  0.1, 0.0930572040929699, 0.08659643233600653, 0.08058421877614819,
  0.07498942093324558, 0.06978305848598663, 0.06493816315762113, 0.060429639023813285,
  0.05623413251903491, 0.05232991146814947, 0.04869675251658631, 0.04531583637600818,
  0.042169650342858224, 0.03924189758484536, 0.03651741272548377, 0.03398208328942559,
  0.03162277660168379, 0.029427271762092817, 0.027384196342643614, 0.025482967479793464,
  0.023713737056616554, 0.0220673406908459, 0.02053525026457146, 0.019109529749704406,
  0.01778279410038923, 0.016548170999431813, 0.01539926526059492, 0.014330125702369627,
  0.01333521432163324, 0.012409377607517195, 0.011547819846894581, 0.010746078283213174,
  0.01, 0.00930572040929699, 0.008659643233600654, 0.008058421877614819,
  0.007498942093324558, 0.006978305848598663, 0.006493816315762113, 0.006042963902381328,
  0.005623413251903491, 0.005232991146814947, 0.004869675251658631, 0.004531583637600818,
  0.004216965034285823, 0.003924189758484536, 0.003651741272548377, 0.003398208328942559,
  0.0031622776601683794, 0.002942727176209282, 0.0027384196342643613, 0.0025482967479793467,
  0.0023713737056616554, 0.0022067340690845897, 0.002053525026457146, 0.0019109529749704406,
  0.0017782794100389228, 0.0016548170999431814, 0.001539926526059492, 0.0014330125702369627,
  0.001333521432163324, 0.0012409377607517195, 0.0011547819846894581, 0.0010746078283213176,
  0.001, 0.0009305720409296989, 0.0008659643233600654, 0.0008058421877614818,
  0.0007498942093324559, 0.0006978305848598664, 0.0006493816315762113, 0.0006042963902381329,
  0.0005623413251903491, 0.0005232991146814947, 0.0004869675251658631, 0.0004531583637600818,
  0.00042169650342858224, 0.0003924189758484536, 0.0003651741272548377, 0.00033982083289425596,
  0.00031622776601683794, 0.00029427271762092817, 0.0002738419634264361, 0.00025482967479793463,
  0.00023713737056616554, 0.00022067340690845897, 0.0002053525026457146, 0.00019109529749704405,
  0.00017782794100389227, 0.00016548170999431815, 0.0001539926526059492, 0.00014330125702369627,
  0.0001333521432163324, 0.00012409377607517196, 0.00011547819846894582, 0.00010746078283213175
};

#include <hip/hip_cooperative_groups.h>
namespace cg = cooperative_groups;
#define LAS __attribute__((address_space(3)))
#define DI __device__ __forceinline__
typedef unsigned short bf16;
typedef short bf16x8 __attribute__((ext_vector_type(8)));
typedef short s16x4 __attribute__((ext_vector_type(4)));
typedef short v4i16_t __attribute__((ext_vector_type(4)));
typedef float f32x4 __attribute__((ext_vector_type(4)));
typedef float f32x16 __attribute__((ext_vector_type(16)));
typedef unsigned u32x4 __attribute__((ext_vector_type(4)));
typedef unsigned u32x2 __attribute__((ext_vector_type(2)));
typedef float f32x2_t __attribute__((ext_vector_type(2)));
typedef __bf16 bf16x2_t __attribute__((ext_vector_type(2)));
typedef unsigned char uchar;

constexpr int NWAVES = 8, NTHR = 512;
constexpr int D = 1024, TP = 65536, TS = 2048, T = TP + TS, FF = 2816, SEQ = 4096, DSEQ = 64, PAST = 1024, KSAMP = PAST + DSEQ;
constexpr int NB_P = 16, NB_S = 32;
constexpr float EPS = 1e-6f;
constexpr float LOG2E = 1.4426950408889634f;
constexpr int LDS_BYTES = 159744;

constexpr size_t O_Y = 0, O_SRP = 69206016, O_KP = 77594624, O_VP = 144703488, O_LFP = 211812352, O_SRS = 212860928,
                 O_KS = 229638144, O_VS = 231735296, O_LFS = 233832448;
constexpr size_t SZ_WIN = (size_t)5632 * 1024 * 2, SZ_WOUT = (size_t)1024 * 2816 * 2, SZ_ACT = (size_t)T * 1024 * 2;
constexpr size_t WS_WIN = 1u << 20;
constexpr size_t WS_KVF = WS_WIN + 4 * SZ_WIN;
constexpr size_t WS_WOUT = WS_KVF + (size_t)2304 * 1024 * 2;
constexpr size_t WS_RIN = WS_WOUT + 4 * SZ_WOUT;
constexpr size_t WS_ROUT = WS_RIN + (size_t)6144 * 1024 * 2;
constexpr size_t WS_WQ = WS_ROUT + (size_t)1024 * 2048 * 2;
__host__ __device__ constexpr int win_slot(int f) { return f == 2 ? 3 : (f == 3 ? 2 : f); }
constexpr size_t WS_WO = WS_WQ + (size_t)1024 * 1024 * 2;
constexpr size_t WS_ROPE = WS_WO + (size_t)1024 * 1024 * 2;
constexpr size_t WS_SSQ = WS_ROPE + (size_t)4096 * 256 * 4;
constexpr size_t WS_BIASP = WS_SSQ + (size_t)T * 16 * 4;
constexpr size_t WS_BIASS = WS_BIASP + (size_t)256 * 4096 * 4;
constexpr size_t WS_HB = WS_BIASS + (size_t)512 * KSAMP * 4;
constexpr size_t WS_R = WS_HB + SZ_ACT;
constexpr size_t SZ_HID = (size_t)T * FF * 2, K2B_BYTES = (size_t)(TP + NB_S * KSAMP) * 1024 * 2;
constexpr size_t R_HID = 0, R_VO = 0, R_G = 2 * SZ_ACT, R_QF = 0, R_K2B = SZ_HID, R_V2B = R_K2B + K2B_BYTES;
constexpr size_t WS_END = WS_R + R_V2B + K2B_BYTES;
static_assert(R_G + 2 * SZ_ACT <= R_V2B + K2B_BYTES, "retention overlay");
static_assert(SZ_ACT <= SZ_HID && SZ_HID % 256 == 0, "qf overlay");
static_assert(WS_END <= (size_t)1073741824, "ws size");
static_assert(WS_HB % 256 == 0 && WS_R % 256 == 0 && WS_ROPE % 256 == 0 && WS_SSQ % 256 == 0, "align");

DI unsigned pk(float lo, float hi) { f32x2_t v = {lo, hi}; bf16x2_t b = __builtin_convertvector(v, bf16x2_t); return __builtin_bit_cast(unsigned, b); }
DI float bflo(unsigned w) { return __uint_as_float(w << 16); }
DI float bfhi(unsigned w) { return __uint_as_float(w & 0xffff0000u); }
DI float ex2(float x) { return __builtin_amdgcn_exp2f(x); }
DI float silu_f(float x) { return x * __builtin_amdgcn_rcpf(1.0f + __expf(-x)); }
DI float wave_sum(float v) {
#pragma unroll
    for (int o = 1; o < 64; o <<= 1) v += __shfl_xor(v, o);
    return v;
}
DI float row_rstd(const float* ssq, int row) {
    const f32x4* p = (const f32x4*)(ssq + (size_t)row * 16);
    const f32x4 a = p[0], b = p[1], c = p[2], d = p[3];
    const float s = (((a[0] + a[1]) + (a[2] + a[3])) + ((b[0] + b[1]) + (b[2] + b[3]))) + (((c[0] + c[1]) + (c[2] + c[3])) + ((d[0] + d[1]) + (d[2] + d[3])));
    return __builtin_amdgcn_rsqf(s * (1.0f / 1024.0f) + EPS);
}

namespace pg8 {
struct EpiSwiGLU {
    static constexpr bool PERM = true, AFTER_DRAIN = false;
    bf16_t* O; const LAS _Float16* rl;
    __device__ __forceinline__ void operator()(const f32x4 (&acc)[2][2][4][2], const Unit& u, int wr, int wc, int fr, int fq, int ui) const {
        const int row0 = u.pm * BM + wr * 64 + fr, col0 = u.pn * 128 + wc * 32 + 8 * fq;
        const LAS _Float16* rlu = rl + ui * 256 + wr * 64 + fr;
#pragma unroll
        for (int ai = 0; ai < 2; ++ai)
#pragma unroll
            for (int m = 0; m < 4; ++m) {
                const int row = row0 + ai * HALF + m * 16; const float rs = (float)rlu[ai * HALF + m * 16];
                u32x4 w;
#pragma unroll
                for (int n = 0; n < 2; ++n) {
                    const f32x4 g = acc[ai][0][m][n] * rs, up = acc[ai][1][m][n] * rs;
                    const float h0 = silu_f(g[0]) * up[0], h1 = silu_f(g[1]) * up[1], h2 = silu_f(g[2]) * up[2], h3 = silu_f(g[3]) * up[3];
                    w[2 * n] = pk(h0, h1); w[2 * n + 1] = pk(h2, h3);
                }
                *(u32x4*)(O + (size_t)row * FF + col0) = w;
            }
    }
};
struct EpiRes {
    static constexpr bool PERM = true, AFTER_DRAIN = false;
    bf16_t* HB; float* ssq; float alpha;
    __device__ __forceinline__ void operator()(const f32x4 (&acc)[2][2][4][2], const Unit& u, int wr, int wc, int fr, int fq, int ui) const {
        const int row0 = u.pm * BM + wr * 64 + fr, col0 = u.pn * BM + wc * 32 + 8 * fq;
#pragma unroll
        for (int ai = 0; ai < 2; ++ai) {
            asm volatile("" ::: "memory");
            u32x4 pre[4][2];
#pragma unroll
            for (int m = 0; m < 4; ++m)
#pragma unroll
                for (int bj = 0; bj < 2; ++bj) pre[m][bj] = *(const u32x4*)(HB + (size_t)(row0 + ai * HALF + m * 16) * D + col0 + bj * HALF);
#pragma unroll
            for (int m = 0; m < 4; ++m) {
                const int row = row0 + ai * HALF + m * 16; float s = 0.f;
#pragma unroll
                for (int bj = 0; bj < 2; ++bj) {
                    const u32x4 pv = pre[m][bj];
                    const f32x4 h0 = {bflo(pv[0]), bfhi(pv[0]), bflo(pv[1]), bfhi(pv[1])}, h1 = {bflo(pv[2]), bfhi(pv[2]), bflo(pv[3]), bfhi(pv[3])};
                    const f32x4 o0 = h0 + acc[ai][bj][m][0] * alpha, o1 = h1 + acc[ai][bj][m][1] * alpha;
                    u32x4 w; w[0] = pk(o0[0], o0[1]); w[1] = pk(o0[2], o0[3]); w[2] = pk(o1[0], o1[1]); w[3] = pk(o1[2], o1[3]);
                    *(u32x4*)(HB + (size_t)row * D + col0 + bj * HALF) = w;
                    s += (o0[0] * o0[0] + o0[1] * o0[1]) + (o0[2] * o0[2] + o0[3] * o0[3]) + (o1[0] * o1[0] + o1[1] * o1[1]) + (o1[2] * o1[2] + o1[3] * o1[3]);
                }
                s += __shfl_xor(s, 16); s += __shfl_xor(s, 32);
                if (fq == 0) ssq[(size_t)row * 16 + u.pn * 4 + wc] = s;
            }
        }
    }
};
struct EpiRetIn {
    static constexpr bool PERM = true, AFTER_DRAIN = false;
    bf16_t *Q, *K, *V, *G; const LAS _Float16* rl; const float* rope;
    __device__ __forceinline__ void operator()(const f32x4 (&acc)[2][2][4][2], const Unit& u, int wr, int wc, int fr, int fq, int ui) const {
        const int row0 = u.pm * BM + wr * 64 + fr, d0 = wc * 32 + 8 * fq;
        const int pn = u.pn;
        const LAS _Float16* rlu = rl + ui * 256 + wr * 64 + fr;
#pragma unroll
        for (int ai = 0; ai < 2; ++ai)
#pragma unroll
            for (int m = 0; m < 4; ++m) {
                if (pn < 8 && (m & 1) == 0) asm volatile("" ::: "memory");
                const int row = row0 + ai * HALF + m * 16; const float rs = (float)rlu[ai * HALF + m * 16];
                if (pn < 8) {
                    const int pos = row < TP ? (row & (SEQ - 1)) : PAST + ((row - TP) & (DSEQ - 1));
                    const float* cs = rope + (size_t)pos * 256 + d0;
                    const float sc = pn < 4 ? rs * 0.0625f : rs;
                    bf16_t* dst = (pn < 4 ? Q : K) + (size_t)row * D + (pn & 3) * 256 + d0;
                    u32x4 w1, w2;
#pragma unroll
                    for (int n = 0; n < 2; ++n) {
                        const f32x4 c = *(const f32x4*)(cs + 4 * n), s = *(const f32x4*)(cs + 128 + 4 * n);
                        const f32x4 x1 = acc[ai][0][m][n] * sc, x2 = acc[ai][1][m][n] * sc;
                        const f32x4 y1 = x1 * c - x2 * s, y2 = x1 * s + x2 * c;
                        w1[2 * n] = pk(y1[0], y1[1]); w1[2 * n + 1] = pk(y1[2], y1[3]);
                        w2[2 * n] = pk(y2[0], y2[1]); w2[2 * n + 1] = pk(y2[2], y2[3]);
                    }
                    *(u32x4*)dst = w1; *(u32x4*)(dst + 128) = w2;
                } else {
                    const bool isg = pn >= 16;
                    bf16_t* dst = (isg ? G : V) + (size_t)row * 2048 + ((pn - 8) & 7) * 256 + d0;
#pragma unroll
                    for (int bj = 0; bj < 2; ++bj) {
                        f32x4 a = acc[ai][bj][m][0] * rs, b = acc[ai][bj][m][1] * rs;
                        if (isg) { a = (f32x4){silu_f(a[0]), silu_f(a[1]), silu_f(a[2]), silu_f(a[3])}; b = (f32x4){silu_f(b[0]), silu_f(b[1]), silu_f(b[2]), silu_f(b[3])}; }
                        u32x4 w; w[0] = pk(a[0], a[1]); w[1] = pk(a[2], a[3]); w[2] = pk(b[0], b[1]); w[3] = pk(b[2], b[3]);
                        *(u32x4*)(dst + bj * HALF) = w;
                    }
                }
            }
    }
};
struct EpiKVF {
    static constexpr bool PERM = true, AFTER_DRAIN = false;
    float* out; bf16_t *K2B, *V2B; const LAS _Float16* rl; const float* bf;
    __device__ __forceinline__ void operator()(const f32x4 (&acc)[2][2][4][2], const Unit& u, int wr, int wc, int fr, int fq, int ui) const {
        const int row0 = u.pm * BM + wr * 64 + fr, d0 = wc * 32 + 8 * fq;
        const int pn = u.pn; const bool samp = u.pm >= TP / BM;
        const LAS _Float16* rlu = rl + ui * 256 + wr * 64 + fr;
        if (pn < 8) {
            const bool isv = pn >= 4;
            float* fbase = out + (samp ? (isv ? O_VS : O_KS) - (size_t)TP * D : (isv ? O_VP : O_KP)) + (pn & 3) * 256 + d0;
            bf16_t* bbase = (isv ? V2B : K2B) + (pn & 3) * 256 + d0;
#pragma unroll
            for (int ai = 0; ai < 2; ++ai)
#pragma unroll
                for (int m = 0; m < 4; ++m) {
                    const int row = row0 + ai * HALF + m * 16; const float rs = (float)rlu[ai * HALF + m * 16];
                    const int brow = row + (samp ? (((row - TP) >> 6) + 1) * 1024 : 0);
                    float* fo = fbase + (size_t)row * D; bf16_t* bo = bbase + (size_t)brow * D;
#pragma unroll
                    for (int bj = 0; bj < 2; ++bj) {
                        const f32x4 a = acc[ai][bj][m][0] * rs, b = acc[ai][bj][m][1] * rs;
                        __builtin_nontemporal_store(a, (f32x4*)(fo + bj * HALF)); __builtin_nontemporal_store(b, (f32x4*)(fo + bj * HALF + 4));
                        u32x4 w; w[0] = pk(a[0], a[1]); w[1] = pk(a[2], a[3]); w[2] = pk(b[0], b[1]); w[3] = pk(b[2], b[3]);
                        *(u32x4*)(bo + bj * HALF) = w;
                    }
                }
        } else if (wc == 0 && fq < 2) {
            float* lbase = out + (samp ? O_LFS - (size_t)TP * 16 : O_LFP) + 8 * fq;
            const f32x4 bb0 = *(const f32x4*)(bf + 8 * fq), bb1 = *(const f32x4*)(bf + 8 * fq + 4);
#pragma unroll
            for (int ai = 0; ai < 2; ++ai)
#pragma unroll
                for (int m = 0; m < 4; ++m) {
                    const int row = row0 + ai * HALF + m * 16; const float rs = (float)rlu[ai * HALF + m * 16];
                    float* lo = lbase + (size_t)row * 16;
#pragma unroll
                    for (int n = 0; n < 2; ++n) {
                        const f32x4 x = acc[ai][0][m][n] * rs + (n ? bb1 : bb0); f32x4 y;
#pragma unroll
                        for (int j = 0; j < 4; ++j) y[j] = fminf(x[j], 0.f) - __logf(1.0f + __expf(-fabsf(x[j])));
                        *(f32x4*)(lo + 4 * n) = y;
                    }
                }
        }
    }
};
struct EpiSwiKVF {
    static constexpr bool PERM = true, AFTER_DRAIN = false;
    EpiSwiGLU swi; EpiKVF kvf;
    __device__ __forceinline__ void operator()(const f32x4 (&acc)[2][2][4][2], const Unit& u, int wr, int wc, int fr, int fq, int ui) const {
        if (u.pn < 22) swi(acc, u, wr, wc, fr, fq, ui);
        else { Unit u2; u2.pm = u.pm; u2.pn = u.pn - 22; kvf(acc, u2, wr, wc, fr, fq, ui); }
    }
};
struct EpiQ {
    static constexpr bool PERM = true, AFTER_DRAIN = false;
    bf16_t* O; const LAS _Float16* rl;
    __device__ __forceinline__ void operator()(const f32x4 (&acc)[2][2][4][2], const Unit& u, int wr, int wc, int fr, int fq, int ui) const {
        const int row0 = u.pm * BM + wr * 64 + fr, col0 = u.pn * BM + wc * 32 + 8 * fq;
        const LAS _Float16* rlu = rl + ui * 256 + wr * 64 + fr;
#pragma unroll
        for (int ai = 0; ai < 2; ++ai)
#pragma unroll
            for (int m = 0; m < 4; ++m) {
                const int row = row0 + ai * HALF + m * 16; const float rs = (float)rlu[ai * HALF + m * 16] * (0.125f * LOG2E);
#pragma unroll
                for (int bj = 0; bj < 2; ++bj) {
                    const f32x4 a = acc[ai][bj][m][0] * rs, b = acc[ai][bj][m][1] * rs;
                    u32x4 w; w[0] = pk(a[0], a[1]); w[1] = pk(a[2], a[3]); w[2] = pk(b[0], b[1]); w[3] = pk(b[2], b[3]);
                    *(u32x4*)(O + (size_t)row * D + col0 + bj * HALF) = w;
                }
            }
    }
};
}

DI void tr_item(const float* W, int K, int N, bf16* WT, int drow0, const float* g, LAS float* scr, int k0, int n0, int lane) {
    const int n = n0 + 4 * (lane & 7);
    f32x4 v[8];
#pragma unroll
    for (int i = 0; i < 8; ++i) { const int kk = 8 * i + (lane >> 3); v[i] = (n < N) ? __builtin_nontemporal_load((const f32x4*)(W + (size_t)(k0 + kk) * N + n)) : (f32x4){0.f, 0.f, 0.f, 0.f}; }
#pragma unroll
    for (int i = 0; i < 8; ++i) { const int kk = 8 * i + (lane >> 3); const float gs = g ? g[k0 + kk] : 1.0f; LAS float* d = scr + kk * 33 + 4 * (lane & 7);
        d[0] = v[i][0] * gs; d[1] = v[i][1] * gs; d[2] = v[i][2] * gs; d[3] = v[i][3] * gs; }
    asm volatile("s_waitcnt lgkmcnt(0)" ::: "memory");
    const int c = lane & 7;
#pragma unroll
    for (int j = 0; j < 4; ++j) { const int nn = (lane >> 3) + 8 * j; const LAS float* s = scr + (8 * c) * 33 + nn;
        u32x4 o; o[0] = pk(s[0 * 33], s[1 * 33]); o[1] = pk(s[2 * 33], s[3 * 33]); o[2] = pk(s[4 * 33], s[5 * 33]); o[3] = pk(s[6 * 33], s[7 * 33]);
        *(u32x4*)(WT + (size_t)(drow0 + nn) * K + k0 + 8 * c) = o; }
    asm volatile("s_waitcnt lgkmcnt(0)" ::: "memory");
}
DI bool tr_matrix(int& r, const float* W, int K, int N, int nblk, bf16* WT, const float* g, int mode, LAS float* scr, int lane) {
    const int items = (K / 64) * nblk;
    if (r >= items) { r -= items; return false; }
    const int kb = r / nblk, nb = r % nblk, n0 = 32 * nb;
    int drow0 = n0;
    if (mode == 1) { const int bj = n0 / FF, rem = n0 % FF; drow0 = 256 * (rem / 128) + 128 * bj + (rem % 128); }
    tr_item(W, K, N, WT, drow0, g, scr, 64 * kb, n0, lane);
    return true;
}
DI void sincos_d(double x, float& s, float& c) {
    const double n = __builtin_rint(x * 0.63661977236758134308);
    double r = __builtin_fma(-n, 1.57079632679489655800e+00, x); r = __builtin_fma(-n, 6.12323399573676603587e-17, r);
    const double r2 = r * r;
    double sp = -1.0 / 1307674368000.0; sp = sp * r2 + 1.0 / 6227020800.0; sp = sp * r2 - 1.0 / 39916800.0; sp = sp * r2 + 1.0 / 362880.0; sp = sp * r2 - 1.0 / 5040.0; sp = sp * r2 + 1.0 / 120.0; sp = sp * r2 - 1.0 / 6.0; sp = sp * r2 * r + r;
    double cp = 1.0 / 20922789888000.0; cp = cp * r2 - 1.0 / 87178291200.0; cp = cp * r2 + 1.0 / 479001600.0; cp = cp * r2 - 1.0 / 3628800.0; cp = cp * r2 + 1.0 / 40320.0; cp = cp * r2 - 1.0 / 720.0; cp = cp * r2 + 1.0 / 24.0; cp = cp * r2 - 0.5; cp = cp * r2 + 1.0;
    const int q = ((int)n) & 3;
    const double ss = (q == 0) ? sp : (q == 1) ? cp : (q == 2) ? -sp : -cp;
    const double cc = (q == 0) ? cp : (q == 1) ? -sp : (q == 2) ? -cp : sp;
    s = (float)ss; c = (float)cc;
}

constexpr int RL_OFF = 131072;
static_assert(RL_OFF + 32 * 512 <= LDS_BYTES - 64, "rstd table (fp16, up to 32 units per block)");
DI void rstd_prepass(LAS uchar* lds, const float* ssq, const pg8::StaticOrder& S, int tid) {
    LAS _Float16* rl = (LAS _Float16*)(lds + RL_OFF);
    pg8::Unit u; int nun = 0;
    while (nun < 32 && S.next(nun, u)) ++nun;
#pragma unroll 4
    for (int e = tid; e < nun * 256; e += NTHR) { S.next(e >> 8, u); rl[e] = (_Float16)row_rstd(ssq, u.pm * 256 + (e & 255)); }
    __syncthreads();
}
#define KSEL(k) (ONLY < 0 || ONLY == (k))
struct Params { const float* in[22]; float* out; unsigned char* ws; int ph_lo, ph_hi; unsigned char prog[32]; };

DI void phase_prologue(const Params& P, uchar* ws, float* out, LAS uchar* lds, int gw, int NGW, int wave, int lane) {
    LAS float* scr = (LAS float*)(lds + wave * 16384);
    constexpr int I_IN = 16 * 176, I_OUT = 44 * 32;
    constexpr int NITEMS = 4 * I_IN + 4 * I_OUT + 16 * 192 + 32 * 32 + 16 * 72 + 2 * 16 * 32;
    for (int it = gw; it < NITEMS; it += NGW) {
        int r = it; bool done = false;
#pragma unroll
        for (int f = 0; f < 4; ++f) {
            if (done) break;
            const int l = f >> 1; const bool second = f & 1;
            done = tr_matrix(r, P.in[second ? 11 : 7] + (size_t)l * 1024 * 5632, 1024, 5632, 176, (bf16*)(ws + WS_WIN + win_slot(f) * SZ_WIN), P.in[second ? 10 : 6] + l * 1024, 1, scr, lane);
        }
#pragma unroll
        for (int f = 0; f < 4; ++f) {
            if (done) break;
            const int l = f >> 1; const bool second = f & 1;
            done = tr_matrix(r, P.in[second ? 12 : 8] + (size_t)l * 2816 * 1024, 2816, 1024, 32, (bf16*)(ws + WS_WOUT + f * SZ_WOUT), nullptr, 0, scr, lane);
        }
        if (!done) done = tr_matrix(r, P.in[13], 1024, 6144, 192, (bf16*)(ws + WS_RIN), P.in[9], 0, scr, lane);
        if (!done) done = tr_matrix(r, P.in[15], 2048, 1024, 32, (bf16*)(ws + WS_ROUT), P.in[14], 0, scr, lane);
        if (!done) done = tr_matrix(r, P.in[17], 1024, 2064, 72, (bf16*)(ws + WS_KVF), P.in[16], 0, scr, lane);
        if (!done) done = tr_matrix(r, P.in[19], 1024, 1024, 32, (bf16*)(ws + WS_WQ), P.in[9] + 1024, 0, scr, lane);
        if (!done) done = tr_matrix(r, P.in[20], 1024, 1024, 32, (bf16*)(ws + WS_WO), nullptr, 0, scr, lane);
    }
    {
        bf16* HB = (bf16*)(ws + WS_HB); float* ssq = (float*)(ws + WS_SSQ);
        constexpr int NR = 4;
        for (int m0 = gw; m0 < T; m0 += NR * NGW) {
            f32x4 v[NR][4];
#pragma unroll
            for (int u = 0; u < NR; ++u) { const int m = m0 + u * NGW < T ? m0 + u * NGW : m0;
                const float* src = m < TP ? P.in[0] + (size_t)m * D : P.in[1] + (size_t)(m - TP) * D;
#pragma unroll
                for (int j = 0; j < 4; ++j) v[u][j] = __builtin_nontemporal_load((const f32x4*)src + lane + 64 * j); }
#pragma unroll
            for (int u = 0; u < NR; ++u) {
                const int m = m0 + u * NGW; if (m >= T) break;
                float s = 0.f;
#pragma unroll
                for (int j = 0; j < 4; ++j) s += (v[u][j][0] * v[u][j][0] + v[u][j][1] * v[u][j][1]) + (v[u][j][2] * v[u][j][2] + v[u][j][3] * v[u][j][3]);
                s = wave_sum(s);
#pragma unroll
                for (int j = 0; j < 4; ++j) { u32x2 w; w[0] = pk(v[u][j][0], v[u][j][1]); w[1] = pk(v[u][j][2], v[u][j][3]); ((u32x2*)(HB + (size_t)m * D))[lane + 64 * j] = w; }
                if (lane < 16) ssq[(size_t)m * 16 + lane] = lane == 0 ? s : 0.f;
            }
        }
    }
}

DI void rope_table(uchar* ws, int gw, int NGW, int lane) {
    {
        const int gt = gw * 64 + lane, NGT = NGW * 64; float* rope = (float*)(ws + WS_ROPE);
        for (int e = gt; e < 4096 * 128; e += NGT) { const int pos = e >> 7, j = e & 127; float s, c; sincos_d((double)pos * INVF[j], s, c); rope[(size_t)pos * 256 + j] = c; rope[(size_t)pos * 256 + 128 + j] = s; }
    }
}

DI f32x16 mfma32(bf16x8 a, bf16x8 b, f32x16 c) { return __builtin_amdgcn_mfma_f32_32x32x16_bf16(a, b, c, 0, 0, 0); }
DI int crow(int i, int hh) { return (i & 3) + 8 * (i >> 2) + 4 * hh; }
DI s16x4 vtr(const LAS uchar* p) { return __builtin_bit_cast(s16x4, __builtin_amdgcn_ds_read_tr16_b64_v4i16((LAS v4i16_t*)p)); }
DI bf16x8 cat8(s16x4 lo, s16x4 hi) { return __builtin_shufflevector(lo, hi, 0, 1, 2, 3, 4, 5, 6, 7); }
DI bf16x8 ldsv(const LAS uchar* p) { return *(const LAS bf16x8*)p; }
template <int S> DI bf16x8 pack8(const f32x16& x) { u32x4 p; p[0] = pk(x[8 * S], x[8 * S + 1]); p[1] = pk(x[8 * S + 2], x[8 * S + 3]); p[2] = pk(x[8 * S + 4], x[8 * S + 5]); p[3] = pk(x[8 * S + 6], x[8 * S + 7]); return __builtin_bit_cast(bf16x8, p); }
DI s16x4 scale4(s16x4 v, float f0, float f1, float f2, float f3) {
    const u32x2 w = __builtin_bit_cast(u32x2, v); u32x2 o;
    o[0] = pk(bflo(w[0]) * f0, bfhi(w[0]) * f1); o[1] = pk(bflo(w[1]) * f2, bfhi(w[1]) * f3);
    return __builtin_bit_cast(s16x4, o);
}
namespace ret {
constexpr int QP = 528, KP = 528, VP = 320, SP = 528;
constexpr int OFF_Q = 0, OFF_K = 64 * QP, OFF_V = OFF_K + 64 * KP, OFF_ST = OFF_V + 64 * VP, END = OFF_ST + 128 * SP;
static_assert(END <= LDS_BYTES, "retention LDS");
}
DI void ret_item(LAS uchar* lds, const bf16* Qg, const bf16* Kg, bf16* Vg, size_t rowbase, int h, int sl, int nch, const float* S0, float* Sout, float lg2) {
    using namespace ret;
    int tid_ = threadIdx.x; asm volatile("" : "+v"(tid_));
    const int tid = tid_, lane = tid & 63, w = __builtin_amdgcn_readfirstlane(tid >> 6), r = lane & 31, hh = lane >> 5;
    const int ci = w >> 2, ei = w & 3, dq = w >> 1, eh = w & 1;
    const int q4 = (lane & 15) >> 2, p4 = lane & 3, blk = (lane >> 4) & 1;
    f32x16 S[2][2];
    if (S0) {
#pragma unroll
        for (int ti = 0; ti < 2; ++ti)
#pragma unroll
            for (int tj = 0; tj < 2; ++tj)
#pragma unroll
                for (int i = 0; i < 16; ++i) S[ti][tj][i] = S0[(size_t)(64 * dq + 32 * ti + crow(i, hh)) * 512 + 128 * sl + 64 * eh + 32 * tj + r];
    } else {
#pragma unroll
        for (int ti = 0; ti < 2; ++ti)
#pragma unroll
            for (int tj = 0; tj < 2; ++tj)
#pragma unroll
                for (int i = 0; i < 16; ++i) S[ti][tj][i] = 0.f;
    }
    const float g64 = ex2(lg2 * 64.f);
    const bf16* qsrc = Qg + (rowbase + (tid >> 5)) * D + h * 256 + (tid & 31) * 8;
    const bf16* ksrc = Kg + (rowbase + (tid >> 5)) * D + h * 256 + (tid & 31) * 8;
    bf16* vsrc = Vg + (rowbase + (tid >> 4)) * 2048 + h * 512 + sl * 128 + (tid & 15) * 8;
    const int qdst = (tid >> 5) * QP + (tid & 31) * 16, vdst = (tid >> 4) * VP + (tid & 15) * 16;
    const float lg2_inv = lg2;
#pragma unroll 1
    for (int n = 0; n < nch; ++n) {
        float lg2 = lg2_inv; asm volatile("" : "+v"(lg2));
        u32x4 rq[4], rk[4], rv[2];
        {
            const size_t adv = (size_t)64 * n;
#pragma unroll
            for (int i = 0; i < 4; ++i) { rq[i] = *(const u32x4*)(qsrc + (adv + 16 * i) * D); rk[i] = *(const u32x4*)(ksrc + (adv + 16 * i) * D); }
#pragma unroll
            for (int i = 0; i < 2; ++i) rv[i] = *(const u32x4*)(vsrc + (adv + 32 * i) * 2048);
        }
        __syncthreads();
#pragma unroll
        for (int i = 0; i < 4; ++i) { *(LAS u32x4*)(lds + OFF_Q + qdst + 16 * i * QP) = rq[i]; *(LAS u32x4*)(lds + OFF_K + qdst + 16 * i * KP) = rk[i]; }
        asm volatile("" ::: "memory");
#pragma unroll
        for (int i = 0; i < 2; ++i) {
            const float f = ex2(lg2 * (float)(63 - 32 * i - (tid >> 4))); u32x4 w;
#pragma unroll
            for (int j = 0; j < 4; ++j) w[j] = pk(bflo(rv[i][j]) * f, bfhi(rv[i][j]) * f);
            *(LAS u32x4*)(lds + OFF_V + vdst + 32 * i * VP) = w;
        }
        asm volatile("" ::: "memory");
#pragma unroll
        for (int ti = 0; ti < 2; ++ti)
#pragma unroll
            for (int tj = 0; tj < 2; ++tj)
#pragma unroll
                for (int g = 0; g < 4; ++g) { u32x2 v; v[0] = pk(S[ti][tj][4 * g], S[ti][tj][4 * g + 1]); v[1] = pk(S[ti][tj][4 * g + 2], S[ti][tj][4 * g + 3]);
                    *(LAS u32x2*)(lds + OFF_ST + (64 * eh + 32 * tj + r) * SP + (64 * dq + 32 * ti + 8 * g + 4 * hh) * 2) = v; }
        __syncthreads();
        f32x16 sc0, sc1;
#pragma unroll
        for (int i = 0; i < 16; ++i) { sc0[i] = 0.f; sc1[i] = 0.f; }
        const LAS uchar* qrow = lds + OFF_Q + (32 * ci + r) * QP + hh * 16;
        {
            const LAS uchar* krow = lds + OFF_K + r * KP + hh * 16;
#pragma unroll
            for (int kk = 0; kk < 16; ++kk) { const bf16x8 qf = ldsv(qrow + kk * 32); sc0 = mfma32(ldsv(krow + kk * 32), qf, sc0); sc1 = mfma32(ldsv(krow + 32 * KP + kk * 32), qf, sc1);
                if ((kk & 3) == 3) asm volatile("" ::: "memory"); }
        }
        {
            const float a0 = (float)(32 * ci + r - 4 * hh), a1 = a0 - 32.f;
#pragma unroll
            for (int i = 0; i < 16; ++i) { const float cc = (float)((i & 3) + 8 * (i >> 2)); const float sm = cc + (float)(4 * hh - 63);
                sc0[i] *= ex2(lg2 * (fabsf(a0 - cc) + sm)); sc1[i] *= ex2(lg2 * (fabsf(a1 - cc) + sm + 32.f)); }
        }
        f32x16 o;
#pragma unroll
        for (int i = 0; i < 16; ++i) o[i] = 0.f;
        {
            const LAS uchar* vb = lds + OFF_V + (4 * hh + q4) * VP + (32 * ei + 16 * blk + 4 * p4) * 2;
            o = mfma32(pack8<0>(sc0), cat8(vtr(vb), vtr(vb + 8 * VP)), o);
            o = mfma32(pack8<1>(sc0), cat8(vtr(vb + 16 * VP), vtr(vb + 24 * VP)), o);
            o = mfma32(pack8<0>(sc1), cat8(vtr(vb + 32 * VP), vtr(vb + 40 * VP)), o);
            o = mfma32(pack8<1>(sc1), cat8(vtr(vb + 48 * VP), vtr(vb + 56 * VP)), o);
        }
        f32x16 o2;
#pragma unroll
        for (int i = 0; i < 16; ++i) o2[i] = 0.f;
        {
            const LAS uchar* strow = lds + OFF_ST + (32 * ei + r) * SP + hh * 16;
#pragma unroll
            for (int kk = 0; kk < 16; ++kk) { o2 = mfma32(ldsv(qrow + kk * 32), ldsv(strow + kk * 32), o2); if ((kk & 3) == 3) asm volatile("" ::: "memory"); }
        }
        {
            bf16* op = Vg + (rowbase + (size_t)64 * n + 32 * ci) * 2048 + h * 512 + sl * 128 + 32 * ei + r;
#pragma unroll
            for (int i = 0; i < 16; ++i) { const int c = crow(i, hh); const float val = o[i] + o2[i] * ex2(lg2 * (float)(32 * ci + c + 1));
                op[(size_t)c * 2048] = (bf16)(pk(val, 0.f) & 0xffffu); }
        }
        asm volatile("" ::: "memory");
#pragma unroll
        for (int ti = 0; ti < 2; ++ti)
#pragma unroll
            for (int tj = 0; tj < 2; ++tj) S[ti][tj] = S[ti][tj] * g64;
        {
            const LAS uchar* ka = lds + OFF_K + (8 * hh + q4) * KP + (64 * dq + 16 * blk + 4 * p4) * 2;
            const LAS uchar* va = lds + OFF_V + (8 * hh + q4) * VP + (64 * eh + 16 * blk + 4 * p4) * 2;
#pragma unroll
            for (int kk = 0; kk < 4; ++kk) {
                bf16x8 A[2], B[2];
#pragma unroll
                for (int ti = 0; ti < 2; ++ti) A[ti] = cat8(vtr(ka + kk * 16 * KP + ti * 64), vtr(ka + kk * 16 * KP + 4 * KP + ti * 64));
#pragma unroll
                for (int tj = 0; tj < 2; ++tj) B[tj] = cat8(vtr(va + kk * 16 * VP + tj * 64), vtr(va + kk * 16 * VP + 4 * VP + tj * 64));
#pragma unroll
                for (int ti = 0; ti < 2; ++ti)
#pragma unroll
                    for (int tj = 0; tj < 2; ++tj) S[ti][tj] = mfma32(A[ti], B[tj], S[ti][tj]);
                asm volatile("" ::: "memory");
            }
        }
    }
#pragma unroll
    for (int ti = 0; ti < 2; ++ti)
#pragma unroll
        for (int tj = 0; tj < 2; ++tj)
#pragma unroll
            for (int i = 0; i < 16; ++i) __builtin_nontemporal_store(S[ti][tj][i], Sout + (size_t)(64 * dq + 32 * ti + crow(i, hh)) * 512 + 128 * sl + 64 * eh + 32 * tj + r);
    __syncthreads();
}

namespace fox {
constexpr int KPI = 144, VPI = 192, KB = 64 * KPI, VB = 64 * VPI;
constexpr int OFF_K = 0, OFF_V = 3 * KB, OFF_BIAS = OFF_V + 3 * VB, OFF_SCR = OFF_BIAS + 4096 * 4, END = OFF_SCR + 8 * 256;
static_assert(END <= LDS_BYTES, "attention LDS");
}
DI float max3f(float a, float b, float c) { float r; asm("v_max3_f32 %0, %1, %2, %3" : "=v"(r) : "v"(a), "v"(b), "v"(c)); return r; }
DI float fadd_s(float a, float b) { float r; asm("v_add_f32_e32 %0, %1, %2" : "=v"(r) : "v"(a), "v"(b)); return r; }
DI float fsub_s(float a, float b) { float r; asm("v_sub_f32_e32 %0, %1, %2" : "=v"(r) : "v"(a), "v"(b)); return r; }
#define SBAR() __builtin_amdgcn_sched_barrier(0)
DI void fox_init(f32x16& n0, f32x16& n1, const LAS f32x4* bp, float m) {
#pragma unroll
    for (int g = 0; g < 4; ++g) { const f32x4 b0 = bp[2 * g], b1 = bp[2 * g + 8];
#pragma unroll
        for (int j = 0; j < 4; ++j) { n0[4 * g + j] = b0[j] - m; n1[4 * g + j] = b1[j] - m; }
        SBAR(); }
}
DI void fox_qk_plain(f32x16& n0, f32x16& n1, const LAS uchar* kb, const bf16x8 (&qf)[4]) {
#pragma unroll
    for (int kk = 0; kk < 4; ++kk) { n0 = mfma32(ldsv(kb + kk * 32), qf[kk], n0); n1 = mfma32(ldsv(kb + 32 * fox::KPI + kk * 32), qf[kk], n1); }
}
DI void fox_hot(f32x16& c0, f32x16& c1, f32x16& n0, f32x16& n1, f32x16& o0, f32x16& o1, float& l, float m,
                const LAS uchar* kb, const LAS uchar* vb, const LAS f32x4* bpn, const bf16x8 (&qf)[4], bf16x8 x0, bf16x8 x1, bf16x8 x2) {
    using namespace fox;
#define FOX_KF(i) ldsv(kb + ((i) & 1) * 32 * KPI + ((i) >> 1) * 32)
#define FOX_VFR(i) cat8(vtr(vb + (16 * ((i) >> 1)) * VPI + ((i) & 1) * 64), vtr(vb + (16 * ((i) >> 1) + 8) * VPI + ((i) & 1) * 64))
#define FOX_EX4(P, B) do { P[B] = ex2(P[B]); P[B + 1] = ex2(P[B + 1]); P[B + 2] = ex2(P[B + 2]); P[B + 3] = ex2(P[B + 3]); } while (0)
#define FOX_SUM4(P, B) do { sacc = fadd_s(sacc, P[B]); sacc = fadd_s(sacc, P[B + 1]); sacc = fadd_s(sacc, P[B + 2]); sacc = fadd_s(sacc, P[B + 3]); } while (0)
    fox_init(n0, n1, bpn, m);
    n0 = mfma32(x0, qf[0], n0); FOX_EX4(c0, 0);  x0 = FOX_KF(3); SBAR();
    n1 = mfma32(x1, qf[0], n1); FOX_EX4(c0, 4);  x1 = FOX_KF(4); SBAR();
    n0 = mfma32(x2, qf[1], n0); FOX_EX4(c0, 8);  x2 = FOX_KF(5); SBAR();
    n1 = mfma32(x0, qf[1], n1); FOX_EX4(c0, 12); x0 = FOX_KF(6); SBAR();
    n0 = mfma32(x1, qf[2], n0); FOX_EX4(c1, 0);  x1 = FOX_KF(7); SBAR();
    n1 = mfma32(x2, qf[2], n1); FOX_EX4(c1, 4);  x2 = FOX_VFR(0); SBAR();
    n0 = mfma32(x0, qf[3], n0); FOX_EX4(c1, 8);  x0 = FOX_VFR(1); SBAR();
    n1 = mfma32(x1, qf[3], n1); FOX_EX4(c1, 12); x1 = FOX_VFR(2); SBAR();
    float sacc = fadd_s(c0[0], c0[1]);
    bf16x8 a0 = pack8<0>(c0), a1; SBAR();
#define FOX_MOV4(DST, SRC, B) do { DST[B] = SRC[B]; DST[B + 1] = SRC[B + 1]; DST[B + 2] = SRC[B + 2]; DST[B + 3] = SRC[B + 3]; } while (0)
    o0 = mfma32(a0, x2, o0); sacc = fadd_s(sacc, c0[2]); sacc = fadd_s(sacc, c0[3]); FOX_SUM4(c0, 4); a1 = pack8<1>(c0); x2 = FOX_VFR(3); SBAR();
    o1 = mfma32(a0, x0, o1); FOX_SUM4(c0, 8); FOX_SUM4(c0, 12); x0 = FOX_VFR(4); SBAR();
    o0 = mfma32(a1, x1, o0); a0 = pack8<0>(c1); FOX_MOV4(c0, n0, 0); FOX_MOV4(c0, n0, 4); x1 = FOX_VFR(5); SBAR();
    o1 = mfma32(a1, x2, o1); FOX_SUM4(c1, 0); FOX_SUM4(c1, 4); FOX_MOV4(c0, n0, 8); x2 = FOX_VFR(6); SBAR();
    o0 = mfma32(a0, x0, o0); a1 = pack8<1>(c1); FOX_SUM4(c1, 8); FOX_MOV4(c0, n0, 12); x0 = FOX_VFR(7); SBAR();
    o1 = mfma32(a0, x1, o1); FOX_SUM4(c1, 12); FOX_MOV4(c1, n1, 0); FOX_MOV4(c1, n1, 4); SBAR();
    o0 = mfma32(a1, x2, o0); FOX_MOV4(c1, n1, 8); FOX_MOV4(c1, n1, 12); SBAR();
    o1 = mfma32(a1, x0, o1); SBAR();
#undef FOX_MOV4
    l += sacc;
#undef FOX_KF
#undef FOX_VFR
#undef FOX_EX4
#undef FOX_SUM4
}
struct FoxCtx { int nt, qlim, qlim_min, hh, r; bool active; const LAS uchar *kb0, *vb0; const LAS float* biasl; LAS float* scr; LAS uchar* lds; int kdst, vdst; const bf16 *ksrc, *vsrc; };
DI void fox_ring(const FoxCtx& X, int t, int bwr, u32x4& rk, u32x4& rv) {
    using namespace fox;
    *(LAS u32x4*)(X.lds + X.kdst + bwr * KB) = rk; *(LAS u32x4*)(X.lds + X.vdst + bwr * VB) = rv;
    __syncthreads();
    const int tl = t - 3 > 0 ? t - 3 : 0;
    rk = *(const u32x4*)(X.ksrc + (size_t)64 * tl * D); rv = *(const u32x4*)(X.vsrc + (size_t)64 * tl * D);
}
DI void fox_step(const FoxCtx& X, int s, int bcur, int bnext, int bwr, f32x16& c0, f32x16& c1, f32x16& n0, f32x16& n1, f32x16& o0, f32x16& o1, float& l, float& m,
                 const bf16x8 (&qf)[4], u32x4& rk, u32x4& rv) {
    using namespace fox;
    const int nt = X.nt, t = nt - 1 - s, hh = X.hh;
    {
        const bool vis = 64 * t <= X.qlim_min, visn = 64 * (t - 1) <= X.qlim_min;
        const LAS f32x4* bpn = (const LAS f32x4*)(X.biasl + 64 * (t - 1) + 4 * hh);
        if (vis) {
            const LAS uchar* kbn = X.kb0 + bnext * KB;
            const bf16x8 x0 = ldsv(kbn), x1 = ldsv(kbn + 32 * KPI), x2 = ldsv(kbn + 32);
            if (64 * t + 63 > X.qlim_min) {
#pragma unroll
                for (int i = 0; i < 16; ++i) { const int key = 64 * t + crow(i, hh); if (key > X.qlim) c0[i] = -INFINITY; if (key + 32 > X.qlim) c1[i] = -INFINITY; }
            }
            asm volatile("s_nop 15\n\ts_nop 7" : "+v"(c0), "+v"(c1));
            float mx = max3f(c0[0], c1[0], c0[1]), mx2 = max3f(c1[1], c0[2], c1[2]);
#pragma unroll
            for (int i = 3; i < 15; i += 2) { mx = max3f(mx, c0[i], c1[i]); mx2 = max3f(mx2, c0[i + 1], c1[i + 1]); }
            mx = max3f(mx, c0[15], c1[15]); mx = max3f(mx, mx2, mx2);
            { auto rr = __builtin_amdgcn_permlane32_swap(__float_as_uint(mx), __float_as_uint(mx), false, false); mx = max3f(__uint_as_float(rr[0]), __uint_as_float(rr[1]), __uint_as_float(rr[1])); }
            if (__builtin_expect(__any(mx > 16.f), 0)) {
                const float d = fmaxf(mx, 0.f), f = ex2(-d); m += d; l *= f;
#pragma unroll
                for (int i = 0; i < 16; ++i) { c0[i] -= d; c1[i] -= d; }
                if (hh == 0) X.scr[X.r] = f;
                asm volatile("s_waitcnt lgkmcnt(0)" ::: "memory");
#pragma unroll
                for (int g = 0; g < 4; ++g) { const f32x4 fv = *(const LAS f32x4*)(X.scr + 8 * g + 4 * hh);
#pragma unroll
                    for (int j = 0; j < 4; ++j) { o0[4 * g + j] *= fv[j]; o1[4 * g + j] *= fv[j]; } }
                asm volatile("s_waitcnt lgkmcnt(0)" ::: "memory");
            }
            fox_hot(c0, c1, n0, n1, o0, o1, l, m, kbn, X.vb0 + bcur * VB, bpn, qf, x0, x1, x2);
        } else if (visn) {
            fox_init(n0, n1, bpn, m); fox_qk_plain(n0, n1, X.kb0 + bnext * KB, qf); c0 = n0; c1 = n1;
        }
    }
    fox_ring(X, t, bwr, rk, rv);
}
DI void fox_unit(LAS uchar* lds, const bf16* Qg, const bf16* K2B, const bf16* V2B, bf16* Og, size_t qrow0, int nq, size_t krow0, int nt, int qlim0, int h, const float* biasg) {
    using namespace fox;
    int tid_ = threadIdx.x; asm volatile("" : "+v"(tid_));
    const int tid = tid_, lane = tid & 63, w = __builtin_amdgcn_readfirstlane(tid >> 6), r = lane & 31, hh = lane >> 5;
    const int q4 = (lane & 15) >> 2, p4 = lane & 3, blk = (lane >> 4) & 1;
    FoxCtx X;
    X.nt = nt; X.hh = hh; X.r = r; X.lds = lds;
    X.active = 32 * w < nq;
    __syncthreads();
    const bool bp0 = tid < nt * 16, bp1 = tid + NTHR < nt * 16;
    const f32x4 bias0 = bp0 ? ((const f32x4*)biasg)[tid] : (f32x4){0.f, 0.f, 0.f, 0.f}, bias1 = bp1 ? ((const f32x4*)biasg)[tid + NTHR] : (f32x4){0.f, 0.f, 0.f, 0.f};
    X.ksrc = K2B + (krow0 + (tid >> 3)) * D + h * 64 + (tid & 7) * 8;
    X.vsrc = V2B + (krow0 + (tid >> 3)) * D + h * 64 + (tid & 7) * 8;
    X.kdst = OFF_K + (tid >> 3) * KPI + (tid & 7) * 16; X.vdst = OFF_V + (tid >> 3) * VPI + (tid & 7) * 16;
    u32x4 rk = *(const u32x4*)(X.ksrc + (size_t)64 * (nt - 1) * D), rv = *(const u32x4*)(X.vsrc + (size_t)64 * (nt - 1) * D);
    u32x4 rk1 = rk, rv1 = rv;
    if (nt > 1) { rk1 = *(const u32x4*)(X.ksrc + (size_t)64 * (nt - 2) * D); rv1 = *(const u32x4*)(X.vsrc + (size_t)64 * (nt - 2) * D); }
    bf16x8 qf[4];
    {
        const bf16* qp = Qg + (qrow0 + (X.active ? 32 * w + r : 0)) * D + h * 64 + hh * 8;
#pragma unroll
        for (int kk = 0; kk < 4; ++kk) qf[kk] = *(const bf16x8*)(qp + kk * 16);
    }
    if (bp0) *(LAS f32x4*)(lds + OFF_BIAS + tid * 16) = bias0;
    if (bp1) *(LAS f32x4*)(lds + OFF_BIAS + (tid + NTHR) * 16) = bias1;
    *(LAS u32x4*)(lds + X.kdst) = rk; *(LAS u32x4*)(lds + X.vdst) = rv;
    *(LAS u32x4*)(lds + X.kdst + KB) = rk1; *(LAS u32x4*)(lds + X.vdst + VB) = rv1;
    { const int tl = nt > 2 ? nt - 3 : 0; rk = *(const u32x4*)(X.ksrc + (size_t)64 * tl * D); rv = *(const u32x4*)(X.vsrc + (size_t)64 * tl * D); }
    float l = 0.f; f32x16 o0, o1;
#pragma unroll
    for (int i = 0; i < 16; ++i) { o0[i] = 0.f; o1[i] = 0.f; }
    X.qlim = X.active ? qlim0 + 32 * w + r : 0; X.qlim_min = qlim0 + 32 * w;
    X.scr = (LAS float*)(lds + OFF_SCR + w * 256);
    X.kb0 = lds + OFF_K + r * KPI + hh * 16;
    X.vb0 = lds + OFF_V + (4 * hh + q4) * VPI + (16 * blk + 4 * p4) * 2;
    X.biasl = (const LAS float*)(lds + OFF_BIAS);
    __syncthreads();
    float m = X.biasl[X.qlim];
    f32x16 pa0, pa1, pb0, pb1;
#pragma unroll
    for (int i = 0; i < 16; ++i) { pa0[i] = 0.f; pa1[i] = 0.f; pb0[i] = 0.f; pb1[i] = 0.f; }
    if (X.active && 64 * (nt - 1) <= X.qlim_min) { fox_init(pa0, pa1, (const LAS f32x4*)(X.biasl + 64 * (nt - 1) + 4 * hh), m); fox_qk_plain(pa0, pa1, X.kb0, qf); }
    int b0 = 0, b1 = 1, b2 = 2;
    if (w >= 4) __builtin_amdgcn_s_setprio(1);
    if (X.active) {
#pragma unroll 1
        for (int s = 0; s < nt; ++s) {
            fox_step(X, s, b0, b1, b2, pa0, pa1, pb0, pb1, o0, o1, l, m, qf, rk, rv);
            { const int tb = b0; b0 = b1; b1 = b2; b2 = tb; }
        }
    } else {
#pragma unroll 1
        for (int s = 0; s < nt; ++s) { fox_ring(X, nt - 1 - s, b2, rk, rv); { const int tb = b0; b0 = b1; b1 = b2; b2 = tb; } }
    }
    __builtin_amdgcn_s_setprio(0);
    if (X.active) {
        l += __shfl_xor(l, 32);
        if (hh == 0) X.scr[32 + r] = l;
        asm volatile("s_waitcnt lgkmcnt(0)" ::: "memory");
        bf16* op = Og + (qrow0 + 32 * w) * D + h * 64 + r;
#pragma unroll
        for (int g = 0; g < 4; ++g) { const f32x4 lv = *(const LAS f32x4*)(X.scr + 32 + 8 * g + 4 * hh);
#pragma unroll
            for (int j = 0; j < 4; ++j) { const float inv = 1.0f / lv[j]; const int c = 8 * g + 4 * hh + j;
                op[(size_t)c * D] = (bf16)(pk(o0[4 * g + j] * inv, 0.f) & 0xffffu); op[(size_t)c * D + 32] = (bf16)(pk(o1[4 * g + j] * inv, 0.f) & 0xffffu); } }
    }
}

#define XB_TMO      128
#define XB_XCNT(j)  (256  + 64 * (j))
#define XB_XSUB(j)  (1280 + 64 * (j))
#define XB_XGEN(j)  (2304 + 64 * (j))
#define XB_TOP      3328
#define XB_TOPGEN   3392
#define XCD_BAR_WORDS 3456
#define XB_SPIN_CAP (1u << 18)

__device__ __forceinline__ unsigned xb_ld(unsigned* p)              { return __hip_atomic_load(p, __ATOMIC_RELAXED, __HIP_MEMORY_SCOPE_AGENT); }
__device__ __forceinline__ unsigned xb_add(unsigned* p, unsigned v) { return __hip_atomic_fetch_add(p, v, __ATOMIC_RELAXED, __HIP_MEMORY_SCOPE_AGENT); }
__device__ __forceinline__ unsigned xb_xcc_id() { return (unsigned)__builtin_amdgcn_s_getreg((3 << 11) | 20) & 0xFu; }
#define XB_SPIN(cond, bar) do { unsigned _sp = 0; while (cond) { __builtin_amdgcn_s_sleep(1); \
    if ((++_sp & 255u) == 0u) { if (xb_ld(&(bar)[XB_TMO])) break; if (_sp > XB_SPIN_CAP) { atomicAdd(&(bar)[XB_TMO], 1u); break; } } } } while (0)

struct XcdBarrier {
    unsigned* bar; unsigned x;
    volatile LAS unsigned* st;
};

__device__ __forceinline__ XcdBarrier xcd_barrier_post(unsigned* bar, volatile LAS unsigned* st) {
    XcdBarrier b; b.bar = bar; b.x = xb_xcc_id(); b.st = st;
    if (threadIdx.x == 0) (void)xb_add(&bar[XB_XCNT(b.x)], 1u);
    return b;
}
__device__ __forceinline__ void xcd_barrier_complete(unsigned* bar, unsigned x, unsigned& nloc, unsigned& nx) {
    const unsigned G = gridDim.x * gridDim.y * gridDim.z;
    unsigned sum, cnt, mine, sp = 0u;
    for (;;) {
        sum = 0u; cnt = 0u; mine = 0u;
#pragma unroll
        for (unsigned j = 0; j < 16; ++j) { const unsigned c = xb_ld(&bar[XB_XCNT(j)]); sum += c; cnt += (c > 0u) ? 1u : 0u; mine = (j == x) ? c : mine; }
        if (sum == G) break;
        __builtin_amdgcn_s_sleep(1);
        if ((++sp & 255u) == 0u) { if (xb_ld(&bar[XB_TMO])) break; if (sp > XB_SPIN_CAP) { atomicAdd(&bar[XB_TMO], 1u); break; } }
    }
    nloc = mine > 0u ? mine : 1u; nx = cnt > 0u ? cnt : 1u;
}

__device__ __forceinline__ void xcd_barrier(const XcdBarrier& b) {
    asm volatile("s_waitcnt vmcnt(0)" ::: "memory");
    __syncthreads();
    if (threadIdx.x == 0) {
        unsigned* bar = b.bar;
        __builtin_amdgcn_s_waitcnt(0);
        unsigned nloc = b.st[0], nx = b.st[1];
        if (nloc == 0u) { xcd_barrier_complete(bar, b.x, nloc, nx); b.st[0] = nloc; b.st[1] = nx; }
        const unsigned old = xb_add(&bar[XB_XSUB(b.x)], 1u);
        const unsigned gen = old / nloc;
        if (old + 1u == (gen + 1u) * nloc) {
            __builtin_amdgcn_fence(__ATOMIC_RELEASE, "agent");
            asm volatile("s_waitcnt vmcnt(0)" ::: "memory");
            const unsigned og = xb_add(&bar[XB_TOP], 1u);
            const unsigned tg = og / nx;
            if (og + 1u == (tg + 1u) * nx) xb_add(&bar[XB_TOPGEN], 1u);
            else XB_SPIN(xb_ld(&bar[XB_TOPGEN]) == tg, bar);
            __builtin_amdgcn_fence(__ATOMIC_ACQUIRE, "agent");
            xb_add(&bar[XB_XGEN(b.x)], 1u);
            asm volatile("s_waitcnt vmcnt(0)" ::: "memory");
        } else {
            XB_SPIN(xb_ld(&bar[XB_XGEN(b.x)]) == gen, bar);
            __builtin_amdgcn_fence(__ATOMIC_ACQUIRE, "agent");
            asm volatile("s_waitcnt vmcnt(0)" ::: "memory");
        }
    }
    __syncthreads();
}

constexpr int XB_WS_OFF = 65536, XB_LDS_OFF = LDS_BYTES - 64, CTL_ZERO_BYTES = 262144;

template <int ONLY> __global__ void __launch_bounds__(NTHR, 2) yoco_fwd_t(Params P) {
    extern __shared__ __attribute__((aligned(16))) unsigned char lds_raw[];
    LAS uchar* lds = (LAS uchar*)lds_raw;
    if (threadIdx.x < 16) ((LAS unsigned*)(lds + XB_LDS_OFF))[threadIdx.x] = 0u;
    __syncthreads();
    if (P.ph_hi - P.ph_lo > 1) (void)xcd_barrier_post((unsigned*)(P.ws + XB_WS_OFF), (volatile LAS unsigned*)(lds + XB_LDS_OFF));
    if (P.ph_lo == 0) {
        const int lane0 = threadIdx.x & 63, wave0 = threadIdx.x >> 6;
        rope_table(P.ws, blockIdx.x * NWAVES + wave0, gridDim.x * NWAVES, lane0);
    }
    for (int step = P.ph_lo; step < P.ph_hi; ++step) {
        const int ph = P.prog[step];
        int tid_ = threadIdx.x; asm volatile("" : "+v"(tid_));
        const int tid = tid_;
#define LWG() const int lane = tid & 63, wave = __builtin_amdgcn_readfirstlane(tid >> 6); const int gw = bx * NWAVES + wave, NGW = G * NWAVES; (void)lane; (void)gw; (void)NGW
        int G_ = gridDim.x, bx_ = blockIdx.x; asm volatile("" : "+s"(G_), "+s"(bx_));
        const int G = G_, bx = bx_;
        uchar* ws = P.ws; float* out = P.out; int zz = 0;
        asm volatile("" : "+s"(ws), "+s"(out), "+s"(zz));
#define PIN(i) (P.in[(i) + zz])
        float* H = out + O_Y; bf16* HB = (bf16*)(ws + WS_HB); float* ssq = (float*)(ws + WS_SSQ);
        bf16* HID = (bf16*)(ws + WS_R + R_HID);
        bf16* RQ = (bf16*)(out + O_KP); bf16* RK = RQ + (size_t)T * D;
        bf16* VO = (bf16*)(ws + WS_R + R_VO); bf16* GG = (bf16*)(ws + WS_R + R_G);
        bf16* QF = (bf16*)(ws + WS_R + R_QF); bf16* K2B = (bf16*)(ws + WS_R + R_K2B); bf16* V2B = (bf16*)(ws + WS_R + R_V2B);
        float* biasP = (float*)(ws + WS_BIASP); float* biasS = (float*)(ws + WS_BIASS);
        const float* rope = (const float*)(ws + WS_ROPE);
        int kind, f = 0;
        switch (ph) {
            case 0: kind = 0; break;
            case 1: kind = 1; f = 0; break;   case 2: kind = 2; f = 0; break;
            case 3: kind = 3; break;          case 4: kind = 4; break;        case 5: kind = 5; break;
            case 6: kind = 2; f = 4; break;
            case 7: kind = 1; f = 1; break;   case 8: kind = 2; f = 1; break;
            case 9: kind = 1; f = 2; break;   case 10: kind = 7; break;
            case 11: kind = 1; f = 2; break;  case 12: kind = 2; f = 2; break;
            case 13: kind = 8; break;         case 14: kind = 9; break;
            case 15: kind = 2; f = 5; break;
            case 16: kind = 1; f = 3; break;  case 17: kind = 2; f = 3; break;
            case 20: kind = 11; break;
            case 19: kind = 2; f = 8; break;
            default: kind = 10; break;
        }
        if (KSEL(0) && kind == 0) {
            LWG();
            phase_prologue(P, ws, out, lds, gw, NGW, wave, lane);
        } else if (KSEL(1) && kind == 1) {
            const int N = f == 2 ? 2 * FF + 2304 : 2 * FF;
            pg8::Gemm g{HB, (const bf16*)(ws + WS_WIN + win_slot(f) * SZ_WIN), T, N, D}; pg8::StaticOrder S; S.init(T, N, G, bx);
            rstd_prepass(lds, ssq, S, tid);
            const LAS _Float16* rl = (const LAS _Float16*)(lds + RL_OFF);
            pg8::EpiSwiKVF E{pg8::EpiSwiGLU{HID, rl}, pg8::EpiKVF{out, K2B, V2B, rl, PIN(18)}};
            pg8::gemm_phase<pg8::EpiSwiKVF, pg8::StaticOrder, true, true>(lds, g, S, E);
        } else if (KSEL(2) && kind == 2) {
            const bf16* A; const bf16* Bt; int K; float alpha;
            if (f == 8) { A = HID; Bt = (const bf16*)(ws + WS_WOUT); K = FF; alpha = 0.0f; }
            else if (f < 4) { A = HID; Bt = (const bf16*)(ws + WS_WOUT + f * SZ_WOUT); K = FF; alpha = 0.5f; }
            else if (f == 4) { A = VO; Bt = (const bf16*)(ws + WS_ROUT); K = 2048; alpha = 1.0f; }
            else { A = QF; Bt = (const bf16*)(ws + WS_WO); K = D; alpha = 1.0f; }
            pg8::Gemm g{A, Bt, T, D, K}; pg8::StaticOrder S; S.init(T, D, G, bx);
            pg8::EpiRes E{HB, ssq, alpha};
            pg8::gemm_phase<pg8::EpiRes, pg8::StaticOrder, true, true>(lds, g, S, E);
        } else if (KSEL(3) && kind == 3) {
            pg8::Gemm g{HB, (const bf16*)(ws + WS_RIN), T, 6144, D}; pg8::StaticOrder S; S.init(T, 6144, G, bx);
            rstd_prepass(lds, ssq, S, tid); pg8::EpiRetIn E{RQ, RK, VO, GG, (const LAS _Float16*)(lds + RL_OFF), rope};
            pg8::gemm_phase<pg8::EpiRetIn, pg8::StaticOrder, true, true>(lds, g, S, E);
        } else if (KSEL(4) && kind == 4) {
            for (int it = bx; it < 256 + 512; it += G) {
                const bool samp = it >= 256; const int q = samp ? it - 256 : it;
                const int sl = q & 3, h = (q >> 2) & 3, b = q >> 4;
                const float lg2 = h == 0 ? -0.04580368961312479f : h == 1 ? -0.02272007650008353f : h == 2 ? -0.011315313227834146f : -0.005646563141142063f;
                const size_t rowbase = samp ? (size_t)TP + (size_t)b * DSEQ : (size_t)b * SEQ;
                const float* S0 = samp ? PIN(2) + (size_t)(b * 4 + h) * 256 * 512 : nullptr;
                float* Sout = out + (samp ? O_SRS : O_SRP) + (size_t)(b * 4 + h) * 256 * 512;
                ret_item(lds, RQ, RK, VO, rowbase, h, sl, samp ? 1 : 64, S0, Sout, lg2);
            }
        } else if (KSEL(5) && kind == 5) {
            LWG();
            const float* gn = PIN(14); (void)gn;
            constexpr int NR = 4;
            for (int row0 = gw; row0 < T; row0 += NR * NGW) {
                u32x4 ov[NR][4], gv[NR][4];
#pragma unroll
                for (int u = 0; u < NR; ++u) { const int row = row0 + u * NGW < T ? row0 + u * NGW : row0;
                    const u32x4* op = (const u32x4*)(VO + (size_t)row * 2048 + lane * 32); const u32x4* gp = (const u32x4*)(GG + (size_t)row * 2048 + lane * 32);
#pragma unroll
                    for (int i = 0; i < 4; ++i) { ov[u][i] = op[i]; gv[u][i] = gp[i]; } }
#pragma unroll
                for (int u = 0; u < NR; ++u) {
                    const int row = row0 + u * NGW; if (row >= T) break;
                    float s = 0.f, s2 = 0.f;
#pragma unroll
                    for (int i = 0; i < 4; ++i)
#pragma unroll
                        for (int j = 0; j < 4; ++j) { const float a = bflo(ov[u][i][j]), bq = bfhi(ov[u][i][j]); s += a + bq; s2 += a * a + bq * bq; }
#pragma unroll
                    for (int o = 1; o < 16; o <<= 1) { s += __shfl_xor(s, o); s2 += __shfl_xor(s2, o); }
                    const float mu = s * (1.f / 512.f), var = fmaxf(s2 * (1.f / 512.f) - mu * mu, 0.f), rstd = __builtin_amdgcn_rsqf(var + EPS);
                    u32x4* op = (u32x4*)(VO + (size_t)row * 2048 + lane * 32);
#pragma unroll
                    for (int i = 0; i < 4; ++i) { u32x4 w;
#pragma unroll
                        for (int j = 0; j < 4; ++j) w[j] = pk((bflo(ov[u][i][j]) - mu) * rstd * bflo(gv[u][i][j]), (bfhi(ov[u][i][j]) - mu) * rstd * bfhi(gv[u][i][j]));
                        op[i] = w; }
                }
            }
        } else if (KSEL(7) && kind == 7) {
            LWG();
            {
                const int gt = gw * 64 + lane, NGT = NGW * 64;
                constexpr int NPIECE = NB_S * PAST * D / 8; const float* in3 = PIN(3); const float* in4 = PIN(4);
                for (int p0 = gt; p0 < 2 * NPIECE; p0 += 4 * NGT) {
                    f32x4 a[4], bq[4];
#pragma unroll
                    for (int u = 0; u < 4; ++u) { const int p = p0 + u * NGT < 2 * NPIECE ? p0 + u * NGT : p0; const bool isv = p >= NPIECE; const int q = isv ? p - NPIECE : p;
                        const float* src = (isv ? in4 : in3) + (size_t)(q >> 7) * D + (q & 127) * 8; a[u] = __builtin_nontemporal_load((const f32x4*)src); bq[u] = __builtin_nontemporal_load((const f32x4*)(src + 4)); }
#pragma unroll
                    for (int u = 0; u < 4; ++u) { const int p = p0 + u * NGT; if (p >= 2 * NPIECE) break; const bool isv = p >= NPIECE; const int q = isv ? p - NPIECE : p;
                        const int row = q >> 7, c8 = q & 127; const int b_ = row >> 10, s = row & 1023;
                        u32x4 w; w[0] = pk(a[u][0], a[u][1]); w[1] = pk(a[u][2], a[u][3]); w[2] = pk(bq[u][0], bq[u][1]); w[3] = pk(bq[u][2], bq[u][3]);
                        *(u32x4*)((isv ? V2B : K2B) + ((size_t)TP + (size_t)b_ * KSAMP + s) * D + c8 * 8) = w; }
                }
            }

            for (int seq = bx; seq < 768; seq += G) {
                const bool samp = seq >= 256; const int ss = samp ? seq - 256 : seq; const int b_ = ss >> 4, h = ss & 15;
                const int L = samp ? KSAMP : SEQ, n = samp ? 3 : 8, s0 = tid * n;
                float* dst = samp ? biasS + (size_t)ss * KSAMP : biasP + (size_t)ss * SEQ;
                float v[8]; float sum = 0.f;
#pragma unroll
                for (int i = 0; i < 8; ++i) { const int s = s0 + i; float x = 0.f;
                    if (i < n && s < L) x = samp ? (s < PAST ? PIN(5)[((size_t)b_ * PAST + s) * 16 + h] : out[O_LFS + ((size_t)b_ * DSEQ + (s - PAST)) * 16 + h]) : out[O_LFP + ((size_t)b_ * SEQ + s) * 16 + h];
                    sum += x; v[i] = sum; }
                float inc = sum;
#pragma unroll
                for (int o = 1; o < 64; o <<= 1) { const float t = __shfl_up(inc, o); if (lane >= o) inc += t; }
                LAS float* wt = (LAS float*)lds;
                __syncthreads();
                if (lane == 63) wt[wave] = inc;
                __syncthreads();
                float base = inc - sum;
#pragma unroll
                for (int w2 = 0; w2 < 8; ++w2) if (w2 < wave) base += wt[w2];
#pragma unroll
                for (int i = 0; i < 8; ++i) { const int s = s0 + i; if (i < n && s < L) dst[s] = -(base + v[i]) * LOG2E; }
            }
        } else if (KSEL(8) && kind == 8) {
            pg8::Gemm g{HB, (const bf16*)(ws + WS_WQ), T, D, D}; pg8::StaticOrder S; S.init(T, D, G, bx);
            rstd_prepass(lds, ssq, S, tid); pg8::EpiQ E{QF, (const LAS _Float16*)(lds + RL_OFF)};
            pg8::gemm_phase<pg8::EpiQ, pg8::StaticOrder, true, true>(lds, g, S, E);
        } else if (KSEL(9) && kind == 9) {
            for (int u = bx; u < 4096 + 512; u += G) {
                const bool samp = u >= 4096; const int us = u - 4096;
                int bh = samp ? us : (u & 255), qb = 15 - (u >> 8);
                if (!samp && G == 256) {
                    const int k = u >> 8, xcd = bx & 7, idx = bx >> 3, g = idx >> 2, mem = idx & 3, rr = k >> 2, kk = k & 3;
                    bh = xcd * 32 + rr * 8 + g; qb = kk == 0 ? 15 - mem : kk == 1 ? 11 - mem : kk == 2 ? mem + 4 : mem;
                }
                const int b_ = bh >> 4, h = bh & 15;
                const size_t qrow0 = samp ? (size_t)TP + b_ * DSEQ : (size_t)b_ * SEQ + qb * 256;
                const size_t krow0 = samp ? (size_t)TP + (size_t)b_ * KSAMP : (size_t)b_ * SEQ;
                fox_unit(lds, QF, K2B, V2B, QF, qrow0, samp ? 64 : 256, krow0, samp ? 17 : 4 * (qb + 1), samp ? PAST : qb * 256, h,
                         samp ? biasS + (size_t)us * KSAMP : biasP + (size_t)bh * SEQ);
            }
        } else if (KSEL(10) && kind == 10) {
            LWG();
            const float* fg = PIN(21);
            constexpr int NR = 4;
            for (int row0 = gw; row0 < T; row0 += NR * NGW) {
                u32x2 hv[NR][4]; float rsv[NR];
#pragma unroll
                for (int u = 0; u < NR; ++u) { const int row = row0 + u * NGW < T ? row0 + u * NGW : row0; const u32x2* bp = (const u32x2*)(HB + (size_t)row * D);
#pragma unroll
                    for (int j = 0; j < 4; ++j) hv[u][j] = bp[lane + 64 * j];
                    rsv[u] = row_rstd(ssq, row); }
#pragma unroll
                for (int u = 0; u < NR; ++u) {
                    const int row = row0 + u * NGW; if (row >= T) break;
                    f32x4* hp = (f32x4*)(H + (size_t)row * D); const float rs = rsv[u];
#pragma unroll
                    for (int j = 0; j < 4; ++j) { const u32x2 x = hv[u][j]; const f32x4 v = {bflo(x[0]), bfhi(x[0]), bflo(x[1]), bfhi(x[1])}, gq = ((const f32x4*)fg)[lane + 64 * j]; __builtin_nontemporal_store(v * rs * gq, hp + lane + 64 * j); }
                }
            }
        }
        if (step + 1 < P.ph_hi) { if (P.ph_lo < 0) cg::this_grid().sync(); else { XcdBarrier xb; xb.bar = (unsigned*)(ws + XB_WS_OFF); xb.x = xb_xcc_id(); xb.st = (volatile LAS unsigned*)(lds + XB_LDS_OFF); xcd_barrier(xb); } }
    }
}

#ifdef DIAG
template __global__ void yoco_fwd_t<0>(Params); template __global__ void yoco_fwd_t<1>(Params); template __global__ void yoco_fwd_t<2>(Params); template __global__ void yoco_fwd_t<3>(Params);
template __global__ void yoco_fwd_t<4>(Params); template __global__ void yoco_fwd_t<5>(Params); template __global__ void yoco_fwd_t<6>(Params); template __global__ void yoco_fwd_t<7>(Params);
template __global__ void yoco_fwd_t<8>(Params); template __global__ void yoco_fwd_t<9>(Params); template __global__ void yoco_fwd_t<10>(Params);
#endif
#define yoco_fwd yoco_fwd_t<-1>
#ifndef MK_ONE_LAUNCH
#define MK_ONE_LAUNCH 1
#endif
constexpr int N_PHASES = 19;
extern "C" void kernel_launch(void* const* d_in, const int* in_sizes, int n_in, void* d_out, int out_size, void* d_ws, size_t ws_size, hipStream_t stream) {
    static int grid = 0;
    if (grid == 0) {
        if (n_in != 22 || ws_size < WS_END) { fprintf(stderr, "kernel_launch: unexpected n_in %d / ws %zu\n", n_in, ws_size); grid = -1; return; }
        int dev = 0, cus = 0, per_cu = 0;
        hipGetDevice(&dev); hipDeviceGetAttribute(&cus, hipDeviceAttributeMultiprocessorCount, dev);
        if (hipFuncSetAttribute((const void*)yoco_fwd, hipFuncAttributeMaxDynamicSharedMemorySize, LDS_BYTES) != hipSuccess) { fprintf(stderr, "kernel_launch: hipFuncSetAttribute failed\n"); grid = -1; return; }
        if (hipOccupancyMaxActiveBlocksPerMultiprocessor(&per_cu, (const void*)yoco_fwd, NTHR, LDS_BYTES) != hipSuccess || per_cu < 1) { fprintf(stderr, "kernel_launch: occupancy query says %d\n", per_cu); per_cu = 1; }
        (void)hipGetLastError();
        grid = cus * 1;
    }
    if (grid < 0) return;
    Params p{};
    for (int i = 0; i < 22; ++i) p.in[i] = (const float*)d_in[i];
    p.out = (float*)d_out; p.ws = (unsigned char*)d_ws;
#ifndef MK_PROG
#define MK_PROG 0,1,2,3,4,5,6,7,8,9,10,12,13,14,15,16,17,18
#endif
    const unsigned char prog[] = {MK_PROG}; const int nprog = (int)sizeof(prog);
    for (int i = 0; i < nprog && i < 32; ++i) p.prog[i] = prog[i];
#if MK_ONE_LAUNCH
    if (hipMemsetAsync(d_ws, 0, CTL_ZERO_BYTES, stream) != hipSuccess) { fprintf(stderr, "kernel_launch: hipMemsetAsync failed\n"); return; }
    p.ph_lo = 0; p.ph_hi = nprog;
    void* args[] = {&p};
    hipError_t e = hipLaunchCooperativeKernel((const void*)yoco_fwd, dim3(grid), dim3(NTHR), args, LDS_BYTES, stream);
    if (e != hipSuccess) fprintf(stderr, "cooperative launch failed: %s (grid %d)\n", hipGetErrorString(e), grid);
#else
    for (int ph = 0; ph < nprog; ++ph) { p.ph_lo = ph; p.ph_hi = ph + 1; hipLaunchKernelGGL(yoco_fwd, dim3(grid), dim3(NTHR), LDS_BYTES, stream, p); }
#endif
}
```

```cpp
#include <hip/hip_runtime.h>
#include <cstdio>
#include <cstdint>
namespace pg8 {
#define PG8_LAS __attribute__((address_space(3)))
typedef unsigned short bf16_t;
typedef short bf16x8 __attribute__((ext_vector_type(8)));
typedef float f32x4 __attribute__((ext_vector_type(4)));
typedef unsigned u32x4 __attribute__((ext_vector_type(4)));
constexpr int BM = 256, BK = 64, HALF = 128, HTB = HALF * BK * 2  , STAGE_BYTES = 8 * HTB, NXCD = 8, WGM = 8;

__host__ __device__ __forceinline__ int lds_byte(int r, int c) { const int st = (r >> 4) * 2 + (c >> 5), rr = r & 15, cc = c & 31, ob = rr * 64 + cc * 2; return st * 1024 + (ob ^ (((ob >> 9) & 1) << 5)); }
__host__ __device__ __forceinline__ void stage_rc(int b, int& R, int& C) { const int st = b / 1024, sb = b % 1024, swz = sb ^ (((sb >> 9) & 1) << 5); R = (st >> 1) * 16 + swz / 64; C = (st & 1) * 32 + (swz % 64) / 2; }
__host__ __device__ __forceinline__ int perm32(int rho) { const int n = rho >> 4, i = rho & 15; return 8 * (i >> 2) + 4 * n + (i & 3); }

struct Unit { int pm, pn; };
struct Gemm { const bf16_t* A; const bf16_t* Bt; int M, N, K; };

struct StaticOrder {
    int nM, nN, nwg, G, c;
    __host__ __device__ void init(int M, int N, int G_, int c_) { nM = M / BM; nN = N / BM; nwg = nM * nN; G = G_; c = c_; }
    __host__ __device__ bool next(int i, Unit& u) const {
        const long L = (long)i * G + c; if (L >= nwg) return false;
        int wgid = (int)L; { const int q = nwg / NXCD, r = nwg % NXCD, xcd = wgid % NXCD, off = wgid / NXCD; wgid = (xcd < r ? xcd * (q + 1) : r * (q + 1) + (xcd - r) * q) + off; }
        const int nig = WGM * nN, gid = wgid / nig, fm = gid * WGM, gsz = (nM - fm) < WGM ? (nM - fm) : WGM;
        u.pm = fm + ((wgid % nig) % gsz); u.pn = (wgid % nig) / gsz; return true;
    }
    __device__ __forceinline__ void a_ready(const Unit&) const {}
    __device__ __forceinline__ void done(const Unit&) const {}
};

__device__ __forceinline__ unsigned cvt_pk_bf16(float lo, float hi) { unsigned r; asm volatile("v_cvt_pk_bf16_f32 %0, %1, %2" : "=v"(r) : "v"(lo), "v"(hi)); return r; }
typedef float f32x2 __attribute__((ext_vector_type(2)));
template <class Epi, class Sched, bool ALIGN_EPI = false, bool SP2 = false>
__device__ __forceinline__ void gemm_phase(PG8_LAS unsigned char* lds, const Gemm g, const Sched& S, const Epi& E) {
    int tid_ = threadIdx.x; asm volatile("" : "+v"(tid_));
    const int tid = tid_, wid = __builtin_amdgcn_readfirstlane(tid >> 6), lane = tid & 63, wr = wid >> 2, wc = wid & 3, fr = lane & 15, fq = lane >> 4;
    const int K = g.K, nt = K / BK;
    unsigned voffA[2], voffB[2];
#pragma unroll
    for (int i = 0; i < 2; ++i) { int R, C; stage_rc(tid * 16 + i * 8192, R, C); const int Rb = Epi::PERM ? ((R & ~31) + perm32(R & 31)) : R;
        voffA[i] = (unsigned)(R * K + C) * 2u; voffB[i] = (unsigned)(Rb * K + C) * 2u; }
    const size_t kstep = (size_t)(BK * 2);
    const size_t hstep = (size_t)HALF * K * 2;
    const size_t tstep = 2 * hstep;
    const unsigned ldsw = (unsigned)wid * 1024u;
    const int aoff = lds_byte(wr * 64 + fr, fq * 8), boff = lds_byte(wc * 32 + fr, fq * 8);
#define PG8_SA(b, h) (((b) * 2 + (h)) * HTB)
#define PG8_SB(b, h) ((4 + (b) * 2 + (h)) * HTB)
#define PG8_STAGE(bufoff, gbase, voff) do { _Pragma("unroll") for (int _i = 0; _i < 2; ++_i) \
        __builtin_amdgcn_global_load_lds((const unsigned*)((const char*)(gbase) + (voff)[_i]), (PG8_LAS unsigned*)(lds + (bufoff) + ldsw + _i * 8192), 16, 0, 0); } while (0)
#define PG8_LDA(dst, b, h) do { _Pragma("unroll") for (int m = 0; m < 4; ++m) _Pragma("unroll") for (int k = 0; k < 2; ++k) dst[m][k] = *(const PG8_LAS bf16x8*)(lds + PG8_SA(b, h) + aoff + m * 2048 + k * 1024); } while (0)
#define PG8_LDB(dst, b, h) do { _Pragma("unroll") for (int n = 0; n < 2; ++n) _Pragma("unroll") for (int k = 0; k < 2; ++k) dst[n][k] = *(const PG8_LAS bf16x8*)(lds + PG8_SB(b, h) + boff + n * 2048 + k * 1024); } while (0)
#define PG8_MMA(ai, bj, At, Bt) do { __builtin_amdgcn_s_setprio(1); _Pragma("unroll") for (int m = 0; m < 4; ++m) _Pragma("unroll") for (int n = 0; n < 2; ++n) _Pragma("unroll") for (int k = 0; k < 2; ++k) \
        acc[ai][bj][m][n] = __builtin_amdgcn_mfma_f32_16x16x32_bf16(Bt[n][k], At[m][k], acc[ai][bj][m][n], 0, 0, 0); __builtin_amdgcn_s_setprio(0); } while (0)
#define PG8_WAIT_V(n) asm volatile("s_waitcnt vmcnt(" #n ")" ::: "memory")
#define PG8_WAIT_L(n) asm volatile("s_waitcnt lgkmcnt(" #n ")" ::: "memory")
#define PG8_BAR __builtin_amdgcn_s_barrier()
#define PG8_SCHED __builtin_amdgcn_sched_barrier(0)
    Unit cur, nxt; int ui = 0;
    if (!S.next(0, cur)) return;
    f32x4 acc[2][2][4][2];
#pragma unroll
    for (int a = 0; a < 2; ++a)
#pragma unroll
        for (int b = 0; b < 2; ++b)
#pragma unroll
            for (int m = 0; m < 4; ++m)
#pragma unroll
                for (int n = 0; n < 2; ++n) acc[a][b][m][n] = (f32x4){0.f, 0.f, 0.f, 0.f};
    bf16x8 At[4][2], B0[2][2], B1[2][2];
    const char* cA = (const char*)g.A + (size_t)cur.pm * tstep; const char* cB = (const char*)g.Bt + (size_t)cur.pn * tstep;
    S.a_ready(cur);
    if constexpr (SP2) {
        PG8_STAGE(PG8_SB(0, 0), cB, voffB); PG8_STAGE(PG8_SB(0, 1), cB + hstep, voffB); PG8_STAGE(PG8_SA(0, 0), cA, voffA); PG8_STAGE(PG8_SA(0, 1), cA + hstep, voffA);
        if (wr == 1) PG8_BAR;
        PG8_WAIT_V(2); PG8_BAR;
        PG8_STAGE(PG8_SB(1, 0), cB + kstep, voffB); PG8_STAGE(PG8_SA(1, 0), cA + kstep, voffA); PG8_STAGE(PG8_SB(1, 1), cB + hstep + kstep, voffB);
        PG8_WAIT_V(6); PG8_BAR;
    } else {
        PG8_STAGE(PG8_SB(0, 0), cB, voffB); PG8_STAGE(PG8_SA(0, 0), cA, voffA); PG8_STAGE(PG8_SB(0, 1), cB + hstep, voffB); PG8_STAGE(PG8_SA(0, 1), cA + hstep, voffA);
        if (wr == 1) PG8_BAR;
        PG8_WAIT_V(4); PG8_BAR;
        PG8_STAGE(PG8_SB(1, 0), cB + kstep, voffB); PG8_STAGE(PG8_SA(1, 0), cA + kstep, voffA); PG8_STAGE(PG8_SB(1, 1), cB + hstep + kstep, voffB);
        PG8_WAIT_V(6); PG8_BAR;
    }
    for (;;) {
        const bool has_next = S.next(ui + 1, nxt);
        const char* nA = has_next ? (const char*)g.A + (size_t)nxt.pm * tstep : cA; const char* nB = has_next ? (const char*)g.Bt + (size_t)nxt.pn * tstep : cB;
        for (int t = 0; t < nt; t += 2) {
            const bool last = (t == nt - 2);
            const char* a1 = cA + (size_t)(t + 1) * kstep;
            const char* a2 = last ? nA : cA + (size_t)(t + 2) * kstep; const char* b2 = last ? nB : cB + (size_t)(t + 2) * kstep;
            const char* a3 = a2 + kstep; const char* b3 = b2 + kstep;
            if (last && has_next) S.a_ready(nxt);
            if constexpr (SP2) {
            PG8_LDB(B0, 0, 0); PG8_LDB(B1, 0, 1); PG8_SCHED; PG8_LDA(At, 0, 0); PG8_STAGE(PG8_SA(1, 1), a1 + hstep, voffA);
            PG8_WAIT_V(8); PG8_WAIT_L(0); PG8_BAR; PG8_MMA(0, 0, At, B0); PG8_MMA(0, 1, At, B1); PG8_BAR; PG8_SCHED;
            PG8_LDA(At, 0, 1); PG8_STAGE(PG8_SB(0, 0), b2, voffB); PG8_STAGE(PG8_SB(0, 1), b2 + hstep, voffB); PG8_STAGE(PG8_SA(0, 0), a2, voffA);
            PG8_WAIT_V(8); PG8_WAIT_L(0); PG8_BAR; PG8_MMA(1, 0, At, B0); PG8_MMA(1, 1, At, B1); PG8_BAR; PG8_SCHED;
            PG8_LDB(B0, 1, 0); PG8_LDB(B1, 1, 1); PG8_SCHED; PG8_LDA(At, 1, 0); PG8_STAGE(PG8_SA(0, 1), a2 + hstep, voffA);
            PG8_WAIT_V(8); PG8_WAIT_L(0); PG8_BAR; PG8_MMA(0, 0, At, B0); PG8_MMA(0, 1, At, B1); PG8_BAR; PG8_SCHED;
            PG8_LDA(At, 1, 1); PG8_STAGE(PG8_SB(1, 0), b3, voffB); PG8_STAGE(PG8_SB(1, 1), b3 + hstep, voffB); PG8_STAGE(PG8_SA(1, 0), a3, voffA);
            PG8_WAIT_V(8); PG8_WAIT_L(0); PG8_BAR; PG8_MMA(1, 0, At, B0); PG8_MMA(1, 1, At, B1); PG8_BAR; PG8_SCHED;
            } else {
            PG8_LDB(B0, 0, 0); PG8_SCHED; PG8_LDA(At, 0, 0); PG8_STAGE(PG8_SA(1, 1), a1 + hstep, voffA);
            PG8_WAIT_L(8); PG8_BAR; PG8_WAIT_L(0); PG8_MMA(0, 0, At, B0); PG8_BAR; PG8_SCHED;
            PG8_LDB(B1, 0, 1); PG8_STAGE(PG8_SB(0, 0), b2, voffB);
            PG8_BAR; PG8_WAIT_L(0); PG8_MMA(0, 1, At, B1); PG8_BAR;
            PG8_LDA(At, 0, 1); PG8_STAGE(PG8_SA(0, 0), a2, voffA);
            PG8_BAR; PG8_WAIT_L(0); PG8_MMA(1, 0, At, B0); PG8_BAR; PG8_SCHED;
            PG8_STAGE(PG8_SB(0, 1), b2 + hstep, voffB);
            PG8_WAIT_V(6); PG8_BAR; PG8_MMA(1, 1, At, B1); PG8_BAR;
            PG8_LDB(B0, 1, 0); PG8_SCHED; PG8_LDA(At, 1, 0); PG8_STAGE(PG8_SA(0, 1), a2 + hstep, voffA);
            PG8_WAIT_L(8); PG8_BAR; PG8_WAIT_L(0); PG8_MMA(0, 0, At, B0); PG8_BAR; PG8_SCHED;
            PG8_LDB(B1, 1, 1); PG8_STAGE(PG8_SB(1, 0), b3, voffB);
            PG8_BAR; PG8_WAIT_L(0); PG8_MMA(0, 1, At, B1); PG8_BAR;
            PG8_LDA(At, 1, 1); PG8_STAGE(PG8_SA(1, 0), a3, voffA);
            PG8_BAR; PG8_WAIT_L(0); PG8_MMA(1, 0, At, B0); PG8_BAR; PG8_SCHED;
            PG8_STAGE(PG8_SB(1, 1), b3 + hstep, voffB);
            PG8_WAIT_V(6); PG8_BAR; PG8_MMA(1, 1, At, B1); PG8_BAR;
            }
        }
        if constexpr (ALIGN_EPI) { if (wr == 0) PG8_BAR; }
        if constexpr (!Epi::AFTER_DRAIN) { E(acc, cur, wr, wc, fr, fq, ui); S.done(cur); }
        if (!has_next) break;
#pragma unroll
        for (int a = 0; a < 2; ++a)
#pragma unroll
            for (int b = 0; b < 2; ++b)
#pragma unroll
                for (int m = 0; m < 4; ++m)
#pragma unroll
                    for (int n = 0; n < 2; ++n) acc[a][b][m][n] = (f32x4){0.f, 0.f, 0.f, 0.f};
        cur = nxt; cA = nA; cB = nB; ++ui;
        if constexpr (ALIGN_EPI) { if (wr == 1) PG8_BAR; }
    }
    PG8_WAIT_V(0);
    if constexpr (!ALIGN_EPI) { if (wr == 0) PG8_BAR; }
    PG8_BAR;
    if constexpr (Epi::AFTER_DRAIN) { E.fused(acc, cur, wr, wc, fr, fq, lds, wid, lane); S.done(cur); }
#undef PG8_SA
#undef PG8_SB
#undef PG8_STAGE
#undef PG8_LDA
#undef PG8_LDB
#undef PG8_MMA
#undef PG8_WAIT_V
#undef PG8_WAIT_L
#undef PG8_BAR
#undef PG8_SCHED
}
}
static __device__ const double INVF[128] = {
  1.0, 0.930572040929699, 0.8659643233600653, 0.8058421877614819,
  0.7498942093324559, 0.6978305848598664, 0.6493816315762113, 0.6042963902381329,
  0.5623413251903491, 0.5232991146814947, 0.4869675251658631, 0.4531583637600818,
  0.4216965034285822, 0.3924189758484536, 0.3651741272548377, 0.33982083289425596,
  0.31622776601683794, 0.29427271762092816, 0.27384196342643613, 0.25482967479793467,
  0.23713737056616552, 0.220673406908459, 0.2053525026457146, 0.19109529749704404,
  0.1778279410038923, 0.16548170999431813, 0.1539926526059492, 0.14330125702369628,
  0.1333521432163324, 0.12409377607517195, 0.11547819846894582, 0.10746078283213174,
  0.1, 0.0930572040929699, 0.08659643233600653, 0.08058421877614819,
  0.07498942093324558, 0.06978305848598663, 0.06493816315762113, 0.060429639023813285,
  0.05623413251903491, 0.05232991146814947, 0.04869675251658631, 0.04531583637600818,
  0.042169650342858224, 0.03924189758484536, 0.03651741272548377, 0.03398208328942559,
  0.03162277660168379, 0.029427271762092817, 0.027384196342643614, 0.025482967479793464,
  0.023713737056616554, 0.0220673406908459, 0.02053525026457146, 0.019109529749704406,
  0.01778279410038923, 0.016548170999431813, 0.01539926526059492, 0.014330125702369627,
  0.01333521432163324, 0.012409377607517195, 0.011547819846894581, 0.010746078283213174,
  0.01, 0.00930572040929699, 0.008659643233600654, 0.008058421877614819,
  0.007498942093324558, 0.006978305848598663, 0.006493816315762113, 0.006042963902381328,
  0.005623413251903491, 0.005232991146814947, 0.004869675251658631, 0.004531583637600818,
  0.004216965034285823, 0.003924189758484536, 0.003651741272548377, 0.003398208328942559,
  0.0031622776601683794, 0.002942727176209282, 0.0027384196342643613, 0.0025482967479793467,
  0.0023713737056616554, 0.0022067340690845897, 0.002053525026457146, 0.0019109529749704406,
  0.0017782794100389228, 0.0016548170999431814, 0.001539926526059492, 0.0014330125702369627,
  0.001333521432163324, 0.0012409377607517195, 0.0011547819846894581, 0.0010746078283213176,
  0.001, 0.0009305720409296989, 0.0008659643233600654, 0.0008058421877614818,
  0.0007498942093324559, 0.0006978305848598664, 0.0006493816315762113, 0.0006042963902381329,
  0.0005623413251903491, 0.0005232991146814947, 0.0004869675251658631, 0.0004531583637600818,
  0.00042169650342858224, 0.0003924189758484536, 0.0003651741272548377, 0.00033982083289425596,
  0.00031622776601683794, 0.00029427271762092817, 0.0002738419634264361, 0.00025482967479793463,
  0.00023713737056616554, 0.00022067340690845897, 0.0002053525026457146, 0.00019109529749704405,
  0.00017782794100389227, 0.00016548170999431815, 0.0001539926526059492, 0.00014330125702369627,
  0.0001333521432163324, 0.00012409377607517196, 0.00011547819846894582, 0.00010746078283213175
};

#include <hip/hip_cooperative_groups.h>
namespace cg = cooperative_groups;
#define LAS __attribute__((address_space(3)))
#define DI __device__ __forceinline__
typedef unsigned short bf16;
typedef short bf16x8 __attribute__((ext_vector_type(8)));
typedef short s16x4 __attribute__((ext_vector_type(4)));
typedef short v4i16_t __attribute__((ext_vector_type(4)));
typedef float f32x4 __attribute__((ext_vector_type(4)));
typedef float f32x16 __attribute__((ext_vector_type(16)));
typedef unsigned u32x4 __attribute__((ext_vector_type(4)));
typedef unsigned u32x2 __attribute__((ext_vector_type(2)));
typedef float f32x2_t __attribute__((ext_vector_type(2)));
typedef __bf16 bf16x2_t __attribute__((ext_vector_type(2)));
typedef unsigned char uchar;

constexpr int NWAVES = 8, NTHR = 512;
constexpr int D = 1024, TP = 65536, TS = 2048, T = TP + TS, FF = 2816, SEQ = 4096, DSEQ = 64, PAST = 1024, KSAMP = PAST + DSEQ;
constexpr int NB_P = 16, NB_S = 32;
constexpr float EPS = 1e-6f;
constexpr float LOG2E = 1.4426950408889634f;
constexpr int LDS_BYTES = 159744;

constexpr size_t O_Y = 0, O_SRP = 69206016, O_KP = 77594624, O_VP = 144703488, O_LFP = 211812352, O_SRS = 212860928,
                 O_KS = 229638144, O_VS = 231735296, O_LFS = 233832448;
constexpr size_t SZ_WIN = (size_t)5632 * 1024 * 2, SZ_WOUT = (size_t)1024 * 2816 * 2, SZ_ACT = (size_t)T * 1024 * 2;
constexpr size_t WS_WIN = 1u << 20;
constexpr size_t WS_KVF = WS_WIN + 4 * SZ_WIN;
constexpr size_t WS_WOUT = WS_KVF + (size_t)2304 * 1024 * 2;
constexpr size_t WS_RIN = WS_WOUT + 4 * SZ_WOUT;
constexpr size_t WS_ROUT = WS_RIN + (size_t)6144 * 1024 * 2;
constexpr size_t WS_WQ = WS_ROUT + (size_t)1024 * 2048 * 2;
__host__ __device__ constexpr int win_slot(int f) { return f == 2 ? 3 : (f == 3 ? 2 : f); }
constexpr size_t WS_WO = WS_WQ + (size_t)1024 * 1024 * 2;
constexpr size_t WS_ROPE = WS_WO + (size_t)1024 * 1024 * 2;
constexpr size_t WS_SSQ = WS_ROPE + (size_t)4096 * 256 * 4;
constexpr size_t WS_BIASP = WS_SSQ + (size_t)T * 16 * 4;
constexpr size_t WS_BIASS = WS_BIASP + (size_t)256 * 4096 * 4;
constexpr size_t WS_HB = WS_BIASS + (size_t)512 * KSAMP * 4;
constexpr size_t WS_R = WS_HB + SZ_ACT;
constexpr size_t SZ_HID = (size_t)T * FF * 2, K2B_BYTES = (size_t)(TP + NB_S * KSAMP) * 1024 * 2;
constexpr size_t R_HID = 0, R_VO = 0, R_G = 2 * SZ_ACT, R_QF = 0, R_K2B = SZ_HID, R_V2B = R_K2B + K2B_BYTES;
constexpr size_t WS_END = WS_R + R_V2B + K2B_BYTES;
static_assert(R_G + 2 * SZ_ACT <= R_V2B + K2B_BYTES, "retention overlay");
static_assert(SZ_ACT <= SZ_HID && SZ_HID % 256 == 0, "qf overlay");
static_assert(WS_END <= (size_t)1073741824, "ws size");
static_assert(WS_HB % 256 == 0 && WS_R % 256 == 0 && WS_ROPE % 256 == 0 && WS_SSQ % 256 == 0, "align");

DI unsigned pk(float lo, float hi) { f32x2_t v = {lo, hi}; bf16x2_t b = __builtin_convertvector(v, bf16x2_t); return __builtin_bit_cast(unsigned, b); }
DI float bflo(unsigned w) { return __uint_as_float(w << 16); }
DI float bfhi(unsigned w) { return __uint_as_float(w & 0xffff0000u); }
DI float ex2(float x) { return __builtin_amdgcn_exp2f(x); }
DI float silu_f(float x) { return x * __builtin_amdgcn_rcpf(1.0f + __expf(-x)); }
DI float wave_sum(float v) {
#pragma unroll
    for (int o = 1; o < 64; o <<= 1) v += __shfl_xor(v, o);
    return v;
}
DI float row_rstd(const float* ssq, int row) {
    const f32x4* p = (const f32x4*)(ssq + (size_t)row * 16);
    const f32x4 a = p[0], b = p[1], c = p[2], d = p[3];
    const float s = (((a[0] + a[1]) + (a[2] + a[3])) + ((b[0] + b[1]) + (b[2] + b[3]))) + (((c[0] + c[1]) + (c[2] + c[3])) + ((d[0] + d[1]) + (d[2] + d[3])));
    return __builtin_amdgcn_rsqf(s * (1.0f / 1024.0f) + EPS);
}

namespace pg8 {
struct EpiSwiGLU {
    static constexpr bool PERM = true, AFTER_DRAIN = false;
    bf16_t* O; const LAS _Float16* rl;
    __device__ __forceinline__ void operator()(const f32x4 (&acc)[2][2][4][2], const Unit& u, int wr, int wc, int fr, int fq, int ui) const {
        const int row0 = u.pm * BM + wr * 64 + fr, col0 = u.pn * 128 + wc * 32 + 8 * fq;
        const LAS _Float16* rlu = rl + ui * 256 + wr * 64 + fr;
#pragma unroll
        for (int ai = 0; ai < 2; ++ai)
#pragma unroll
            for (int m = 0; m < 4; ++m) {
                const int row = row0 + ai * HALF + m * 16; const float rs = (float)rlu[ai * HALF + m * 16];
                u32x4 w;
#pragma unroll
                for (int n = 0; n < 2; ++n) {
                    const f32x4 g = acc[ai][0][m][n] * rs, up = acc[ai][1][m][n] * rs;
                    const float h0 = silu_f(g[0]) * up[0], h1 = silu_f(g[1]) * up[1], h2 = silu_f(g[2]) * up[2], h3 = silu_f(g[3]) * up[3];
                    w[2 * n] = pk(h0, h1); w[2 * n + 1] = pk(h2, h3);
                }
                *(u32x4*)(O + (size_t)row * FF + col0) = w;
            }
    }
};
struct EpiRes {
    static constexpr bool PERM = true, AFTER_DRAIN = false;
    bf16_t* HB; float* ssq; float alpha;
    __device__ __forceinline__ void operator()(const f32x4 (&acc)[2][2][4][2], const Unit& u, int wr, int wc, int fr, int fq, int ui) const {
        const int row0 = u.pm * BM + wr * 64 + fr, col0 = u.pn * BM + wc * 32 + 8 * fq;
#pragma unroll
        for (int ai = 0; ai < 2; ++ai) {
            asm volatile("" ::: "memory");
            u32x4 pre[4][2];
#pragma unroll
            for (int m = 0; m < 4; ++m)
#pragma unroll
                for (int bj = 0; bj < 2; ++bj) pre[m][bj] = *(const u32x4*)(HB + (size_t)(row0 + ai * HALF + m * 16) * D + col0 + bj * HALF);
#pragma unroll
            for (int m = 0; m < 4; ++m) {
                const int row = row0 + ai * HALF + m * 16; float s = 0.f;
#pragma unroll
                for (int bj = 0; bj < 2; ++bj) {
                    const u32x4 pv = pre[m][bj];
                    const f32x4 h0 = {bflo(pv[0]), bfhi(pv[0]), bflo(pv[1]), bfhi(pv[1])}, h1 = {bflo(pv[2]), bfhi(pv[2]), bflo(pv[3]), bfhi(pv[3])};
                    const f32x4 o0 = h0 + acc[ai][bj][m][0] * alpha, o1 = h1 + acc[ai][bj][m][1] * alpha;
                    u32x4 w; w[0] = pk(o0[0], o0[1]); w[1] = pk(o0[2], o0[3]); w[2] = pk(o1[0], o1[1]); w[3] = pk(o1[2], o1[3]);
                    *(u32x4*)(HB + (size_t)row * D + col0 + bj * HALF) = w;
                    s += (o0[0] * o0[0] + o0[1] * o0[1]) + (o0[2] * o0[2] + o0[3] * o0[3]) + (o1[0] * o1[0] + o1[1] * o1[1]) + (o1[2] * o1[2] + o1[3] * o1[3]);
                }
                s += __shfl_xor(s, 16); s += __shfl_xor(s, 32);
                if (fq == 0) ssq[(size_t)row * 16 + u.pn * 4 + wc] = s;
            }
        }
    }
};
struct EpiRetIn {
    static constexpr bool PERM = true, AFTER_DRAIN = false;
    bf16_t *Q, *K, *V, *G; const LAS _Float16* rl; const float* rope;
    __device__ __forceinline__ void operator()(const f32x4 (&acc)[2][2][4][2], const Unit& u, int wr, int wc, int fr, int fq, int ui) const {
        const int row0 = u.pm * BM + wr * 64 + fr, d0 = wc * 32 + 8 * fq;
        const int pn = u.pn;
        const LAS _Float16* rlu = rl + ui * 256 + wr * 64 + fr;
#pragma unroll
        for (int ai = 0; ai < 2; ++ai)
#pragma unroll
            for (int m = 0; m < 4; ++m) {
                if (pn < 8 && (m & 1) == 0) asm volatile("" ::: "memory");
                const int row = row0 + ai * HALF + m * 16; const float rs = (float)rlu[ai * HALF + m * 16];
                if (pn < 8) {
                    const int pos = row < TP ? (row & (SEQ - 1)) : PAST + ((row - TP) & (DSEQ - 1));
                    const float* cs = rope + (size_t)pos * 256 + d0;
                    const float sc = pn < 4 ? rs * 0.0625f : rs;
                    bf16_t* dst = (pn < 4 ? Q : K) + (size_t)row * D + (pn & 3) * 256 + d0;
                    u32x4 w1, w2;
#pragma unroll
                    for (int n = 0; n < 2; ++n) {
                        const f32x4 c = *(const f32x4*)(cs + 4 * n), s = *(const f32x4*)(cs + 128 + 4 * n);
                        const f32x4 x1 = acc[ai][0][m][n] * sc, x2 = acc[ai][1][m][n] * sc;
                        const f32x4 y1 = x1 * c - x2 * s, y2 = x1 * s + x2 * c;
                        w1[2 * n] = pk(y1[0], y1[1]); w1[2 * n + 1] = pk(y1[2], y1[3]);
                        w2[2 * n] = pk(y2[0], y2[1]); w2[2 * n + 1] = pk(y2[2], y2[3]);
                    }
                    *(u32x4*)dst = w1; *(u32x4*)(dst + 128) = w2;
                } else {
                    const bool isg = pn >= 16;
                    bf16_t* dst = (isg ? G : V) + (size_t)row * 2048 + ((pn - 8) & 7) * 256 + d0;
#pragma unroll
                    for (int bj = 0; bj < 2; ++bj) {
                        f32x4 a = acc[ai][bj][m][0] * rs, b = acc[ai][bj][m][1] * rs;
                        if (isg) { a = (f32x4){silu_f(a[0]), silu_f(a[1]), silu_f(a[2]), silu_f(a[3])}; b = (f32x4){silu_f(b[0]), silu_f(b[1]), silu_f(b[2]), silu_f(b[3])}; }
                        u32x4 w; w[0] = pk(a[0], a[1]); w[1] = pk(a[2], a[3]); w[2] = pk(b[0], b[1]); w[3] = pk(b[2], b[3]);
                        *(u32x4*)(dst + bj * HALF) = w;
                    }
                }
            }
    }
};
struct EpiKVF {
    static constexpr bool PERM = true, AFTER_DRAIN = false;
    float* out; bf16_t *K2B, *V2B; const LAS _Float16* rl; const float* bf;
    __device__ __forceinline__ void operator()(const f32x4 (&acc)[2][2][4][2], const Unit& u, int wr, int wc, int fr, int fq, int ui) const {
        const int row0 = u.pm * BM + wr * 64 + fr, d0 = wc * 32 + 8 * fq;
        const int pn = u.pn; const bool samp = u.pm >= TP / BM;
        const LAS _Float16* rlu = rl + ui * 256 + wr * 64 + fr;
        if (pn < 8) {
            const bool isv = pn >= 4;
            float* fbase = out + (samp ? (isv ? O_VS : O_KS) - (size_t)TP * D : (isv ? O_VP : O_KP)) + (pn & 3) * 256 + d0;
            bf16_t* bbase = (isv ? V2B : K2B) + (pn & 3) * 256 + d0;
#pragma unroll
            for (int ai = 0; ai < 2; ++ai)
#pragma unroll
                for (int m = 0; m < 4; ++m) {
                    const int row = row0 + ai * HALF + m * 16; const float rs = (float)rlu[ai * HALF + m * 16];
                    const int brow = row + (samp ? (((row - TP) >> 6) + 1) * 1024 : 0);
                    float* fo = fbase + (size_t)row * D; bf16_t* bo = bbase + (size_t)brow * D;
#pragma unroll
                    for (int bj = 0; bj < 2; ++bj) {
                        const f32x4 a = acc[ai][bj][m][0] * rs, b = acc[ai][bj][m][1] * rs;
                        __builtin_nontemporal_store(a, (f32x4*)(fo + bj * HALF)); __builtin_nontemporal_store(b, (f32x4*)(fo + bj * HALF + 4));
                        u32x4 w; w[0] = pk(a[0], a[1]); w[1] = pk(a[2], a[3]); w[2] = pk(b[0], b[1]); w[3] = pk(b[2], b[3]);
                        *(u32x4*)(bo + bj * HALF) = w;
                    }
                }
        } else if (wc == 0 && fq < 2) {
            float* lbase = out + (samp ? O_LFS - (size_t)TP * 16 : O_LFP) + 8 * fq;
            const f32x4 bb0 = *(const f32x4*)(bf + 8 * fq), bb1 = *(const f32x4*)(bf + 8 * fq + 4);
#pragma unroll
            for (int ai = 0; ai < 2; ++ai)
#pragma unroll
                for (int m = 0; m < 4; ++m) {
                    const int row = row0 + ai * HALF + m * 16; const float rs = (float)rlu[ai * HALF + m * 16];
                    float* lo = lbase + (size_t)row * 16;
#pragma unroll
                    for (int n = 0; n < 2; ++n) {
                        const f32x4 x = acc[ai][0][m][n] * rs + (n ? bb1 : bb0); f32x4 y;
#pragma unroll
                        for (int j = 0; j < 4; ++j) y[j] = fminf(x[j], 0.f) - __logf(1.0f + __expf(-fabsf(x[j])));
                        *(f32x4*)(lo + 4 * n) = y;
                    }
                }
        }
    }
};
struct EpiSwiKVF {
    static constexpr bool PERM = true, AFTER_DRAIN = false;
    EpiSwiGLU swi; EpiKVF kvf;
    __device__ __forceinline__ void operator()(const f32x4 (&acc)[2][2][4][2], const Unit& u, int wr, int wc, int fr, int fq, int ui) const {
        if (u.pn < 22) swi(acc, u, wr, wc, fr, fq, ui);
        else { Unit u2; u2.pm = u.pm; u2.pn = u.pn - 22; kvf(acc, u2, wr, wc, fr, fq, ui); }
    }
};
struct EpiQ {
    static constexpr bool PERM = true, AFTER_DRAIN = false;
    bf16_t* O; const LAS _Float16* rl;
    __device__ __forceinline__ void operator()(const f32x4 (&acc)[2][2][4][2], const Unit& u, int wr, int wc, int fr, int fq, int ui) const {
        const int row0 = u.pm * BM + wr * 64 + fr, col0 = u.pn * BM + wc * 32 + 8 * fq;
        const LAS _Float16* rlu = rl + ui * 256 + wr * 64 + fr;
#pragma unroll
        for (int ai = 0; ai < 2; ++ai)
#pragma unroll
            for (int m = 0; m < 4; ++m) {
                const int row = row0 + ai * HALF + m * 16; const float rs = (float)rlu[ai * HALF + m * 16] * (0.125f * LOG2E);
#pragma unroll
                for (int bj = 0; bj < 2; ++bj) {
                    const f32x4 a = acc[ai][bj][m][0] * rs, b = acc[ai][bj][m][1] * rs;
                    u32x4 w; w[0] = pk(a[0], a[1]); w[1] = pk(a[2], a[3]); w[2] = pk(b[0], b[1]); w[3] = pk(b[2], b[3]);
                    *(u32x4*)(O + (size_t)row * D + col0 + bj * HALF) = w;
                }
            }
    }
};
}

DI void tr_item(const float* W, int K, int N, bf16* WT, int drow0, const float* g, LAS float* scr, int k0, int n0, int lane) {
    const int n = n0 + 4 * (lane & 7);
    f32x4 v[8];
#pragma unroll
    for (int i = 0; i < 8; ++i) { const int kk = 8 * i + (lane >> 3); v[i] = (n < N) ? __builtin_nontemporal_load((const f32x4*)(W + (size_t)(k0 + kk) * N + n)) : (f32x4){0.f, 0.f, 0.f, 0.f}; }
#pragma unroll
    for (int i = 0; i < 8; ++i) { const int kk = 8 * i + (lane >> 3); const float gs = g ? g[k0 + kk] : 1.0f; LAS float* d = scr + kk * 33 + 4 * (lane & 7);
        d[0] = v[i][0] * gs; d[1] = v[i][1] * gs; d[2] = v[i][2] * gs; d[3] = v[i][3] * gs; }
    asm volatile("s_waitcnt lgkmcnt(0)" ::: "memory");
    const int c = lane & 7;
#pragma unroll
    for (int j = 0; j < 4; ++j) { const int nn = (lane >> 3) + 8 * j; const LAS float* s = scr + (8 * c) * 33 + nn;
        u32x4 o; o[0] = pk(s[0 * 33], s[1 * 33]); o[1] = pk(s[2 * 33], s[3 * 33]); o[2] = pk(s[4 * 33], s[5 * 33]); o[3] = pk(s[6 * 33], s[7 * 33]);
        *(u32x4*)(WT + (size_t)(drow0 + nn) * K + k0 + 8 * c) = o; }
    asm volatile("s_waitcnt lgkmcnt(0)" ::: "memory");
}
DI bool tr_matrix(int& r, const float* W, int K, int N, int nblk, bf16* WT, const float* g, int mode, LAS float* scr, int lane) {
    const int items = (K / 64) * nblk;
    if (r >= items) { r -= items; return false; }
    const int kb = r / nblk, nb = r % nblk, n0 = 32 * nb;
    int drow0 = n0;
    if (mode == 1) { const int bj = n0 / FF, rem = n0 % FF; drow0 = 256 * (rem / 128) + 128 * bj + (rem % 128); }
    tr_item(W, K, N, WT, drow0, g, scr, 64 * kb, n0, lane);
    return true;
}
DI void sincos_d(double x, float& s, float& c) {
    const double n = __builtin_rint(x * 0.63661977236758134308);
    double r = __builtin_fma(-n, 1.57079632679489655800e+00, x); r = __builtin_fma(-n, 6.12323399573676603587e-17, r);
    const double r2 = r * r;
    double sp = -1.0 / 1307674368000.0; sp = sp * r2 + 1.0 / 6227020800.0; sp = sp * r2 - 1.0 / 39916800.0; sp = sp * r2 + 1.0 / 362880.0; sp = sp * r2 - 1.0 / 5040.0; sp = sp * r2 + 1.0 / 120.0; sp = sp * r2 - 1.0 / 6.0; sp = sp * r2 * r + r;
    double cp = 1.0 / 20922789888000.0; cp = cp * r2 - 1.0 / 87178291200.0; cp = cp * r2 + 1.0 / 479001600.0; cp = cp * r2 - 1.0 / 3628800.0; cp = cp * r2 + 1.0 / 40320.0; cp = cp * r2 - 1.0 / 720.0; cp = cp * r2 + 1.0 / 24.0; cp = cp * r2 - 0.5; cp = cp * r2 + 1.0;
    const int q = ((int)n) & 3;
    const double ss = (q == 0) ? sp : (q == 1) ? cp : (q == 2) ? -sp : -cp;
    const double cc = (q == 0) ? cp : (q == 1) ? -sp : (q == 2) ? -cp : sp;
    s = (float)ss; c = (float)cc;
}

DI void cache_convert(const float* src0, bf16* dst, int gt, int NGT) {
    constexpr int NPIECE = NB_S * PAST * D / 8;
    for (int p0 = gt; p0 < NPIECE; p0 += 4 * NGT) {
        f32x4 a[4], bq[4];
#pragma unroll
        for (int u = 0; u < 4; ++u) { const int q = p0 + u * NGT < NPIECE ? p0 + u * NGT : p0;
            const float* src = src0 + (size_t)(q >> 7) * D + (q & 127) * 8; a[u] = __builtin_nontemporal_load((const f32x4*)src); bq[u] = __builtin_nontemporal_load((const f32x4*)(src + 4)); }
#pragma unroll
        for (int u = 0; u < 4; ++u) { const int q = p0 + u * NGT; if (q >= NPIECE) break;
            const int row = q >> 7, c8 = q & 127; const int b_ = row >> 10, s = row & 1023;
            u32x4 w; w[0] = pk(a[u][0], a[u][1]); w[1] = pk(a[u][2], a[u][3]); w[2] = pk(bq[u][0], bq[u][1]); w[3] = pk(bq[u][2], bq[u][3]);
            *(u32x4*)(dst + ((size_t)TP + (size_t)b_ * KSAMP + s) * D + c8 * 8) = w; }
    }
}
constexpr int RL_OFF = 131072;
static_assert(RL_OFF + 32 * 512 <= LDS_BYTES - 64, "rstd table (fp16, up to 32 units per block)");
DI void rstd_prepass(LAS uchar* lds, const float* ssq, const pg8::StaticOrder& S, int tid) {
    LAS _Float16* rl = (LAS _Float16*)(lds + RL_OFF);
    pg8::Unit u; int nun = 0;
    while (nun < 32 && S.next(nun, u)) ++nun;
#pragma unroll 4
    for (int e = tid; e < nun * 256; e += NTHR) { S.next(e >> 8, u); rl[e] = (_Float16)row_rstd(ssq, u.pm * 256 + (e & 255)); }
    __syncthreads();
}
#define KSEL(k) (ONLY < 0 || ONLY == (k))
struct Params { const float* in[22]; float* out; unsigned char* ws; int ph_lo, ph_hi; unsigned char prog[32]; };

DI void phase_prologue(const Params& P, uchar* ws, float* out, LAS uchar* lds, int gw, int NGW, int wave, int lane) {
    LAS float* scr = (LAS float*)(lds + wave * 16384);
    constexpr int I_IN = 16 * 176, I_OUT = 44 * 32;
    constexpr int NITEMS = 4 * I_IN + 4 * I_OUT + 16 * 192 + 32 * 32 + 16 * 72 + 2 * 16 * 32;
    for (int it = gw; it < NITEMS; it += NGW) {
        int r = it; bool done = false;
#pragma unroll
        for (int f = 0; f < 4; ++f) {
            if (done) break;
            const int l = f >> 1; const bool second = f & 1;
            done = tr_matrix(r, P.in[second ? 11 : 7] + (size_t)l * 1024 * 5632, 1024, 5632, 176, (bf16*)(ws + WS_WIN + win_slot(f) * SZ_WIN), P.in[second ? 10 : 6] + l * 1024, 1, scr, lane);
        }
#pragma unroll
        for (int f = 0; f < 4; ++f) {
            if (done) break;
            const int l = f >> 1; const bool second = f & 1;
            done = tr_matrix(r, P.in[second ? 12 : 8] + (size_t)l * 2816 * 1024, 2816, 1024, 32, (bf16*)(ws + WS_WOUT + f * SZ_WOUT), nullptr, 0, scr, lane);
        }
        if (!done) done = tr_matrix(r, P.in[13], 1024, 6144, 192, (bf16*)(ws + WS_RIN), P.in[9], 0, scr, lane);
        if (!done) done = tr_matrix(r, P.in[15], 2048, 1024, 32, (bf16*)(ws + WS_ROUT), P.in[14], 0, scr, lane);
        if (!done) done = tr_matrix(r, P.in[17], 1024, 2064, 72, (bf16*)(ws + WS_KVF), P.in[16], 0, scr, lane);
        if (!done) done = tr_matrix(r, P.in[19], 1024, 1024, 32, (bf16*)(ws + WS_WQ), P.in[9] + 1024, 0, scr, lane);
        if (!done) done = tr_matrix(r, P.in[20], 1024, 1024, 32, (bf16*)(ws + WS_WO), nullptr, 0, scr, lane);
    }
    {
        bf16* HB = (bf16*)(ws + WS_HB); float* ssq = (float*)(ws + WS_SSQ);
        constexpr int NR = 4;
        for (int m0 = gw; m0 < T; m0 += NR * NGW) {
            f32x4 v[NR][4];
#pragma unroll
            for (int u = 0; u < NR; ++u) { const int m = m0 + u * NGW < T ? m0 + u * NGW : m0;
                const float* src = m < TP ? P.in[0] + (size_t)m * D : P.in[1] + (size_t)(m - TP) * D;
#pragma unroll
                for (int j = 0; j < 4; ++j) v[u][j] = __builtin_nontemporal_load((const f32x4*)src + lane + 64 * j); }
#pragma unroll
            for (int u = 0; u < NR; ++u) {
                const int m = m0 + u * NGW; if (m >= T) break;
                float s = 0.f;
#pragma unroll
                for (int j = 0; j < 4; ++j) s += (v[u][j][0] * v[u][j][0] + v[u][j][1] * v[u][j][1]) + (v[u][j][2] * v[u][j][2] + v[u][j][3] * v[u][j][3]);
                s = wave_sum(s);
#pragma unroll
                for (int j = 0; j < 4; ++j) { u32x2 w; w[0] = pk(v[u][j][0], v[u][j][1]); w[1] = pk(v[u][j][2], v[u][j][3]); ((u32x2*)(HB + (size_t)m * D))[lane + 64 * j] = w; }
                if (lane < 16) ssq[(size_t)m * 16 + lane] = lane == 0 ? s : 0.f;
            }
        }
    }
}

DI void rope_table(uchar* ws, int gw, int NGW, int lane) {
    {
        const int gt = gw * 64 + lane, NGT = NGW * 64; float* rope = (float*)(ws + WS_ROPE);
        for (int e = gt; e < 4096 * 128; e += NGT) { const int pos = e >> 7, j = e & 127; float s, c; sincos_d((double)pos * INVF[j], s, c); rope[(size_t)pos * 256 + j] = c; rope[(size_t)pos * 256 + 128 + j] = s; }
    }
}

DI f32x16 mfma32(bf16x8 a, bf16x8 b, f32x16 c) { return __builtin_amdgcn_mfma_f32_32x32x16_bf16(a, b, c, 0, 0, 0); }
DI int crow(int i, int hh) { return (i & 3) + 8 * (i >> 2) + 4 * hh; }
DI s16x4 vtr(const LAS uchar* p) { return __builtin_bit_cast(s16x4, __builtin_amdgcn_ds_read_tr16_b64_v4i16((LAS v4i16_t*)p)); }
DI bf16x8 cat8(s16x4 lo, s16x4 hi) { return __builtin_shufflevector(lo, hi, 0, 1, 2, 3, 4, 5, 6, 7); }
DI bf16x8 ldsv(const LAS uchar* p) { return *(const LAS bf16x8*)p; }
template <int S> DI bf16x8 pack8(const f32x16& x) { u32x4 p; p[0] = pk(x[8 * S], x[8 * S + 1]); p[1] = pk(x[8 * S + 2], x[8 * S + 3]); p[2] = pk(x[8 * S + 4], x[8 * S + 5]); p[3] = pk(x[8 * S + 6], x[8 * S + 7]); return __builtin_bit_cast(bf16x8, p); }
DI s16x4 scale4(s16x4 v, float f0, float f1, float f2, float f3) {
    const u32x2 w = __builtin_bit_cast(u32x2, v); u32x2 o;
    o[0] = pk(bflo(w[0]) * f0, bfhi(w[0]) * f1); o[1] = pk(bflo(w[1]) * f2, bfhi(w[1]) * f3);
    return __builtin_bit_cast(s16x4, o);
}
namespace ret {
constexpr int QP = 528, KP = 528, VP = 320, SP = 528;
constexpr int OFF_Q = 0, OFF_K = 64 * QP, OFF_V = OFF_K + 64 * KP, OFF_ST = OFF_V + 64 * VP, END = OFF_ST + 128 * SP;
static_assert(END <= LDS_BYTES, "retention LDS");
}
DI void ret_item(LAS uchar* lds, const bf16* Qg, const bf16* Kg, bf16* Vg, size_t rowbase, int h, int sl, int nch, const float* S0, float* Sout, float lg2) {
    using namespace ret;
    int tid_ = threadIdx.x; asm volatile("" : "+v"(tid_));
    const int tid = tid_, lane = tid & 63, w = __builtin_amdgcn_readfirstlane(tid >> 6), r = lane & 31, hh = lane >> 5;
    const int ci = w >> 2, ei = w & 3, dq = w >> 1, eh = w & 1;
    const int q4 = (lane & 15) >> 2, p4 = lane & 3, blk = (lane >> 4) & 1;
    f32x16 S[2][2];
    if (S0) {
#pragma unroll
        for (int ti = 0; ti < 2; ++ti)
#pragma unroll
            for (int tj = 0; tj < 2; ++tj)
#pragma unroll
                for (int i = 0; i < 16; ++i) S[ti][tj][i] = S0[(size_t)(64 * dq + 32 * ti + crow(i, hh)) * 512 + 128 * sl + 64 * eh + 32 * tj + r];
    } else {
#pragma unroll
        for (int ti = 0; ti < 2; ++ti)
#pragma unroll
            for (int tj = 0; tj < 2; ++tj)
#pragma unroll
                for (int i = 0; i < 16; ++i) S[ti][tj][i] = 0.f;
    }
    const float g64 = ex2(lg2 * 64.f);
    const bf16* qsrc = Qg + (rowbase + (tid >> 5)) * D + h * 256 + (tid & 31) * 8;
    const bf16* ksrc = Kg + (rowbase + (tid >> 5)) * D + h * 256 + (tid & 31) * 8;
    bf16* vsrc = Vg + (rowbase + (tid >> 4)) * 2048 + h * 512 + sl * 128 + (tid & 15) * 8;
    const int qdst = (tid >> 5) * QP + (tid & 31) * 16, vdst = (tid >> 4) * VP + (tid & 15) * 16;
    const float lg2_inv = lg2;
#pragma unroll 1
    for (int n = 0; n < nch; ++n) {
        float lg2 = lg2_inv; asm volatile("" : "+v"(lg2));
        u32x4 rq[4], rk[4], rv[2];
        {
            const size_t adv = (size_t)64 * n;
#pragma unroll
            for (int i = 0; i < 4; ++i) { rq[i] = *(const u32x4*)(qsrc + (adv + 16 * i) * D); rk[i] = *(const u32x4*)(ksrc + (adv + 16 * i) * D); }
#pragma unroll
            for (int i = 0; i < 2; ++i) rv[i] = *(const u32x4*)(vsrc + (adv + 32 * i) * 2048);
        }
        __syncthreads();
#pragma unroll
        for (int i = 0; i < 4; ++i) { *(LAS u32x4*)(lds + OFF_Q + qdst + 16 * i * QP) = rq[i]; *(LAS u32x4*)(lds + OFF_K + qdst + 16 * i * KP) = rk[i]; }
        asm volatile("" ::: "memory");
#pragma unroll
        for (int i = 0; i < 2; ++i) {
            const float f = ex2(lg2 * (float)(63 - 32 * i - (tid >> 4))); u32x4 w;
#pragma unroll
            for (int j = 0; j < 4; ++j) w[j] = pk(bflo(rv[i][j]) * f, bfhi(rv[i][j]) * f);
            *(LAS u32x4*)(lds + OFF_V + vdst + 32 * i * VP) = w;
        }
        asm volatile("" ::: "memory");
#pragma unroll
        for (int ti = 0; ti < 2; ++ti)
#pragma unroll
            for (int tj = 0; tj < 2; ++tj)
#pragma unroll
                for (int g = 0; g < 4; ++g) { u32x2 v; v[0] = pk(S[ti][tj][4 * g], S[ti][tj][4 * g + 1]); v[1] = pk(S[ti][tj][4 * g + 2], S[ti][tj][4 * g + 3]);
                    *(LAS u32x2*)(lds + OFF_ST + (64 * eh + 32 * tj + r) * SP + (64 * dq + 32 * ti + 8 * g + 4 * hh) * 2) = v; }
        __syncthreads();
        f32x16 sc0, sc1;
#pragma unroll
        for (int i = 0; i < 16; ++i) { sc0[i] = 0.f; sc1[i] = 0.f; }
        const LAS uchar* qrow = lds + OFF_Q + (32 * ci + r) * QP + hh * 16;
        {
            const LAS uchar* krow = lds + OFF_K + r * KP + hh * 16;
#pragma unroll
            for (int kk = 0; kk < 16; ++kk) { const bf16x8 qf = ldsv(qrow + kk * 32); sc0 = mfma32(ldsv(krow + kk * 32), qf, sc0); sc1 = mfma32(ldsv(krow + 32 * KP + kk * 32), qf, sc1);
                if ((kk & 3) == 3) asm volatile("" ::: "memory"); }
        }
        {
            const float a0 = (float)(32 * ci + r - 4 * hh), a1 = a0 - 32.f;
#pragma unroll
            for (int i = 0; i < 16; ++i) { const float cc = (float)((i & 3) + 8 * (i >> 2)); const float sm = cc + (float)(4 * hh - 63);
                sc0[i] *= ex2(lg2 * (fabsf(a0 - cc) + sm)); sc1[i] *= ex2(lg2 * (fabsf(a1 - cc) + sm + 32.f)); }
        }
        f32x16 o;
#pragma unroll
        for (int i = 0; i < 16; ++i) o[i] = 0.f;
        {
            const LAS uchar* vb = lds + OFF_V + (4 * hh + q4) * VP + (32 * ei + 16 * blk + 4 * p4) * 2;
            o = mfma32(pack8<0>(sc0), cat8(vtr(vb), vtr(vb + 8 * VP)), o);
            o = mfma32(pack8<1>(sc0), cat8(vtr(vb + 16 * VP), vtr(vb + 24 * VP)), o);
            o = mfma32(pack8<0>(sc1), cat8(vtr(vb + 32 * VP), vtr(vb + 40 * VP)), o);
            o = mfma32(pack8<1>(sc1), cat8(vtr(vb + 48 * VP), vtr(vb + 56 * VP)), o);
        }
        f32x16 o2;
#pragma unroll
        for (int i = 0; i < 16; ++i) o2[i] = 0.f;
        {
            const LAS uchar* strow = lds + OFF_ST + (32 * ei + r) * SP + hh * 16;
#pragma unroll
            for (int kk = 0; kk < 16; ++kk) { o2 = mfma32(ldsv(qrow + kk * 32), ldsv(strow + kk * 32), o2); if ((kk & 3) == 3) asm volatile("" ::: "memory"); }
        }
        {
            bf16* op = Vg + (rowbase + (size_t)64 * n + 32 * ci) * 2048 + h * 512 + sl * 128 + 32 * ei + r;
#pragma unroll
            for (int i = 0; i < 16; ++i) { const int c = crow(i, hh); const float val = o[i] + o2[i] * ex2(lg2 * (float)(32 * ci + c + 1));
                op[(size_t)c * 2048] = (bf16)(pk(val, 0.f) & 0xffffu); }
        }
        asm volatile("" ::: "memory");
#pragma unroll
        for (int ti = 0; ti < 2; ++ti)
#pragma unroll
            for (int tj = 0; tj < 2; ++tj) S[ti][tj] = S[ti][tj] * g64;
        {
            const LAS uchar* ka = lds + OFF_K + (8 * hh + q4) * KP + (64 * dq + 16 * blk + 4 * p4) * 2;
            const LAS uchar* va = lds + OFF_V + (8 * hh + q4) * VP + (64 * eh + 16 * blk + 4 * p4) * 2;
#pragma unroll
            for (int kk = 0; kk < 4; ++kk) {
                bf16x8 A[2], B[2];
#pragma unroll
                for (int ti = 0; ti < 2; ++ti) A[ti] = cat8(vtr(ka + kk * 16 * KP + ti * 64), vtr(ka + kk * 16 * KP + 4 * KP + ti * 64));
#pragma unroll
                for (int tj = 0; tj < 2; ++tj) B[tj] = cat8(vtr(va + kk * 16 * VP + tj * 64), vtr(va + kk * 16 * VP + 4 * VP + tj * 64));
#pragma unroll
                for (int ti = 0; ti < 2; ++ti)
#pragma unroll
                    for (int tj = 0; tj < 2; ++tj) S[ti][tj] = mfma32(A[ti], B[tj], S[ti][tj]);
                asm volatile("" ::: "memory");
            }
        }
    }
#pragma unroll
    for (int ti = 0; ti < 2; ++ti)
#pragma unroll
        for (int tj = 0; tj < 2; ++tj)
#pragma unroll
            for (int i = 0; i < 16; ++i) __builtin_nontemporal_store(S[ti][tj][i], Sout + (size_t)(64 * dq + 32 * ti + crow(i, hh)) * 512 + 128 * sl + 64 * eh + 32 * tj + r);
    __syncthreads();
}

namespace fox {
constexpr int KPI = 144, VPI = 192, KB = 64 * KPI, VB = 64 * VPI;
constexpr int OFF_K = 0, OFF_V = 3 * KB, OFF_BIAS = OFF_V + 3 * VB, OFF_SCR = OFF_BIAS + 4096 * 4, END = OFF_SCR + 8 * 256;
static_assert(END <= LDS_BYTES, "attention LDS");
}
DI float max3f(float a, float b, float c) { float r; asm("v_max3_f32 %0, %1, %2, %3" : "=v"(r) : "v"(a), "v"(b), "v"(c)); return r; }
DI float fadd_s(float a, float b) { float r; asm("v_add_f32_e32 %0, %1, %2" : "=v"(r) : "v"(a), "v"(b)); return r; }
DI float fsub_s(float a, float b) { float r; asm("v_sub_f32_e32 %0, %1, %2" : "=v"(r) : "v"(a), "v"(b)); return r; }
#define SBAR() __builtin_amdgcn_sched_barrier(0)
DI void fox_init(f32x16& n0, f32x16& n1, const LAS f32x4* bp, float m) {
#pragma unroll
    for (int g = 0; g < 4; ++g) { const f32x4 b0 = bp[2 * g], b1 = bp[2 * g + 8];
#pragma unroll
        for (int j = 0; j < 4; ++j) { n0[4 * g + j] = b0[j] - m; n1[4 * g + j] = b1[j] - m; }
        SBAR(); }
}
DI void fox_qk_plain(f32x16& n0, f32x16& n1, const LAS uchar* kb, const bf16x8 (&qf)[4]) {
#pragma unroll
    for (int kk = 0; kk < 4; ++kk) { n0 = mfma32(ldsv(kb + kk * 32), qf[kk], n0); n1 = mfma32(ldsv(kb + 32 * fox::KPI + kk * 32), qf[kk], n1); }
}
DI void fox_hot(f32x16& c0, f32x16& c1, f32x16& n0, f32x16& n1, f32x16& o0, f32x16& o1, float& l, float m,
                const LAS uchar* kb, const LAS uchar* vb, const LAS f32x4* bpn, const bf16x8 (&qf)[4], bf16x8 x0, bf16x8 x1, bf16x8 x2) {
    using namespace fox;
#define FOX_KF(i) ldsv(kb + ((i) & 1) * 32 * KPI + ((i) >> 1) * 32)
#define FOX_VFR(i) cat8(vtr(vb + (16 * ((i) >> 1)) * VPI + ((i) & 1) * 64), vtr(vb + (16 * ((i) >> 1) + 8) * VPI + ((i) & 1) * 64))
#define FOX_EX4(P, B) do { P[B] = ex2(P[B]); P[B + 1] = ex2(P[B + 1]); P[B + 2] = ex2(P[B + 2]); P[B + 3] = ex2(P[B + 3]); } while (0)
#define FOX_SUM4(P, B) do { sacc = fadd_s(sacc, P[B]); sacc = fadd_s(sacc, P[B + 1]); sacc = fadd_s(sacc, P[B + 2]); sacc = fadd_s(sacc, P[B + 3]); } while (0)
    fox_init(n0, n1, bpn, m);
    n0 = mfma32(x0, qf[0], n0); FOX_EX4(c0, 0);  x0 = FOX_KF(3); SBAR();
    n1 = mfma32(x1, qf[0], n1); FOX_EX4(c0, 4);  x1 = FOX_KF(4); SBAR();
    n0 = mfma32(x2, qf[1], n0); FOX_EX4(c0, 8);  x2 = FOX_KF(5); SBAR();
    n1 = mfma32(x0, qf[1], n1); FOX_EX4(c0, 12); x0 = FOX_KF(6); SBAR();
    n0 = mfma32(x1, qf[2], n0); FOX_EX4(c1, 0);  x1 = FOX_KF(7); SBAR();
    n1 = mfma32(x2, qf[2], n1); FOX_EX4(c1, 4);  x2 = FOX_VFR(0); SBAR();
    n0 = mfma32(x0, qf[3], n0); FOX_EX4(c1, 8);  x0 = FOX_VFR(1); SBAR();
    n1 = mfma32(x1, qf[3], n1); FOX_EX4(c1, 12); x1 = FOX_VFR(2); SBAR();
    float sacc = fadd_s(c0[0], c0[1]);
    bf16x8 a0 = pack8<0>(c0), a1; SBAR();
#define FOX_MOV4(DST, SRC, B) do { DST[B] = SRC[B]; DST[B + 1] = SRC[B + 1]; DST[B + 2] = SRC[B + 2]; DST[B + 3] = SRC[B + 3]; } while (0)
    o0 = mfma32(a0, x2, o0); sacc = fadd_s(sacc, c0[2]); sacc = fadd_s(sacc, c0[3]); FOX_SUM4(c0, 4); a1 = pack8<1>(c0); x2 = FOX_VFR(3); SBAR();
    o1 = mfma32(a0, x0, o1); FOX_SUM4(c0, 8); FOX_SUM4(c0, 12); x0 = FOX_VFR(4); SBAR();
    o0 = mfma32(a1, x1, o0); a0 = pack8<0>(c1); FOX_MOV4(c0, n0, 0); FOX_MOV4(c0, n0, 4); x1 = FOX_VFR(5); SBAR();
    o1 = mfma32(a1, x2, o1); FOX_SUM4(c1, 0); FOX_SUM4(c1, 4); FOX_MOV4(c0, n0, 8); x2 = FOX_VFR(6); SBAR();
    o0 = mfma32(a0, x0, o0); a1 = pack8<1>(c1); FOX_SUM4(c1, 8); FOX_MOV4(c0, n0, 12); x0 = FOX_VFR(7); SBAR();
    o1 = mfma32(a0, x1, o1); FOX_SUM4(c1, 12); FOX_MOV4(c1, n1, 0); FOX_MOV4(c1, n1, 4); SBAR();
    o0 = mfma32(a1, x2, o0); FOX_MOV4(c1, n1, 8); FOX_MOV4(c1, n1, 12); SBAR();
    o1 = mfma32(a1, x0, o1); SBAR();
#undef FOX_MOV4
    l += sacc;
#undef FOX_KF
#undef FOX_VFR
#undef FOX_EX4
#undef FOX_SUM4
}
struct FoxCtx { int nt, qlim, qlim_min, hh, r; bool active; const LAS uchar *kb0, *vb0; const LAS float* biasl; LAS float* scr; LAS uchar* lds; int kdst, vdst; const bf16 *ksrc, *vsrc; };
DI void fox_ring(const FoxCtx& X, int t, int bwr, u32x4& rk, u32x4& rv) {
    using namespace fox;
    *(LAS u32x4*)(X.lds + X.kdst + bwr * KB) = rk; *(LAS u32x4*)(X.lds + X.vdst + bwr * VB) = rv;
    __syncthreads();
    const int tl = t - 3 > 0 ? t - 3 : 0;
    rk = *(const u32x4*)(X.ksrc + (size_t)64 * tl * D); rv = *(const u32x4*)(X.vsrc + (size_t)64 * tl * D);
}
DI void fox_step(const FoxCtx& X, int s, int bcur, int bnext, int bwr, f32x16& c0, f32x16& c1, f32x16& n0, f32x16& n1, f32x16& o0, f32x16& o1, float& l, float& m,
                 const bf16x8 (&qf)[4], u32x4& rk, u32x4& rv) {
    using namespace fox;
    const int nt = X.nt, t = nt - 1 - s, hh = X.hh;
    {
        const bool vis = 64 * t <= X.qlim_min, visn = 64 * (t - 1) <= X.qlim_min;
        const LAS f32x4* bpn = (const LAS f32x4*)(X.biasl + 64 * (t - 1) + 4 * hh);
        if (vis) {
            const LAS uchar* kbn = X.kb0 + bnext * KB;
            const bf16x8 x0 = ldsv(kbn), x1 = ldsv(kbn + 32 * KPI), x2 = ldsv(kbn + 32);
            if (64 * t + 63 > X.qlim_min) {
#pragma unroll
                for (int i = 0; i < 16; ++i) { const int key = 64 * t + crow(i, hh); if (key > X.qlim) c0[i] = -INFINITY; if (key + 32 > X.qlim) c1[i] = -INFINITY; }
            }
            asm volatile("s_nop 15\n\ts_nop 7" : "+v"(c0), "+v"(c1));
            float mx = max3f(c0[0], c1[0], c0[1]), mx2 = max3f(c1[1], c0[2], c1[2]);
#pragma unroll
            for (int i = 3; i < 15; i += 2) { mx = max3f(mx, c0[i], c1[i]); mx2 = max3f(mx2, c0[i + 1], c1[i + 1]); }
            mx = max3f(mx, c0[15], c1[15]); mx = max3f(mx, mx2, mx2);
            { auto rr = __builtin_amdgcn_permlane32_swap(__float_as_uint(mx), __float_as_uint(mx), false, false); mx = max3f(__uint_as_float(rr[0]), __uint_as_float(rr[1]), __uint_as_float(rr[1])); }
            if (__builtin_expect(__any(mx > 16.f), 0)) {
                const float d = fmaxf(mx, 0.f), f = ex2(-d); m += d; l *= f;
#pragma unroll
                for (int i = 0; i < 16; ++i) { c0[i] -= d; c1[i] -= d; }
                if (hh == 0) X.scr[X.r] = f;
                asm volatile("s_waitcnt lgkmcnt(0)" ::: "memory");
#pragma unroll
                for (int g = 0; g < 4; ++g) { const f32x4 fv = *(const LAS f32x4*)(X.scr + 8 * g + 4 * hh);
#pragma unroll
                    for (int j = 0; j < 4; ++j) { o0[4 * g + j] *= fv[j]; o1[4 * g + j] *= fv[j]; } }
                asm volatile("s_waitcnt lgkmcnt(0)" ::: "memory");
            }
            fox_hot(c0, c1, n0, n1, o0, o1, l, m, kbn, X.vb0 + bcur * VB, bpn, qf, x0, x1, x2);
        } else if (visn) {
            fox_init(n0, n1, bpn, m); fox_qk_plain(n0, n1, X.kb0 + bnext * KB, qf); c0 = n0; c1 = n1;
        }
    }
    fox_ring(X, t, bwr, rk, rv);
}
DI void fox_unit(LAS uchar* lds, const bf16* Qg, const bf16* K2B, const bf16* V2B, bf16* Og, size_t qrow0, int nq, size_t krow0, int nt, int qlim0, int h, const float* biasg) {
    using namespace fox;
    int tid_ = threadIdx.x; asm volatile("" : "+v"(tid_));
    const int tid = tid_, lane = tid & 63, w = __builtin_amdgcn_readfirstlane(tid >> 6), r = lane & 31, hh = lane >> 5;
    const int q4 = (lane & 15) >> 2, p4 = lane & 3, blk = (lane >> 4) & 1;
    FoxCtx X;
    X.nt = nt; X.hh = hh; X.r = r; X.lds = lds;
    X.active = 32 * w < nq;
    __syncthreads();
    const bool bp0 = tid < nt * 16, bp1 = tid + NTHR < nt * 16;
    const f32x4 bias0 = bp0 ? ((const f32x4*)biasg)[tid] : (f32x4){0.f, 0.f, 0.f, 0.f}, bias1 = bp1 ? ((const f32x4*)biasg)[tid + NTHR] : (f32x4){0.f, 0.f, 0.f, 0.f};
    X.ksrc = K2B + (krow0 + (tid >> 3)) * D + h * 64 + (tid & 7) * 8;
    X.vsrc = V2B + (krow0 + (tid >> 3)) * D + h * 64 + (tid & 7) * 8;
    X.kdst = OFF_K + (tid >> 3) * KPI + (tid & 7) * 16; X.vdst = OFF_V + (tid >> 3) * VPI + (tid & 7) * 16;
    u32x4 rk = *(const u32x4*)(X.ksrc + (size_t)64 * (nt - 1) * D), rv = *(const u32x4*)(X.vsrc + (size_t)64 * (nt - 1) * D);
    u32x4 rk1 = rk, rv1 = rv;
    if (nt > 1) { rk1 = *(const u32x4*)(X.ksrc + (size_t)64 * (nt - 2) * D); rv1 = *(const u32x4*)(X.vsrc + (size_t)64 * (nt - 2) * D); }
    bf16x8 qf[4];
    {
        const bf16* qp = Qg + (qrow0 + (X.active ? 32 * w + r : 0)) * D + h * 64 + hh * 8;
#pragma unroll
        for (int kk = 0; kk < 4; ++kk) qf[kk] = *(const bf16x8*)(qp + kk * 16);
    }
    if (bp0) *(LAS f32x4*)(lds + OFF_BIAS + tid * 16) = bias0;
    if (bp1) *(LAS f32x4*)(lds + OFF_BIAS + (tid + NTHR) * 16) = bias1;
    *(LAS u32x4*)(lds + X.kdst) = rk; *(LAS u32x4*)(lds + X.vdst) = rv;
    *(LAS u32x4*)(lds + X.kdst + KB) = rk1; *(LAS u32x4*)(lds + X.vdst + VB) = rv1;
    { const int tl = nt > 2 ? nt - 3 : 0; rk = *(const u32x4*)(X.ksrc + (size_t)64 * tl * D); rv = *(const u32x4*)(X.vsrc + (size_t)64 * tl * D); }
    float l = 0.f; f32x16 o0, o1;
#pragma unroll
    for (int i = 0; i < 16; ++i) { o0[i] = 0.f; o1[i] = 0.f; }
    X.qlim = X.active ? qlim0 + 32 * w + r : 0; X.qlim_min = qlim0 + 32 * w;
    X.scr = (LAS float*)(lds + OFF_SCR + w * 256);
    X.kb0 = lds + OFF_K + r * KPI + hh * 16;
    X.vb0 = lds + OFF_V + (4 * hh + q4) * VPI + (16 * blk + 4 * p4) * 2;
    X.biasl = (const LAS float*)(lds + OFF_BIAS);
    __syncthreads();
    float m = X.biasl[X.qlim];
    f32x16 pa0, pa1, pb0, pb1;
#pragma unroll
    for (int i = 0; i < 16; ++i) { pa0[i] = 0.f; pa1[i] = 0.f; pb0[i] = 0.f; pb1[i] = 0.f; }
    if (X.active && 64 * (nt - 1) <= X.qlim_min) { fox_init(pa0, pa1, (const LAS f32x4*)(X.biasl + 64 * (nt - 1) + 4 * hh), m); fox_qk_plain(pa0, pa1, X.kb0, qf); }
    int b0 = 0, b1 = 1, b2 = 2;
    if (w >= 4) __builtin_amdgcn_s_setprio(1);
    if (X.active) {
#pragma unroll 1
        for (int s = 0; s < nt; ++s) {
            fox_step(X, s, b0, b1, b2, pa0, pa1, pb0, pb1, o0, o1, l, m, qf, rk, rv);
            { const int tb = b0; b0 = b1; b1 = b2; b2 = tb; }
        }
    } else {
#pragma unroll 1
        for (int s = 0; s < nt; ++s) { fox_ring(X, nt - 1 - s, b2, rk, rv); { const int tb = b0; b0 = b1; b1 = b2; b2 = tb; } }
    }
    __builtin_amdgcn_s_setprio(0);
    if (X.active) {
        l += __shfl_xor(l, 32);
        if (hh == 0) X.scr[32 + r] = l;
        asm volatile("s_waitcnt lgkmcnt(0)" ::: "memory");
        bf16* op = Og + (qrow0 + 32 * w) * D + h * 64 + r;
#pragma unroll
        for (int g = 0; g < 4; ++g) { const f32x4 lv = *(const LAS f32x4*)(X.scr + 32 + 8 * g + 4 * hh);
#pragma unroll
            for (int j = 0; j < 4; ++j) { const float inv = 1.0f / lv[j]; const int c = 8 * g + 4 * hh + j;
                op[(size_t)c * D] = (bf16)(pk(o0[4 * g + j] * inv, 0.f) & 0xffffu); op[(size_t)c * D + 32] = (bf16)(pk(o1[4 * g + j] * inv, 0.f) & 0xffffu); } }
    }
}

#define XB_TMO      128
#define XB_XCNT(j)  (256  + 64 * (j))
#define XB_XSUB(j)  (1280 + 64 * (j))
#define XB_XGEN(j)  (2304 + 64 * (j))
#define XB_TOP      3328
#define XB_TOPGEN   3392
#define XCD_BAR_WORDS 3456
#define XB_SPIN_CAP (1u << 18)

__device__ __forceinline__ unsigned xb_ld(unsigned* p)              { return __hip_atomic_load(p, __ATOMIC_RELAXED, __HIP_MEMORY_SCOPE_AGENT); }
__device__ __forceinline__ unsigned xb_add(unsigned* p, unsigned v) { return __hip_atomic_fetch_add(p, v, __ATOMIC_RELAXED, __HIP_MEMORY_SCOPE_AGENT); }
__device__ __forceinline__ unsigned xb_xcc_id() { return (unsigned)__builtin_amdgcn_s_getreg((3 << 11) | 20) & 0xFu; }
#define XB_SPIN(cond, bar) do { unsigned _sp = 0; while (cond) { __builtin_amdgcn_s_sleep(1); \
    if ((++_sp & 255u) == 0u) { if (xb_ld(&(bar)[XB_TMO])) break; if (_sp > XB_SPIN_CAP) { atomicAdd(&(bar)[XB_TMO], 1u); break; } } } } while (0)

struct XcdBarrier {
    unsigned* bar; unsigned x;
    volatile LAS unsigned* st;
};

__device__ __forceinline__ XcdBarrier xcd_barrier_post(unsigned* bar, volatile LAS unsigned* st) {
    XcdBarrier b; b.bar = bar; b.x = xb_xcc_id(); b.st = st;
    if (threadIdx.x == 0) (void)xb_add(&bar[XB_XCNT(b.x)], 1u);
    return b;
}
__device__ __forceinline__ void xcd_barrier_complete(unsigned* bar, unsigned x, unsigned& nloc, unsigned& nx) {
    const unsigned G = gridDim.x * gridDim.y * gridDim.z;
    unsigned sum, cnt, mine, sp = 0u;
    for (;;) {
        sum = 0u; cnt = 0u; mine = 0u;
#pragma unroll
        for (unsigned j = 0; j < 16; ++j) { const unsigned c = xb_ld(&bar[XB_XCNT(j)]); sum += c; cnt += (c > 0u) ? 1u : 0u; mine = (j == x) ? c : mine; }
        if (sum == G) break;
        __builtin_amdgcn_s_sleep(1);
        if ((++sp & 255u) == 0u) { if (xb_ld(&bar[XB_TMO])) break; if (sp > XB_SPIN_CAP) { atomicAdd(&bar[XB_TMO], 1u); break; } }
    }
    nloc = mine > 0u ? mine : 1u; nx = cnt > 0u ? cnt : 1u;
}

__device__ __forceinline__ void xcd_barrier(const XcdBarrier& b) {
    asm volatile("s_waitcnt vmcnt(0)" ::: "memory");
    __syncthreads();
    if (threadIdx.x == 0) {
        unsigned* bar = b.bar;
        __builtin_amdgcn_s_waitcnt(0);
        unsigned nloc = b.st[0], nx = b.st[1];
        if (nloc == 0u) { xcd_barrier_complete(bar, b.x, nloc, nx); b.st[0] = nloc; b.st[1] = nx; }
        const unsigned old = xb_add(&bar[XB_XSUB(b.x)], 1u);
        const unsigned gen = old / nloc;
        if (old + 1u == (gen + 1u) * nloc) {
            __builtin_amdgcn_fence(__ATOMIC_RELEASE, "agent");
            asm volatile("s_waitcnt vmcnt(0)" ::: "memory");
            const unsigned og = xb_add(&bar[XB_TOP], 1u);
            const unsigned tg = og / nx;
            if (og + 1u == (tg + 1u) * nx) xb_add(&bar[XB_TOPGEN], 1u);
            else XB_SPIN(xb_ld(&bar[XB_TOPGEN]) == tg, bar);
            __builtin_amdgcn_fence(__ATOMIC_ACQUIRE, "agent");
            xb_add(&bar[XB_XGEN(b.x)], 1u);
            asm volatile("s_waitcnt vmcnt(0)" ::: "memory");
        } else {
            XB_SPIN(xb_ld(&bar[XB_XGEN(b.x)]) == gen, bar);
            __builtin_amdgcn_fence(__ATOMIC_ACQUIRE, "agent");
            asm volatile("s_waitcnt vmcnt(0)" ::: "memory");
        }
    }
    __syncthreads();
}

constexpr int XB_WS_OFF = 65536, XB_LDS_OFF = LDS_BYTES - 64, CTL_ZERO_BYTES = 262144;

template <int ONLY> __global__ void __launch_bounds__(NTHR, 2) yoco_fwd_t(Params P) {
    extern __shared__ __attribute__((aligned(16))) unsigned char lds_raw[];
    LAS uchar* lds = (LAS uchar*)lds_raw;
    if (threadIdx.x < 16) ((LAS unsigned*)(lds + XB_LDS_OFF))[threadIdx.x] = 0u;
    __syncthreads();
    if (P.ph_hi - P.ph_lo > 1) (void)xcd_barrier_post((unsigned*)(P.ws + XB_WS_OFF), (volatile LAS unsigned*)(lds + XB_LDS_OFF));
    if (P.ph_lo == 0) {
        const int lane0 = threadIdx.x & 63, wave0 = threadIdx.x >> 6;
        rope_table(P.ws, blockIdx.x * NWAVES + wave0, gridDim.x * NWAVES, lane0);
    }
    for (int step = P.ph_lo; step < P.ph_hi; ++step) {
        const int ph = P.prog[step];
        int tid_ = threadIdx.x; asm volatile("" : "+v"(tid_));
        const int tid = tid_;
#define LWG() const int lane = tid & 63, wave = __builtin_amdgcn_readfirstlane(tid >> 6); const int gw = bx * NWAVES + wave, NGW = G * NWAVES; (void)lane; (void)gw; (void)NGW
        int G_ = gridDim.x, bx_ = blockIdx.x; asm volatile("" : "+s"(G_), "+s"(bx_));
        const int G = G_, bx = bx_;
        uchar* ws = P.ws; float* out = P.out; int zz = 0;
        asm volatile("" : "+s"(ws), "+s"(out), "+s"(zz));
#define PIN(i) (P.in[(i) + zz])
        float* H = out + O_Y; bf16* HB = (bf16*)(ws + WS_HB); float* ssq = (float*)(ws + WS_SSQ);
        bf16* HID = (bf16*)(ws + WS_R + R_HID);
        bf16* RQ = (bf16*)(out + O_KP); bf16* RK = RQ + (size_t)T * D;
        bf16* VO = (bf16*)(ws + WS_R + R_VO); bf16* GG = (bf16*)(ws + WS_R + R_G);
        bf16* QF = (bf16*)(ws + WS_R + R_QF); bf16* K2B = (bf16*)(ws + WS_R + R_K2B); bf16* V2B = (bf16*)(ws + WS_R + R_V2B);
        float* biasP = (float*)(ws + WS_BIASP); float* biasS = (float*)(ws + WS_BIASS);
        const float* rope = (const float*)(ws + WS_ROPE);
        int kind, f = 0;
        switch (ph) {
            case 0: kind = 0; break;
            case 1: kind = 1; f = 0; break;   case 2: kind = 2; f = 0; break;
            case 3: kind = 3; break;          case 4: kind = 4; break;        case 5: kind = 5; break;
            case 6: kind = 2; f = 4; break;
            case 7: kind = 1; f = 1; break;   case 8: kind = 2; f = 1; break;
            case 9: kind = 1; f = 2; break;   case 10: kind = 7; break;
            case 11: kind = 1; f = 2; break;  case 12: kind = 2; f = 2; break;
            case 13: kind = 8; break;         case 14: kind = 9; break;
            case 15: kind = 2; f = 5; break;
            case 16: kind = 1; f = 3; break;  case 17: kind = 2; f = 3; break;
            case 20: kind = 11; break;
            case 19: kind = 2; f = 8; break;
            default: kind = 10; break;
        }
        if (KSEL(0) && kind == 0) {
            LWG();
            phase_prologue(P, ws, out, lds, gw, NGW, wave, lane);
        } else if (KSEL(1) && kind == 1) {
            const int N = f == 2 ? 2 * FF + 2304 : 2 * FF;
            pg8::Gemm g{HB, (const bf16*)(ws + WS_WIN + win_slot(f) * SZ_WIN), T, N, D}; pg8::StaticOrder S; S.init(T, N, G, bx);
            rstd_prepass(lds, ssq, S, tid);
            const LAS _Float16* rl = (const LAS _Float16*)(lds + RL_OFF);
            pg8::EpiSwiKVF E{pg8::EpiSwiGLU{HID, rl}, pg8::EpiKVF{out, K2B, V2B, rl, PIN(18)}};
            pg8::gemm_phase<pg8::EpiSwiKVF, pg8::StaticOrder, true, true>(lds, g, S, E);
        } else if (KSEL(2) && kind == 2) {
            const bf16* A; const bf16* Bt; int K; float alpha;
            if (f == 8) { A = HID; Bt = (const bf16*)(ws + WS_WOUT); K = FF; alpha = 0.0f; }
            else if (f < 4) { A = HID; Bt = (const bf16*)(ws + WS_WOUT + f * SZ_WOUT); K = FF; alpha = 0.5f; }
            else if (f == 4) { A = VO; Bt = (const bf16*)(ws + WS_ROUT); K = 2048; alpha = 1.0f; }
            else { A = QF; Bt = (const bf16*)(ws + WS_WO); K = D; alpha = 1.0f; }
            pg8::Gemm g{A, Bt, T, D, K}; pg8::StaticOrder S; S.init(T, D, G, bx);
            pg8::EpiRes E{HB, ssq, alpha};
            pg8::gemm_phase<pg8::EpiRes, pg8::StaticOrder, true, true>(lds, g, S, E);
            if (f == 4 || f == 1) {
                const int nwg = (T / 256) * (D / 256), rounds = (nwg + G - 1) / G, nfull = nwg - (rounds - 1) * G;
                const int nidle = G - nfull;
                const int gt = nidle > 0 ? (bx - nfull) * NTHR + tid : bx * NTHR + tid, NGT = (nidle > 0 ? nidle : G) * NTHR;
                if (nidle == 0 || bx >= nfull) cache_convert(f == 4 ? PIN(3) : PIN(4), f == 4 ? K2B : V2B, gt, NGT);
            }
        } else if (KSEL(3) && kind == 3) {
            pg8::Gemm g{HB, (const bf16*)(ws + WS_RIN), T, 6144, D}; pg8::StaticOrder S; S.init(T, 6144, G, bx);
            rstd_prepass(lds, ssq, S, tid); pg8::EpiRetIn E{RQ, RK, VO, GG, (const LAS _Float16*)(lds + RL_OFF), rope};
            pg8::gemm_phase<pg8::EpiRetIn, pg8::StaticOrder, true, true>(lds, g, S, E);
        } else if (KSEL(4) && kind == 4) {
            for (int it = bx; it < 256 + 512; it += G) {
                const bool samp = it >= 256; const int q = samp ? it - 256 : it;
                const int sl = q & 3, h = (q >> 2) & 3, b = q >> 4;
                const float lg2 = h == 0 ? -0.04580368961312479f : h == 1 ? -0.02272007650008353f : h == 2 ? -0.011315313227834146f : -0.005646563141142063f;
                const size_t rowbase = samp ? (size_t)TP + (size_t)b * DSEQ : (size_t)b * SEQ;
                const float* S0 = samp ? PIN(2) + (size_t)(b * 4 + h) * 256 * 512 : nullptr;
                float* Sout = out + (samp ? O_SRS : O_SRP) + (size_t)(b * 4 + h) * 256 * 512;
                ret_item(lds, RQ, RK, VO, rowbase, h, sl, samp ? 1 : 64, S0, Sout, lg2);
            }
        } else if (KSEL(5) && kind == 5) {
            LWG();
            const float* gn = PIN(14); (void)gn;
            constexpr int NR = 4;
            for (int row0 = gw; row0 < T; row0 += NR * NGW) {
                u32x4 ov[NR][4], gv[NR][4];
#pragma unroll
                for (int u = 0; u < NR; ++u) { const int row = row0 + u * NGW < T ? row0 + u * NGW : row0;
                    const u32x4* op = (const u32x4*)(VO + (size_t)row * 2048 + lane * 32); const u32x4* gp = (const u32x4*)(GG + (size_t)row * 2048 + lane * 32);
#pragma unroll
                    for (int i = 0; i < 4; ++i) { ov[u][i] = op[i]; gv[u][i] = gp[i]; } }
#pragma unroll
                for (int u = 0; u < NR; ++u) {
                    const int row = row0 + u * NGW; if (row >= T) break;
                    float s = 0.f, s2 = 0.f;
#pragma unroll
                    for (int i = 0; i < 4; ++i)
#pragma unroll
                        for (int j = 0; j < 4; ++j) { const float a = bflo(ov[u][i][j]), bq = bfhi(ov[u][i][j]); s += a + bq; s2 += a * a + bq * bq; }
#pragma unroll
                    for (int o = 1; o < 16; o <<= 1) { s += __shfl_xor(s, o); s2 += __shfl_xor(s2, o); }
                    const float mu = s * (1.f / 512.f), var = fmaxf(s2 * (1.f / 512.f) - mu * mu, 0.f), rstd = __builtin_amdgcn_rsqf(var + EPS);
                    u32x4* op = (u32x4*)(VO + (size_t)row * 2048 + lane * 32);
#pragma unroll
                    for (int i = 0; i < 4; ++i) { u32x4 w;
#pragma unroll
                        for (int j = 0; j < 4; ++j) w[j] = pk((bflo(ov[u][i][j]) - mu) * rstd * bflo(gv[u][i][j]), (bfhi(ov[u][i][j]) - mu) * rstd * bfhi(gv[u][i][j]));
                        op[i] = w; }
                }
            }
        } else if (KSEL(7) && kind == 7) {
            LWG();
            for (int seq = bx; seq < 768; seq += G) {
                const bool samp = seq >= 256; const int ss = samp ? seq - 256 : seq; const int b_ = ss >> 4, h = ss & 15;
                const int L = samp ? KSAMP : SEQ, n = samp ? 3 : 8, s0 = tid * n;
                float* dst = samp ? biasS + (size_t)ss * KSAMP : biasP + (size_t)ss * SEQ;
                float v[8]; float sum = 0.f;
#pragma unroll
                for (int i = 0; i < 8; ++i) { const int s = s0 + i; float x = 0.f;
                    if (i < n && s < L) x = samp ? (s < PAST ? PIN(5)[((size_t)b_ * PAST + s) * 16 + h] : out[O_LFS + ((size_t)b_ * DSEQ + (s - PAST)) * 16 + h]) : out[O_LFP + ((size_t)b_ * SEQ + s) * 16 + h];
                    sum += x; v[i] = sum; }
                float inc = sum;
#pragma unroll
                for (int o = 1; o < 64; o <<= 1) { const float t = __shfl_up(inc, o); if (lane >= o) inc += t; }
                LAS float* wt = (LAS float*)lds;
                __syncthreads();
                if (lane == 63) wt[wave] = inc;
                __syncthreads();
                float base = inc - sum;
#pragma unroll
                for (int w2 = 0; w2 < 8; ++w2) if (w2 < wave) base += wt[w2];
#pragma unroll
                for (int i = 0; i < 8; ++i) { const int s = s0 + i; if (i < n && s < L) dst[s] = -(base + v[i]) * LOG2E; }
            }
        } else if (KSEL(8) && kind == 8) {
            pg8::Gemm g{HB, (const bf16*)(ws + WS_WQ), T, D, D}; pg8::StaticOrder S; S.init(T, D, G, bx);
            rstd_prepass(lds, ssq, S, tid); pg8::EpiQ E{QF, (const LAS _Float16*)(lds + RL_OFF)};
            pg8::gemm_phase<pg8::EpiQ, pg8::StaticOrder, true, true>(lds, g, S, E);
        } else if (KSEL(9) && kind == 9) {
            for (int u = bx; u < 4096 + 512; u += G) {
                const bool samp = u >= 4096; const int us = u - 4096;
                int bh = samp ? us : (u & 255), qb = 15 - (u >> 8);
                if (!samp && G == 256) {
                    const int k = u >> 8, xcd = bx & 7, idx = bx >> 3, g = idx >> 2, mem = idx & 3, rr = k >> 2, kk = k & 3;
                    bh = xcd * 32 + rr * 8 + g; qb = kk == 0 ? 15 - mem : kk == 1 ? 11 - mem : kk == 2 ? mem + 4 : mem;
                }
                const int b_ = bh >> 4, h = bh & 15;
                const size_t qrow0 = samp ? (size_t)TP + b_ * DSEQ : (size_t)b_ * SEQ + qb * 256;
                const size_t krow0 = samp ? (size_t)TP + (size_t)b_ * KSAMP : (size_t)b_ * SEQ;
                fox_unit(lds, QF, K2B, V2B, QF, qrow0, samp ? 64 : 256, krow0, samp ? 17 : 4 * (qb + 1), samp ? PAST : qb * 256, h,
                         samp ? biasS + (size_t)us * KSAMP : biasP + (size_t)bh * SEQ);
            }
        } else if (KSEL(10) && kind == 10) {
            LWG();
            const float* fg = PIN(21);
            constexpr int NR = 4;
            for (int row0 = gw; row0 < T; row0 += NR * NGW) {
                u32x2 hv[NR][4]; float rsv[NR];
#pragma unroll
                for (int u = 0; u < NR; ++u) { const int row = row0 + u * NGW < T ? row0 + u * NGW : row0; const u32x2* bp = (const u32x2*)(HB + (size_t)row * D);
#pragma unroll
                    for (int j = 0; j < 4; ++j) hv[u][j] = bp[lane + 64 * j];
                    rsv[u] = row_rstd(ssq, row); }
#pragma unroll
                for (int u = 0; u < NR; ++u) {
                    const int row = row0 + u * NGW; if (row >= T) break;
                    f32x4* hp = (f32x4*)(H + (size_t)row * D); const float rs = rsv[u];
#pragma unroll
                    for (int j = 0; j < 4; ++j) { const u32x2 x = hv[u][j]; const f32x4 v = {bflo(x[0]), bfhi(x[0]), bflo(x[1]), bfhi(x[1])}, gq = ((const f32x4*)fg)[lane + 64 * j]; __builtin_nontemporal_store(v * rs * gq, hp + lane + 64 * j); }
                }
            }
        }
        if (step + 1 < P.ph_hi) { if (P.ph_lo < 0) cg::this_grid().sync(); else { XcdBarrier xb; xb.bar = (unsigned*)(ws + XB_WS_OFF); xb.x = xb_xcc_id(); xb.st = (volatile LAS unsigned*)(lds + XB_LDS_OFF); xcd_barrier(xb); } }
    }
}

#ifdef DIAG
template __global__ void yoco_fwd_t<0>(Params); template __global__ void yoco_fwd_t<1>(Params); template __global__ void yoco_fwd_t<2>(Params); template __global__ void yoco_fwd_t<3>(Params);
template __global__ void yoco_fwd_t<4>(Params); template __global__ void yoco_fwd_t<5>(Params); template __global__ void yoco_fwd_t<6>(Params); template __global__ void yoco_fwd_t<7>(Params);
template __global__ void yoco_fwd_t<8>(Params); template __global__ void yoco_fwd_t<9>(Params); template __global__ void yoco_fwd_t<10>(Params);
#endif
#define yoco_fwd yoco_fwd_t<-1>
#ifndef MK_ONE_LAUNCH
#define MK_ONE_LAUNCH 1
#endif
constexpr int N_PHASES = 19;
extern "C" void kernel_launch(void* const* d_in, const int* in_sizes, int n_in, void* d_out, int out_size, void* d_ws, size_t ws_size, hipStream_t stream) {
    static int grid = 0;
    if (grid == 0) {
        if (n_in != 22 || ws_size < WS_END) { fprintf(stderr, "kernel_launch: unexpected n_in %d / ws %zu\n", n_in, ws_size); grid = -1; return; }
        int dev = 0, cus = 0, per_cu = 0;
        hipGetDevice(&dev); hipDeviceGetAttribute(&cus, hipDeviceAttributeMultiprocessorCount, dev);
        if (hipFuncSetAttribute((const void*)yoco_fwd, hipFuncAttributeMaxDynamicSharedMemorySize, LDS_BYTES) != hipSuccess) { fprintf(stderr, "kernel_launch: hipFuncSetAttribute failed\n"); grid = -1; return; }
        if (hipOccupancyMaxActiveBlocksPerMultiprocessor(&per_cu, (const void*)yoco_fwd, NTHR, LDS_BYTES) != hipSuccess || per_cu < 1) { fprintf(stderr, "kernel_launch: occupancy query says %d\n", per_cu); per_cu = 1; }
        (void)hipGetLastError();
        grid = cus * 1;
    }
    if (grid < 0) return;
    Params p{};
    for (int i = 0; i < 22; ++i) p.in[i] = (const float*)d_in[i];
    p.out = (float*)d_out; p.ws = (unsigned char*)d_ws;
#ifndef MK_PROG
#define MK_PROG 0,1,2,3,4,5,6,7,8,9,10,12,13,14,15,16,17,18
#endif
    const unsigned char prog[] = {MK_PROG}; const int nprog = (int)sizeof(prog);
    for (int i = 0; i < nprog && i < 32; ++i) p.prog[i] = prog[i];
#if MK_ONE_LAUNCH
    if (hipMemsetAsync(d_ws, 0, CTL_ZERO_BYTES, stream) != hipSuccess) { fprintf(stderr, "kernel_launch: hipMemsetAsync failed\n"); return; }
    p.ph_lo = 0; p.ph_hi = nprog;
    void* args[] = {&p};
    hipError_t e = hipLaunchCooperativeKernel((const void*)yoco_fwd, dim3(grid), dim3(NTHR), args, LDS_BYTES, stream);
    if (e != hipSuccess) fprintf(stderr, "cooperative launch failed: %s (grid %d)\n", hipGetErrorString(e), grid);
#else
    for (int ph = 0; ph < nprog; ++ph) { p.ph_lo = ph; p.ph_hi = ph + 1; hipLaunchKernelGGL(yoco_fwd, dim3(grid), dim3(NTHR), LDS_BYTES, stream, p); }
#endif
}
```

```cpp
#include <hip/hip_runtime.h>
#include <cstdio>
#include <cstdint>
namespace pg8 {
#define PG8_LAS __attribute__((address_space(3)))
typedef unsigned short bf16_t;
typedef short bf16x8 __attribute__((ext_vector_type(8)));
typedef float f32x4 __attribute__((ext_vector_type(4)));
typedef unsigned u32x4 __attribute__((ext_vector_type(4)));
constexpr int BM = 256, BK = 64, HALF = 128, HTB = HALF * BK * 2  , STAGE_BYTES = 8 * HTB, NXCD = 8, WGM = 8;

__host__ __device__ __forceinline__ int lds_byte(int r, int c) { const int st = (r >> 4) * 2 + (c >> 5), rr = r & 15, cc = c & 31, ob = rr * 64 + cc * 2; return st * 1024 + (ob ^ (((ob >> 9) & 1) << 5)); }
__host__ __device__ __forceinline__ void stage_rc(int b, int& R, int& C) { const int st = b / 1024, sb = b % 1024, swz = sb ^ (((sb >> 9) & 1) << 5); R = (st >> 1) * 16 + swz / 64; C = (st & 1) * 32 + (swz % 64) / 2; }
__host__ __device__ __forceinline__ int perm32(int rho) { const int n = rho >> 4, i = rho & 15; return 8 * (i >> 2) + 4 * n + (i & 3); }

struct Unit { int pm, pn; };
struct Gemm { const bf16_t* A; const bf16_t* Bt; int M, N, K; };

struct StaticOrder {
    int nM, nN, nwg, G, c;
    __host__ __device__ void init(int M, int N, int G_, int c_) { nM = M / BM; nN = N / BM; nwg = nM * nN; G = G_; c = c_; }
    __host__ __device__ bool next(int i, Unit& u) const {
        const long L = (long)i * G + c; if (L >= nwg) return false;
        int wgid = (int)L; { const int q = nwg / NXCD, r = nwg % NXCD, xcd = wgid % NXCD, off = wgid / NXCD; wgid = (xcd < r ? xcd * (q + 1) : r * (q + 1) + (xcd - r) * q) + off; }
        const int nig = WGM * nN, gid = wgid / nig, fm = gid * WGM, gsz = (nM - fm) < WGM ? (nM - fm) : WGM;
        u.pm = fm + ((wgid % nig) % gsz); u.pn = (wgid % nig) / gsz; return true;
    }
    __device__ __forceinline__ void a_ready(const Unit&) const {}
    __device__ __forceinline__ void done(const Unit&) const {}
};

__device__ __forceinline__ unsigned cvt_pk_bf16(float lo, float hi) { unsigned r; asm volatile("v_cvt_pk_bf16_f32 %0, %1, %2" : "=v"(r) : "v"(lo), "v"(hi)); return r; }
typedef float f32x2 __attribute__((ext_vector_type(2)));
template <class Epi, class Sched, bool ALIGN_EPI = false, bool SP2 = false>
__device__ __forceinline__ void gemm_phase(PG8_LAS unsigned char* lds, const Gemm g, const Sched& S, const Epi& E) {
    int tid_ = threadIdx.x; asm volatile("" : "+v"(tid_));
    const int tid = tid_, wid = __builtin_amdgcn_readfirstlane(tid >> 6), lane = tid & 63, wr = wid >> 2, wc = wid & 3, fr = lane & 15, fq = lane >> 4;
    const int K = g.K, nt = K / BK;
    unsigned voffA[2], voffB[2];
#pragma unroll
    for (int i = 0; i < 2; ++i) { int R, C; stage_rc(tid * 16 + i * 8192, R, C); const int Rb = Epi::PERM ? ((R & ~31) + perm32(R & 31)) : R;
        voffA[i] = (unsigned)(R * K + C) * 2u; voffB[i] = (unsigned)(Rb * K + C) * 2u; }
    const size_t kstep = (size_t)(BK * 2);
    const size_t hstep = (size_t)HALF * K * 2;
    const size_t tstep = 2 * hstep;
    const unsigned ldsw = (unsigned)wid * 1024u;
    const int aoff = lds_byte(wr * 64 + fr, fq * 8), boff = lds_byte(wc * 32 + fr, fq * 8);
#define PG8_SA(b, h) (((b) * 2 + (h)) * HTB)
#define PG8_SB(b, h) ((4 + (b) * 2 + (h)) * HTB)
#define PG8_STAGE(bufoff, gbase, voff) do { _Pragma("unroll") for (int _i = 0; _i < 2; ++_i) \
        __builtin_amdgcn_global_load_lds((const unsigned*)((const char*)(gbase) + (voff)[_i]), (PG8_LAS unsigned*)(lds + (bufoff) + ldsw + _i * 8192), 16, 0, 0); } while (0)
#define PG8_LDA(dst, b, h) do { _Pragma("unroll") for (int m = 0; m < 4; ++m) _Pragma("unroll") for (int k = 0; k < 2; ++k) dst[m][k] = *(const PG8_LAS bf16x8*)(lds + PG8_SA(b, h) + aoff + m * 2048 + k * 1024); } while (0)
#define PG8_LDB(dst, b, h) do { _Pragma("unroll") for (int n = 0; n < 2; ++n) _Pragma("unroll") for (int k = 0; k < 2; ++k) dst[n][k] = *(const PG8_LAS bf16x8*)(lds + PG8_SB(b, h) + boff + n * 2048 + k * 1024); } while (0)
#define PG8_MMA(ai, bj, At, Bt) do { __builtin_amdgcn_s_setprio(1); _Pragma("unroll") for (int m = 0; m < 4; ++m) _Pragma("unroll") for (int n = 0; n < 2; ++n) _Pragma("unroll") for (int k = 0; k < 2; ++k) \
        acc[ai][bj][m][n] = __builtin_amdgcn_mfma_f32_16x16x32_bf16(Bt[n][k], At[m][k], acc[ai][bj][m][n], 0, 0, 0); __builtin_amdgcn_s_setprio(0); } while (0)
#define PG8_WAIT_V(n) asm volatile("s_waitcnt vmcnt(" #n ")" ::: "memory")
#define PG8_WAIT_L(n) asm volatile("s_waitcnt lgkmcnt(" #n ")" ::: "memory")
#define PG8_BAR __builtin_amdgcn_s_barrier()
#define PG8_SCHED __builtin_amdgcn_sched_barrier(0)
    Unit cur, nxt; int ui = 0;
    if (!S.next(0, cur)) return;
    f32x4 acc[2][2][4][2];
#pragma unroll
    for (int a = 0; a < 2; ++a)
#pragma unroll
        for (int b = 0; b < 2; ++b)
#pragma unroll
            for (int m = 0; m < 4; ++m)
#pragma unroll
                for (int n = 0; n < 2; ++n) acc[a][b][m][n] = (f32x4){0.f, 0.f, 0.f, 0.f};
    bf16x8 At[4][2], B0[2][2], B1[2][2];
    const char* cA = (const char*)g.A + (size_t)cur.pm * tstep; const char* cB = (const char*)g.Bt + (size_t)cur.pn * tstep;
    S.a_ready(cur);
    if constexpr (SP2) {
        PG8_STAGE(PG8_SB(0, 0), cB, voffB); PG8_STAGE(PG8_SB(0, 1), cB + hstep, voffB); PG8_STAGE(PG8_SA(0, 0), cA, voffA); PG8_STAGE(PG8_SA(0, 1), cA + hstep, voffA);
        if (wr == 1) PG8_BAR;
        PG8_WAIT_V(2); PG8_BAR;
        PG8_STAGE(PG8_SB(1, 0), cB + kstep, voffB); PG8_STAGE(PG8_SA(1, 0), cA + kstep, voffA); PG8_STAGE(PG8_SB(1, 1), cB + hstep + kstep, voffB);
        PG8_WAIT_V(6); PG8_BAR;
    } else {
        PG8_STAGE(PG8_SB(0, 0), cB, voffB); PG8_STAGE(PG8_SA(0, 0), cA, voffA); PG8_STAGE(PG8_SB(0, 1), cB + hstep, voffB); PG8_STAGE(PG8_SA(0, 1), cA + hstep, voffA);
        if (wr == 1) PG8_BAR;
        PG8_WAIT_V(4); PG8_BAR;
        PG8_STAGE(PG8_SB(1, 0), cB + kstep, voffB); PG8_STAGE(PG8_SA(1, 0), cA + kstep, voffA); PG8_STAGE(PG8_SB(1, 1), cB + hstep + kstep, voffB);
        PG8_WAIT_V(6); PG8_BAR;
    }
    for (;;) {
        const bool has_next = S.next(ui + 1, nxt);
        const char* nA = has_next ? (const char*)g.A + (size_t)nxt.pm * tstep : cA; const char* nB = has_next ? (const char*)g.Bt + (size_t)nxt.pn * tstep : cB;
        for (int t = 0; t < nt; t += 2) {
            const bool last = (t == nt - 2);
            const char* a1 = cA + (size_t)(t + 1) * kstep;
            const char* a2 = last ? nA : cA + (size_t)(t + 2) * kstep; const char* b2 = last ? nB : cB + (size_t)(t + 2) * kstep;
            const char* a3 = a2 + kstep; const char* b3 = b2 + kstep;
            if (last && has_next) S.a_ready(nxt);
            if constexpr (SP2) {
            PG8_LDB(B0, 0, 0); PG8_LDB(B1, 0, 1); PG8_SCHED; PG8_LDA(At, 0, 0); PG8_STAGE(PG8_SA(1, 1), a1 + hstep, voffA);
            PG8_WAIT_V(8); PG8_WAIT_L(0); PG8_BAR; PG8_MMA(0, 0, At, B0); PG8_MMA(0, 1, At, B1); PG8_BAR; PG8_SCHED;
            PG8_LDA(At, 0, 1); PG8_STAGE(PG8_SB(0, 0), b2, voffB); PG8_STAGE(PG8_SB(0, 1), b2 + hstep, voffB); PG8_STAGE(PG8_SA(0, 0), a2, voffA);
            PG8_WAIT_V(8); PG8_WAIT_L(0); PG8_BAR; PG8_MMA(1, 0, At, B0); PG8_MMA(1, 1, At, B1); PG8_BAR; PG8_SCHED;
            PG8_LDB(B0, 1, 0); PG8_LDB(B1, 1, 1); PG8_SCHED; PG8_LDA(At, 1, 0); PG8_STAGE(PG8_SA(0, 1), a2 + hstep, voffA);
            PG8_WAIT_V(8); PG8_WAIT_L(0); PG8_BAR; PG8_MMA(0, 0, At, B0); PG8_MMA(0, 1, At, B1); PG8_BAR; PG8_SCHED;
            PG8_LDA(At, 1, 1); PG8_STAGE(PG8_SB(1, 0), b3, voffB); PG8_STAGE(PG8_SB(1, 1), b3 + hstep, voffB); PG8_STAGE(PG8_SA(1, 0), a3, voffA);
            PG8_WAIT_V(8); PG8_WAIT_L(0); PG8_BAR; PG8_MMA(1, 0, At, B0); PG8_MMA(1, 1, At, B1); PG8_BAR; PG8_SCHED;
            } else {
            PG8_LDB(B0, 0, 0); PG8_SCHED; PG8_LDA(At, 0, 0); PG8_STAGE(PG8_SA(1, 1), a1 + hstep, voffA);
            PG8_WAIT_L(8); PG8_BAR; PG8_WAIT_L(0); PG8_MMA(0, 0, At, B0); PG8_BAR; PG8_SCHED;
            PG8_LDB(B1, 0, 1); PG8_STAGE(PG8_SB(0, 0), b2, voffB);
            PG8_BAR; PG8_WAIT_L(0); PG8_MMA(0, 1, At, B1); PG8_BAR;
            PG8_LDA(At, 0, 1); PG8_STAGE(PG8_SA(0, 0), a2, voffA);
            PG8_BAR; PG8_WAIT_L(0); PG8_MMA(1, 0, At, B0); PG8_BAR; PG8_SCHED;
            PG8_STAGE(PG8_SB(0, 1), b2 + hstep, voffB);
            PG8_WAIT_V(6); PG8_BAR; PG8_MMA(1, 1, At, B1); PG8_BAR;
            PG8_LDB(B0, 1, 0); PG8_SCHED; PG8_LDA(At, 1, 0); PG8_STAGE(PG8_SA(0, 1), a2 + hstep, voffA);
            PG8_WAIT_L(8); PG8_BAR; PG8_WAIT_L(0); PG8_MMA(0, 0, At, B0); PG8_BAR; PG8_SCHED;
            PG8_LDB(B1, 1, 1); PG8_STAGE(PG8_SB(1, 0), b3, voffB);
            PG8_BAR; PG8_WAIT_L(0); PG8_MMA(0, 1, At, B1); PG8_BAR;
            PG8_LDA(At, 1, 1); PG8_STAGE(PG8_SA(1, 0), a3, voffA);
            PG8_BAR; PG8_WAIT_L(0); PG8_MMA(1, 0, At, B0); PG8_BAR; PG8_SCHED;
            PG8_STAGE(PG8_SB(1, 1), b3 + hstep, voffB);
            PG8_WAIT_V(6); PG8_BAR; PG8_MMA(1, 1, At, B1); PG8_BAR;
            }
        }
        if constexpr (ALIGN_EPI) { if (wr == 0) PG8_BAR; }
        if constexpr (!Epi::AFTER_DRAIN) { E(acc, cur, wr, wc, fr, fq, ui); S.done(cur); }
        if (!has_next) break;
#pragma unroll
        for (int a = 0; a < 2; ++a)
#pragma unroll
            for (int b = 0; b < 2; ++b)
#pragma unroll
                for (int m = 0; m < 4; ++m)
#pragma unroll
                    for (int n = 0; n < 2; ++n) acc[a][b][m][n] = (f32x4){0.f, 0.f, 0.f, 0.f};
        cur = nxt; cA = nA; cB = nB; ++ui;
        if constexpr (ALIGN_EPI) { if (wr == 1) PG8_BAR; }
    }
    PG8_WAIT_V(0);
    if constexpr (!ALIGN_EPI) { if (wr == 0) PG8_BAR; }
    PG8_BAR;
    if constexpr (Epi::AFTER_DRAIN) { E.fused(acc, cur, wr, wc, fr, fq, lds, wid, lane); S.done(cur); }
#undef PG8_SA
#undef PG8_SB
#undef PG8_STAGE
#undef PG8_LDA
#undef PG8_LDB
#undef PG8_MMA
#undef PG8_WAIT_V
#undef PG8_WAIT_L
#undef PG8_BAR
#undef PG8_SCHED
}
}
static __device__ const double INVF[128] = {
  1.0, 0.930572040929699, 0.8659643233600653, 0.8058421877614819,
  0.7498942093324559, 0.6978305848598664, 0.6493816315762113, 0.6042963902381329,
  0.5623413251903491, 0.5232991146814947, 0.4869675251658631, 0.4531583637600818,
  0.4216965034285822, 0.3924189758484536, 0.3651741272548377, 0.33982083289425596,
  0.31622776601683794, 0.29427271762092816, 0.27384196342643613, 0.25482967479793467,
  0.23713737056616552, 0.220673406908459, 0.2053525026457146, 0.19109529749704404,
  0.1778279410038923, 0.16548170999431813, 0.1539926526059492, 0.14330125702369628,
  0.1333521432163324, 0.12409377607517195, 0.11547819846894582, 0.10746078283213174,
  0.1, 0.0930572040929699, 0.08659643233600653, 0.08058421877614819,
  0.07498942093324558, 0.06978305848598663, 0.06493816315762113, 0.060429639023813285,
  0.05623413251903491, 0.05232991146814947, 0.04869675251658631, 0.04531583637600818,
  0.042169650342858224, 0.03924189758484536, 0.03651741272548377, 0.03398208328942559,
  0.03162277660168379, 0.029427271762092817, 0.027384196342643614, 0.025482967479793464,
  0.023713737056616554, 0.0220673406908459, 0.02053525026457146, 0.019109529749704406,
  0.01778279410038923, 0.016548170999431813, 0.01539926526059492, 0.014330125702369627,
  0.01333521432163324, 0.012409377607517195, 0.011547819846894581, 0.010746078283213174,
  0.01, 0.00930572040929699, 0.008659643233600654, 0.008058421877614819,
  0.007498942093324558, 0.006978305848598663, 0.006493816315762113, 0.006042963902381328,
  0.005623413251903491, 0.005232991146814947, 0.004869675251658631, 0.004531583637600818,
  0.004216965034285823, 0.003924189758484536, 0.003651741272548377, 0.003398208328942559,
  0.0031622776601683794, 0.002942727176209282, 0.0027384196342643613, 0.0025482967479793467,
  0.0023713737056616554, 0.0022067340690845897, 0.002053525026457146, 0.0019109529749704406,
  0.0017782794100389228, 0.0016548170999431814, 0.001539926526059492, 0.0014330125702369627,
  0.001333521432163324, 0.0012409377607517195, 0.0011547819846894581, 0.0010746078283213176,
  0.001, 0.0009305720409296989, 0.0008659643233600654, 0.0008058421877614818,
  0.0007498942093324559, 0.0006978305848598664, 0.0006493816315762113, 0.0006042963902381329,
  0.0005623413251903491, 0.0005232991146814947, 0.0004869675251658631, 0.0004531583637600818,
  0.00042169650342858224, 0.0003924189758484536, 0.0003651741272548377, 0.00033982083289425596,
  0.00031622776601683794, 0.00029427271762092817, 0.0002738419634264361, 0.00025482967479793463,
  0.00023713737056616554, 0.00022067340690845897, 0.0002053525026457146, 0.00019109529749704405,
  0.00017782794100389227, 0.00016548170999431815, 0.0001539926526059492, 0.00014330125702369627,
  0.0001333521432163324, 0.00012409377607517196, 0.00011547819846894582, 0.00010746078283213175
};

#include <hip/hip_cooperative_groups.h>
namespace cg = cooperative_groups;
#define LAS __attribute__((address_space(3)))
#define DI __device__ __forceinline__
typedef unsigned short bf16;
typedef short bf16x8 __attribute__((ext_vector_type(8)));
typedef short s16x4 __attribute__((ext_vector_type(4)));
typedef short v4i16_t __attribute__((ext_vector_type(4)));
typedef float f32x4 __attribute__((ext_vector_type(4)));
typedef float f32x16 __attribute__((ext_vector_type(16)));
typedef unsigned u32x4 __attribute__((ext_vector_type(4)));
typedef unsigned u32x2 __attribute__((ext_vector_type(2)));
typedef float f32x2_t __attribute__((ext_vector_type(2)));
typedef __bf16 bf16x2_t __attribute__((ext_vector_type(2)));
typedef unsigned char uchar;

constexpr int NWAVES = 8, NTHR = 512;
constexpr int D = 1024, TP = 65536, TS = 2048, T = TP + TS, FF = 2816, SEQ = 4096, DSEQ = 64, PAST = 1024, KSAMP = PAST + DSEQ;
constexpr int NB_P = 16, NB_S = 32;
constexpr float EPS = 1e-6f;
constexpr float LOG2E = 1.4426950408889634f;
constexpr int LDS_BYTES = 159744;

constexpr size_t O_Y = 0, O_SRP = 69206016, O_KP = 77594624, O_VP = 144703488, O_LFP = 211812352, O_SRS = 212860928,
                 O_KS = 229638144, O_VS = 231735296, O_LFS = 233832448;
constexpr size_t SZ_WIN = (size_t)5632 * 1024 * 2, SZ_WOUT = (size_t)1024 * 2816 * 2, SZ_ACT = (size_t)T * 1024 * 2;
constexpr size_t WS_WIN = 1u << 20;
constexpr size_t WS_KVF = WS_WIN + 4 * SZ_WIN;
constexpr size_t WS_WOUT = WS_KVF + (size_t)2304 * 1024 * 2;
constexpr size_t WS_RIN = WS_WOUT + 4 * SZ_WOUT;
constexpr size_t WS_ROUT = WS_RIN + (size_t)6144 * 1024 * 2;
constexpr size_t WS_WQ = WS_ROUT + (size_t)1024 * 2048 * 2;
__host__ __device__ constexpr int win_slot(int f) { return f == 2 ? 3 : (f == 3 ? 2 : f); }
constexpr size_t WS_WO = WS_WQ + (size_t)1024 * 1024 * 2;
constexpr size_t WS_ROPE = WS_WO + (size_t)1024 * 1024 * 2;
constexpr size_t WS_SSQ = WS_ROPE + (size_t)4096 * 256 * 4;
constexpr size_t WS_BIASP = WS_SSQ + (size_t)T * 16 * 4;
constexpr size_t WS_BIASS = WS_BIASP + (size_t)256 * 4096 * 4;
constexpr size_t WS_HB = WS_BIASS + (size_t)512 * KSAMP * 4;
constexpr size_t WS_R = WS_HB + SZ_ACT;
constexpr size_t SZ_HID = (size_t)T * FF * 2, K2B_BYTES = (size_t)(TP + NB_S * KSAMP) * 1024 * 2;
constexpr size_t R_HID = 0, R_VO = 0, R_G = 2 * SZ_ACT, R_QF = 0, R_K2B = SZ_HID, R_V2B = R_K2B + K2B_BYTES;
constexpr size_t WS_END = WS_R + R_V2B + K2B_BYTES;
static_assert(R_G + 2 * SZ_ACT <= R_V2B + K2B_BYTES, "retention overlay");
static_assert(SZ_ACT <= SZ_HID && SZ_HID % 256 == 0, "qf overlay");
static_assert(WS_END <= (size_t)1073741824, "ws size");
static_assert(WS_HB % 256 == 0 && WS_R % 256 == 0 && WS_ROPE % 256 == 0 && WS_SSQ % 256 == 0, "align");

DI unsigned pk(float lo, float hi) { f32x2_t v = {lo, hi}; bf16x2_t b = __builtin_convertvector(v, bf16x2_t); return __builtin_bit_cast(unsigned, b); }
DI float bflo(unsigned w) { return __uint_as_float(w << 16); }
DI float bfhi(unsigned w) { return __uint_as_float(w & 0xffff0000u); }
DI float ex2(float x) { return __builtin_amdgcn_exp2f(x); }
DI float silu_f(float x) { return x * __builtin_amdgcn_rcpf(1.0f + __expf(-x)); }
DI float wave_sum(float v) {
#pragma unroll
    for (int o = 1; o < 64; o <<= 1) v += __shfl_xor(v, o);
    return v;
}
DI float row_rstd(const float* ssq, int row) {
    const f32x4* p = (const f32x4*)(ssq + (size_t)row * 16);
    const f32x4 a = p[0], b = p[1], c = p[2], d = p[3];
    const float s = (((a[0] + a[1]) + (a[2] + a[3])) + ((b[0] + b[1]) + (b[2] + b[3]))) + (((c[0] + c[1]) + (c[2] + c[3])) + ((d[0] + d[1]) + (d[2] + d[3])));
    return __builtin_amdgcn_rsqf(s * (1.0f / 1024.0f) + EPS);
}

namespace pg8 {
struct EpiSwiGLU {
    static constexpr bool PERM = true, AFTER_DRAIN = false;
    bf16_t* O; const LAS _Float16* rl;
    __device__ __forceinline__ void operator()(const f32x4 (&acc)[2][2][4][2], const Unit& u, int wr, int wc, int fr, int fq, int ui) const {
        const int row0 = u.pm * BM + wr * 64 + fr, col0 = u.pn * 128 + wc * 32 + 8 * fq;
        const LAS _Float16* rlu = rl + ui * 256 + wr * 64 + fr;
#pragma unroll
        for (int ai = 0; ai < 2; ++ai)
#pragma unroll
            for (int m = 0; m < 4; ++m) {
                const int row = row0 + ai * HALF + m * 16; const float rs = (float)rlu[ai * HALF + m * 16];
                u32x4 w;
#pragma unroll
                for (int n = 0; n < 2; ++n) {
                    const f32x4 g = acc[ai][0][m][n] * rs, up = acc[ai][1][m][n] * rs;
                    const float h0 = silu_f(g[0]) * up[0], h1 = silu_f(g[1]) * up[1], h2 = silu_f(g[2]) * up[2], h3 = silu_f(g[3]) * up[3];
                    w[2 * n] = pk(h0, h1); w[2 * n + 1] = pk(h2, h3);
                }
                *(u32x4*)(O + (size_t)row * FF + col0) = w;
            }
    }
};
struct EpiRes {
    static constexpr bool PERM = true, AFTER_DRAIN = false;
    bf16_t* HB; float* ssq; float alpha;
    __device__ __forceinline__ void operator()(const f32x4 (&acc)[2][2][4][2], const Unit& u, int wr, int wc, int fr, int fq, int ui) const {
        const int row0 = u.pm * BM + wr * 64 + fr, col0 = u.pn * BM + wc * 32 + 8 * fq;
#pragma unroll
        for (int ai = 0; ai < 2; ++ai) {
            asm volatile("" ::: "memory");
            u32x4 pre[4][2];
#pragma unroll
            for (int m = 0; m < 4; ++m)
#pragma unroll
                for (int bj = 0; bj < 2; ++bj) pre[m][bj] = *(const u32x4*)(HB + (size_t)(row0 + ai * HALF + m * 16) * D + col0 + bj * HALF);
#pragma unroll
            for (int m = 0; m < 4; ++m) {
                const int row = row0 + ai * HALF + m * 16; float s = 0.f;
#pragma unroll
                for (int bj = 0; bj < 2; ++bj) {
                    const u32x4 pv = pre[m][bj];
                    const f32x4 h0 = {bflo(pv[0]), bfhi(pv[0]), bflo(pv[1]), bfhi(pv[1])}, h1 = {bflo(pv[2]), bfhi(pv[2]), bflo(pv[3]), bfhi(pv[3])};
                    const f32x4 o0 = h0 + acc[ai][bj][m][0] * alpha, o1 = h1 + acc[ai][bj][m][1] * alpha;
                    u32x4 w; w[0] = pk(o0[0], o0[1]); w[1] = pk(o0[2], o0[3]); w[2] = pk(o1[0], o1[1]); w[3] = pk(o1[2], o1[3]);
                    *(u32x4*)(HB + (size_t)row * D + col0 + bj * HALF) = w;
                    s += (o0[0] * o0[0] + o0[1] * o0[1]) + (o0[2] * o0[2] + o0[3] * o0[3]) + (o1[0] * o1[0] + o1[1] * o1[1]) + (o1[2] * o1[2] + o1[3] * o1[3]);
                }
                s += __shfl_xor(s, 16); s += __shfl_xor(s, 32);
                if (fq == 0) ssq[(size_t)row * 16 + u.pn * 4 + wc] = s;
            }
        }
    }
};
struct EpiRetIn {
    static constexpr bool PERM = true, AFTER_DRAIN = false;
    bf16_t *Q, *K, *V, *G; const LAS _Float16* rl; const float* rope;
    __device__ __forceinline__ void operator()(const f32x4 (&acc)[2][2][4][2], const Unit& u, int wr, int wc, int fr, int fq, int ui) const {
        const int row0 = u.pm * BM + wr * 64 + fr, d0 = wc * 32 + 8 * fq;
        const int pn = u.pn;
        const LAS _Float16* rlu = rl + ui * 256 + wr * 64 + fr;
#pragma unroll
        for (int ai = 0; ai < 2; ++ai)
#pragma unroll
            for (int m = 0; m < 4; ++m) {
                if (pn < 8 && (m & 1) == 0) asm volatile("" ::: "memory");
                const int row = row0 + ai * HALF + m * 16; const float rs = (float)rlu[ai * HALF + m * 16];
                if (pn < 8) {
                    const int pos = row < TP ? (row & (SEQ - 1)) : PAST + ((row - TP) & (DSEQ - 1));
                    const float* cs = rope + (size_t)pos * 256 + d0;
                    const float sc = pn < 4 ? rs * 0.0625f : rs;
                    bf16_t* dst = (pn < 4 ? Q : K) + (size_t)row * D + (pn & 3) * 256 + d0;
                    u32x4 w1, w2;
#pragma unroll
                    for (int n = 0; n < 2; ++n) {
                        const f32x4 c = *(const f32x4*)(cs + 4 * n), s = *(const f32x4*)(cs + 128 + 4 * n);
                        const f32x4 x1 = acc[ai][0][m][n] * sc, x2 = acc[ai][1][m][n] * sc;
                        const f32x4 y1 = x1 * c - x2 * s, y2 = x1 * s + x2 * c;
                        w1[2 * n] = pk(y1[0], y1[1]); w1[2 * n + 1] = pk(y1[2], y1[3]);
                        w2[2 * n] = pk(y2[0], y2[1]); w2[2 * n + 1] = pk(y2[2], y2[3]);
                    }
                    *(u32x4*)dst = w1; *(u32x4*)(dst + 128) = w2;
                } else {
                    const bool isg = pn >= 16;
                    bf16_t* dst = (isg ? G : V) + (size_t)row * 2048 + ((pn - 8) & 7) * 256 + d0;
#pragma unroll
                    for (int bj = 0; bj < 2; ++bj) {
                        f32x4 a = acc[ai][bj][m][0] * rs, b = acc[ai][bj][m][1] * rs;
                        if (isg) { a = (f32x4){silu_f(a[0]), silu_f(a[1]), silu_f(a[2]), silu_f(a[3])}; b = (f32x4){silu_f(b[0]), silu_f(b[1]), silu_f(b[2]), silu_f(b[3])}; }
                        u32x4 w; w[0] = pk(a[0], a[1]); w[1] = pk(a[2], a[3]); w[2] = pk(b[0], b[1]); w[3] = pk(b[2], b[3]);
                        *(u32x4*)(dst + bj * HALF) = w;
                    }
                }
            }
    }
};
struct EpiKVF {
    static constexpr bool PERM = true, AFTER_DRAIN = false;
    float* out; bf16_t *K2B, *V2B; const LAS _Float16* rl; const float* bf;
    __device__ __forceinline__ void operator()(const f32x4 (&acc)[2][2][4][2], const Unit& u, int wr, int wc, int fr, int fq, int ui) const {
        const int row0 = u.pm * BM + wr * 64 + fr, d0 = wc * 32 + 8 * fq;
        const int pn = u.pn; const bool samp = u.pm >= TP / BM;
        const LAS _Float16* rlu = rl + ui * 256 + wr * 64 + fr;
        if (pn < 8) {
            const bool isv = pn >= 4;
            float* fbase = out + (samp ? (isv ? O_VS : O_KS) - (size_t)TP * D : (isv ? O_VP : O_KP)) + (pn & 3) * 256 + d0;
            bf16_t* bbase = (isv ? V2B : K2B) + (pn & 3) * 256 + d0;
#pragma unroll
            for (int ai = 0; ai < 2; ++ai)
#pragma unroll
                for (int m = 0; m < 4; ++m) {
                    const int row = row0 + ai * HALF + m * 16; const float rs = (float)rlu[ai * HALF + m * 16];
                    const int brow = row + (samp ? (((row - TP) >> 6) + 1) * 1024 : 0);
                    float* fo = fbase + (size_t)row * D; bf16_t* bo = bbase + (size_t)brow * D;
#pragma unroll
                    for (int bj = 0; bj < 2; ++bj) {
                        const f32x4 a = acc[ai][bj][m][0] * rs, b = acc[ai][bj][m][1] * rs;
                        __builtin_nontemporal_store(a, (f32x4*)(fo + bj * HALF)); __builtin_nontemporal_store(b, (f32x4*)(fo + bj * HALF + 4));
                        u32x4 w; w[0] = pk(a[0], a[1]); w[1] = pk(a[2], a[3]); w[2] = pk(b[0], b[1]); w[3] = pk(b[2], b[3]);
                        *(u32x4*)(bo + bj * HALF) = w;
                    }
                }
        } else if (wc == 0 && fq < 2) {
            float* lbase = out + (samp ? O_LFS - (size_t)TP * 16 : O_LFP) + 8 * fq;
            const f32x4 bb0 = *(const f32x4*)(bf + 8 * fq), bb1 = *(const f32x4*)(bf + 8 * fq + 4);
#pragma unroll
            for (int ai = 0; ai < 2; ++ai)
#pragma unroll
                for (int m = 0; m < 4; ++m) {
                    const int row = row0 + ai * HALF + m * 16; const float rs = (float)rlu[ai * HALF + m * 16];
                    float* lo = lbase + (size_t)row * 16;
#pragma unroll
                    for (int n = 0; n < 2; ++n) {
                        const f32x4 x = acc[ai][0][m][n] * rs + (n ? bb1 : bb0); f32x4 y;
#pragma unroll
                        for (int j = 0; j < 4; ++j) y[j] = fminf(x[j], 0.f) - __logf(1.0f + __expf(-fabsf(x[j])));
                        *(f32x4*)(lo + 4 * n) = y;
                    }
                }
        }
    }
};
struct EpiSwiKVF {
    static constexpr bool PERM = true, AFTER_DRAIN = false;
    EpiSwiGLU swi; EpiKVF kvf;
    __device__ __forceinline__ void operator()(const f32x4 (&acc)[2][2][4][2], const Unit& u, int wr, int wc, int fr, int fq, int ui) const {
        if (u.pn < 22) swi(acc, u, wr, wc, fr, fq, ui);
        else { Unit u2; u2.pm = u.pm; u2.pn = u.pn - 22; kvf(acc, u2, wr, wc, fr, fq, ui); }
    }
};
struct EpiQ {
    static constexpr bool PERM = true, AFTER_DRAIN = false;
    bf16_t* O; const LAS _Float16* rl;
    __device__ __forceinline__ void operator()(const f32x4 (&acc)[2][2][4][2], const Unit& u, int wr, int wc, int fr, int fq, int ui) const {
        const int row0 = u.pm * BM + wr * 64 + fr, col0 = u.pn * BM + wc * 32 + 8 * fq;
        const LAS _Float16* rlu = rl + ui * 256 + wr * 64 + fr;
#pragma unroll
        for (int ai = 0; ai < 2; ++ai)
#pragma unroll
            for (int m = 0; m < 4; ++m) {
                const int row = row0 + ai * HALF + m * 16; const float rs = (float)rlu[ai * HALF + m * 16] * (0.125f * LOG2E);
#pragma unroll
                for (int bj = 0; bj < 2; ++bj) {
                    const f32x4 a = acc[ai][bj][m][0] * rs, b = acc[ai][bj][m][1] * rs;
                    u32x4 w; w[0] = pk(a[0], a[1]); w[1] = pk(a[2], a[3]); w[2] = pk(b[0], b[1]); w[3] = pk(b[2], b[3]);
                    *(u32x4*)(O + (size_t)row * D + col0 + bj * HALF) = w;
                }
            }
    }
};
}

DI void tr_item(const float* W, int K, int N, bf16* WT, int drow0, const float* g, LAS float* scr, int k0, int n0, int lane) {
    const int n = n0 + 4 * (lane & 7);
    f32x4 v[8];
#pragma unroll
    for (int i = 0; i < 8; ++i) { const int kk = 8 * i + (lane >> 3); v[i] = (n < N) ? __builtin_nontemporal_load((const f32x4*)(W + (size_t)(k0 + kk) * N + n)) : (f32x4){0.f, 0.f, 0.f, 0.f}; }
#pragma unroll
    for (int i = 0; i < 8; ++i) { const int kk = 8 * i + (lane >> 3); const float gs = g ? g[k0 + kk] : 1.0f; LAS float* d = scr + kk * 33 + 4 * (lane & 7);
        d[0] = v[i][0] * gs; d[1] = v[i][1] * gs; d[2] = v[i][2] * gs; d[3] = v[i][3] * gs; }
    asm volatile("s_waitcnt lgkmcnt(0)" ::: "memory");
    const int c = lane & 7;
#pragma unroll
    for (int j = 0; j < 4; ++j) { const int nn = (lane >> 3) + 8 * j; const LAS float* s = scr + (8 * c) * 33 + nn;
        u32x4 o; o[0] = pk(s[0 * 33], s[1 * 33]); o[1] = pk(s[2 * 33], s[3 * 33]); o[2] = pk(s[4 * 33], s[5 * 33]); o[3] = pk(s[6 * 33], s[7 * 33]);
        *(u32x4*)(WT + (size_t)(drow0 + nn) * K + k0 + 8 * c) = o; }
    asm volatile("s_waitcnt lgkmcnt(0)" ::: "memory");
}
DI bool tr_matrix(int& r, const float* W, int K, int N, int nblk, bf16* WT, const float* g, int mode, LAS float* scr, int lane) {
    const int items = (K / 64) * nblk;
    if (r >= items) { r -= items; return false; }
    const int kb = r / nblk, nb = r % nblk, n0 = 32 * nb;
    int drow0 = n0;
    if (mode == 1) { const int bj = n0 / FF, rem = n0 % FF; drow0 = 256 * (rem / 128) + 128 * bj + (rem % 128); }
    tr_item(W, K, N, WT, drow0, g, scr, 64 * kb, n0, lane);
    return true;
}
DI void sincos_d(double x, float& s, float& c) {
    const double n = __builtin_rint(x * 0.63661977236758134308);
    double r = __builtin_fma(-n, 1.57079632679489655800e+00, x); r = __builtin_fma(-n, 6.12323399573676603587e-17, r);
    const double r2 = r * r;
    double sp = -1.0 / 1307674368000.0; sp = sp * r2 + 1.0 / 6227020800.0; sp = sp * r2 - 1.0 / 39916800.0; sp = sp * r2 + 1.0 / 362880.0; sp = sp * r2 - 1.0 / 5040.0; sp = sp * r2 + 1.0 / 120.0; sp = sp * r2 - 1.0 / 6.0; sp = sp * r2 * r + r;
    double cp = 1.0 / 20922789888000.0; cp = cp * r2 - 1.0 / 87178291200.0; cp = cp * r2 + 1.0 / 479001600.0; cp = cp * r2 - 1.0 / 3628800.0; cp = cp * r2 + 1.0 / 40320.0; cp = cp * r2 - 1.0 / 720.0; cp = cp * r2 + 1.0 / 24.0; cp = cp * r2 - 0.5; cp = cp * r2 + 1.0;
    const int q = ((int)n) & 3;
    const double ss = (q == 0) ? sp : (q == 1) ? cp : (q == 2) ? -sp : -cp;
    const double cc = (q == 0) ? cp : (q == 1) ? -sp : (q == 2) ? -cp : sp;
    s = (float)ss; c = (float)cc;
}

DI void cache_convert(const float* src0, bf16* dst, int gt, int NGT) {
    constexpr int NPIECE = NB_S * PAST * D / 8;
    for (int p0 = gt; p0 < NPIECE; p0 += 4 * NGT) {
        f32x4 a[4], bq[4];
#pragma unroll
        for (int u = 0; u < 4; ++u) { const int q = p0 + u * NGT < NPIECE ? p0 + u * NGT : p0;
            const float* src = src0 + (size_t)(q >> 7) * D + (q & 127) * 8; a[u] = __builtin_nontemporal_load((const f32x4*)src); bq[u] = __builtin_nontemporal_load((const f32x4*)(src + 4)); }
#pragma unroll
        for (int u = 0; u < 4; ++u) { const int q = p0 + u * NGT; if (q >= NPIECE) break;
            const int row = q >> 7, c8 = q & 127; const int b_ = row >> 10, s = row & 1023;
            u32x4 w; w[0] = pk(a[u][0], a[u][1]); w[1] = pk(a[u][2], a[u][3]); w[2] = pk(bq[u][0], bq[u][1]); w[3] = pk(bq[u][2], bq[u][3]);
            *(u32x4*)(dst + ((size_t)TP + (size_t)b_ * KSAMP + s) * D + c8 * 8) = w; }
    }
}
constexpr int RL_OFF = 131072;
static_assert(RL_OFF + 32 * 512 <= LDS_BYTES - 64, "rstd table (fp16, up to 32 units per block)");
DI void rstd_prepass(LAS uchar* lds, const float* ssq, const pg8::StaticOrder& S, int tid) {
    LAS _Float16* rl = (LAS _Float16*)(lds + RL_OFF);
    pg8::Unit u; int nun = 0;
    while (nun < 32 && S.next(nun, u)) ++nun;
#pragma unroll 4
    for (int e = tid; e < nun * 256; e += NTHR) { S.next(e >> 8, u); rl[e] = (_Float16)row_rstd(ssq, u.pm * 256 + (e & 255)); }
    __syncthreads();
}
#define KSEL(k) (ONLY < 0 || ONLY == (k))
struct Params { const float* in[22]; float* out; unsigned char* ws; int ph_lo, ph_hi; unsigned char prog[32]; };

DI void phase_prologue(const Params& P, uchar* ws, float* out, LAS uchar* lds, int gw, int NGW, int wave, int lane, int mode) {
    LAS float* scr = (LAS float*)(lds + wave * 16384);
    constexpr int I_IN = 16 * 176, I_OUT = 44 * 32;
    constexpr int NITEMS = 4 * I_IN + 4 * I_OUT + 16 * 192 + 32 * 32 + 16 * 72 + 2 * 16 * 32, NEARLY = I_IN + I_OUT;
    const int count = mode ? NITEMS - NEARLY : NEARLY;
    for (int e = gw; e < count; e += NGW) {
        const int it = mode ? (e < 3 * I_IN ? I_IN + e : 4 * I_IN + I_OUT + (e - 3 * I_IN)) : (e < I_IN ? e : 4 * I_IN + (e - I_IN));
        int r = it; bool done = false;
#pragma unroll
        for (int f = 0; f < 4; ++f) {
            if (done) break;
            const int l = f >> 1; const bool second = f & 1;
            done = tr_matrix(r, P.in[second ? 11 : 7] + (size_t)l * 1024 * 5632, 1024, 5632, 176, (bf16*)(ws + WS_WIN + win_slot(f) * SZ_WIN), P.in[second ? 10 : 6] + l * 1024, 1, scr, lane);
        }
#pragma unroll
        for (int f = 0; f < 4; ++f) {
            if (done) break;
            const int l = f >> 1; const bool second = f & 1;
            done = tr_matrix(r, P.in[second ? 12 : 8] + (size_t)l * 2816 * 1024, 2816, 1024, 32, (bf16*)(ws + WS_WOUT + f * SZ_WOUT), nullptr, 0, scr, lane);
        }
        if (!done) done = tr_matrix(r, P.in[13], 1024, 6144, 192, (bf16*)(ws + WS_RIN), P.in[9], 0, scr, lane);
        if (!done) done = tr_matrix(r, P.in[15], 2048, 1024, 32, (bf16*)(ws + WS_ROUT), P.in[14], 0, scr, lane);
        if (!done) done = tr_matrix(r, P.in[17], 1024, 2064, 72, (bf16*)(ws + WS_KVF), P.in[16], 0, scr, lane);
        if (!done) done = tr_matrix(r, P.in[19], 1024, 1024, 32, (bf16*)(ws + WS_WQ), P.in[9] + 1024, 0, scr, lane);
        if (!done) done = tr_matrix(r, P.in[20], 1024, 1024, 32, (bf16*)(ws + WS_WO), nullptr, 0, scr, lane);
    }
    if (mode == 0) {
        bf16* HB = (bf16*)(ws + WS_HB); float* ssq = (float*)(ws + WS_SSQ);
        constexpr int NR = 4;
        for (int m0 = gw; m0 < T; m0 += NR * NGW) {
            f32x4 v[NR][4];
#pragma unroll
            for (int u = 0; u < NR; ++u) { const int m = m0 + u * NGW < T ? m0 + u * NGW : m0;
                const float* src = m < TP ? P.in[0] + (size_t)m * D : P.in[1] + (size_t)(m - TP) * D;
#pragma unroll
                for (int j = 0; j < 4; ++j) v[u][j] = __builtin_nontemporal_load((const f32x4*)src + lane + 64 * j); }
#pragma unroll
            for (int u = 0; u < NR; ++u) {
                const int m = m0 + u * NGW; if (m >= T) break;
                float s = 0.f;
#pragma unroll
                for (int j = 0; j < 4; ++j) s += (v[u][j][0] * v[u][j][0] + v[u][j][1] * v[u][j][1]) + (v[u][j][2] * v[u][j][2] + v[u][j][3] * v[u][j][3]);
                s = wave_sum(s);
#pragma unroll
                for (int j = 0; j < 4; ++j) { u32x2 w; w[0] = pk(v[u][j][0], v[u][j][1]); w[1] = pk(v[u][j][2], v[u][j][3]); ((u32x2*)(HB + (size_t)m * D))[lane + 64 * j] = w; }
                if (lane < 16) ssq[(size_t)m * 16 + lane] = lane == 0 ? s : 0.f;
            }
        }
    }
}

DI void rope_table(uchar* ws, int gw, int NGW, int lane) {
    {
        const int gt = gw * 64 + lane, NGT = NGW * 64; float* rope = (float*)(ws + WS_ROPE);
        for (int e = gt; e < 4096 * 128; e += NGT) { const int pos = e >> 7, j = e & 127; float s, c; sincos_d((double)pos * INVF[j], s, c); rope[(size_t)pos * 256 + j] = c; rope[(size_t)pos * 256 + 128 + j] = s; }
    }
}

DI f32x16 mfma32(bf16x8 a, bf16x8 b, f32x16 c) { return __builtin_amdgcn_mfma_f32_32x32x16_bf16(a, b, c, 0, 0, 0); }
DI int crow(int i, int hh) { return (i & 3) + 8 * (i >> 2) + 4 * hh; }
DI s16x4 vtr(const LAS uchar* p) { return __builtin_bit_cast(s16x4, __builtin_amdgcn_ds_read_tr16_b64_v4i16((LAS v4i16_t*)p)); }
DI bf16x8 cat8(s16x4 lo, s16x4 hi) { return __builtin_shufflevector(lo, hi, 0, 1, 2, 3, 4, 5, 6, 7); }
DI bf16x8 ldsv(const LAS uchar* p) { return *(const LAS bf16x8*)p; }
template <int S> DI bf16x8 pack8(const f32x16& x) { u32x4 p; p[0] = pk(x[8 * S], x[8 * S + 1]); p[1] = pk(x[8 * S + 2], x[8 * S + 3]); p[2] = pk(x[8 * S + 4], x[8 * S + 5]); p[3] = pk(x[8 * S + 6], x[8 * S + 7]); return __builtin_bit_cast(bf16x8, p); }
DI s16x4 scale4(s16x4 v, float f0, float f1, float f2, float f3) {
    const u32x2 w = __builtin_bit_cast(u32x2, v); u32x2 o;
    o[0] = pk(bflo(w[0]) * f0, bfhi(w[0]) * f1); o[1] = pk(bflo(w[1]) * f2, bfhi(w[1]) * f3);
    return __builtin_bit_cast(s16x4, o);
}
namespace ret {
constexpr int QP = 528, KP = 528, VP = 320, SP = 528;
constexpr int OFF_Q = 0, OFF_K = 64 * QP, OFF_V = OFF_K + 64 * KP, OFF_ST = OFF_V + 64 * VP, END = OFF_ST + 128 * SP;
static_assert(END <= LDS_BYTES, "retention LDS");
}
DI void ret_item(LAS uchar* lds, const bf16* Qg, const bf16* Kg, bf16* Vg, size_t rowbase, int h, int sl, int nch, const float* S0, float* Sout, float lg2) {
    using namespace ret;
    int tid_ = threadIdx.x; asm volatile("" : "+v"(tid_));
    const int tid = tid_, lane = tid & 63, w = __builtin_amdgcn_readfirstlane(tid >> 6), r = lane & 31, hh = lane >> 5;
    const int ci = w >> 2, ei = w & 3, dq = w >> 1, eh = w & 1;
    const int q4 = (lane & 15) >> 2, p4 = lane & 3, blk = (lane >> 4) & 1;
    f32x16 S[2][2];
    if (S0) {
#pragma unroll
        for (int ti = 0; ti < 2; ++ti)
#pragma unroll
            for (int tj = 0; tj < 2; ++tj)
#pragma unroll
                for (int i = 0; i < 16; ++i) S[ti][tj][i] = S0[(size_t)(64 * dq + 32 * ti + crow(i, hh)) * 512 + 128 * sl + 64 * eh + 32 * tj + r];
    } else {
#pragma unroll
        for (int ti = 0; ti < 2; ++ti)
#pragma unroll
            for (int tj = 0; tj < 2; ++tj)
#pragma unroll
                for (int i = 0; i < 16; ++i) S[ti][tj][i] = 0.f;
    }
    const float g64 = ex2(lg2 * 64.f);
    const bf16* qsrc = Qg + (rowbase + (tid >> 5)) * D + h * 256 + (tid & 31) * 8;
    const bf16* ksrc = Kg + (rowbase + (tid >> 5)) * D + h * 256 + (tid & 31) * 8;
    bf16* vsrc = Vg + (rowbase + (tid >> 4)) * 2048 + h * 512 + sl * 128 + (tid & 15) * 8;
    const int qdst = (tid >> 5) * QP + (tid & 31) * 16, vdst = (tid >> 4) * VP + (tid & 15) * 16;
    const float lg2_inv = lg2;
#pragma unroll 1
    for (int n = 0; n < nch; ++n) {
        float lg2 = lg2_inv; asm volatile("" : "+v"(lg2));
        u32x4 rq[4], rk[4], rv[2];
        {
            const size_t adv = (size_t)64 * n;
#pragma unroll
            for (int i = 0; i < 4; ++i) { rq[i] = *(const u32x4*)(qsrc + (adv + 16 * i) * D); rk[i] = *(const u32x4*)(ksrc + (adv + 16 * i) * D); }
#pragma unroll
            for (int i = 0; i < 2; ++i) rv[i] = *(const u32x4*)(vsrc + (adv + 32 * i) * 2048);
        }
        __syncthreads();
#pragma unroll
        for (int i = 0; i < 4; ++i) { *(LAS u32x4*)(lds + OFF_Q + qdst + 16 * i * QP) = rq[i]; *(LAS u32x4*)(lds + OFF_K + qdst + 16 * i * KP) = rk[i]; }
        asm volatile("" ::: "memory");
#pragma unroll
        for (int i = 0; i < 2; ++i) {
            const float f = ex2(lg2 * (float)(63 - 32 * i - (tid >> 4))); u32x4 w;
#pragma unroll
            for (int j = 0; j < 4; ++j) w[j] = pk(bflo(rv[i][j]) * f, bfhi(rv[i][j]) * f);
            *(LAS u32x4*)(lds + OFF_V + vdst + 32 * i * VP) = w;
        }
        asm volatile("" ::: "memory");
#pragma unroll
        for (int ti = 0; ti < 2; ++ti)
#pragma unroll
            for (int tj = 0; tj < 2; ++tj)
#pragma unroll
                for (int g = 0; g < 4; ++g) { u32x2 v; v[0] = pk(S[ti][tj][4 * g], S[ti][tj][4 * g + 1]); v[1] = pk(S[ti][tj][4 * g + 2], S[ti][tj][4 * g + 3]);
                    *(LAS u32x2*)(lds + OFF_ST + (64 * eh + 32 * tj + r) * SP + (64 * dq + 32 * ti + 8 * g + 4 * hh) * 2) = v; }
        __syncthreads();
        f32x16 sc0, sc1;
#pragma unroll
        for (int i = 0; i < 16; ++i) { sc0[i] = 0.f; sc1[i] = 0.f; }
        const LAS uchar* qrow = lds + OFF_Q + (32 * ci + r) * QP + hh * 16;
        {
            const LAS uchar* krow = lds + OFF_K + r * KP + hh * 16;
#pragma unroll
            for (int kk = 0; kk < 16; ++kk) { const bf16x8 qf = ldsv(qrow + kk * 32); sc0 = mfma32(ldsv(krow + kk * 32), qf, sc0); sc1 = mfma32(ldsv(krow + 32 * KP + kk * 32), qf, sc1);
                if ((kk & 3) == 3) asm volatile("" ::: "memory"); }
        }
        {
            const float a0 = (float)(32 * ci + r - 4 * hh), a1 = a0 - 32.f;
#pragma unroll
            for (int i = 0; i < 16; ++i) { const float cc = (float)((i & 3) + 8 * (i >> 2)); const float sm = cc + (float)(4 * hh - 63);
                sc0[i] *= ex2(lg2 * (fabsf(a0 - cc) + sm)); sc1[i] *= ex2(lg2 * (fabsf(a1 - cc) + sm + 32.f)); }
        }
        f32x16 o;
#pragma unroll
        for (int i = 0; i < 16; ++i) o[i] = 0.f;
        {
            const LAS uchar* vb = lds + OFF_V + (4 * hh + q4) * VP + (32 * ei + 16 * blk + 4 * p4) * 2;
            o = mfma32(pack8<0>(sc0), cat8(vtr(vb), vtr(vb + 8 * VP)), o);
            o = mfma32(pack8<1>(sc0), cat8(vtr(vb + 16 * VP), vtr(vb + 24 * VP)), o);
            o = mfma32(pack8<0>(sc1), cat8(vtr(vb + 32 * VP), vtr(vb + 40 * VP)), o);
            o = mfma32(pack8<1>(sc1), cat8(vtr(vb + 48 * VP), vtr(vb + 56 * VP)), o);
        }
        f32x16 o2;
#pragma unroll
        for (int i = 0; i < 16; ++i) o2[i] = 0.f;
        {
            const LAS uchar* strow = lds + OFF_ST + (32 * ei + r) * SP + hh * 16;
#pragma unroll
            for (int kk = 0; kk < 16; ++kk) { o2 = mfma32(ldsv(qrow + kk * 32), ldsv(strow + kk * 32), o2); if ((kk & 3) == 3) asm volatile("" ::: "memory"); }
        }
        {
            bf16* op = Vg + (rowbase + (size_t)64 * n + 32 * ci) * 2048 + h * 512 + sl * 128 + 32 * ei + r;
#pragma unroll
            for (int i = 0; i < 16; ++i) { const int c = crow(i, hh); const float val = o[i] + o2[i] * ex2(lg2 * (float)(32 * ci + c + 1));
                op[(size_t)c * 2048] = (bf16)(pk(val, 0.f) & 0xffffu); }
        }
        asm volatile("" ::: "memory");
#pragma unroll
        for (int ti = 0; ti < 2; ++ti)
#pragma unroll
            for (int tj = 0; tj < 2; ++tj) S[ti][tj] = S[ti][tj] * g64;
        {
            const LAS uchar* ka = lds + OFF_K + (8 * hh + q4) * KP + (64 * dq + 16 * blk + 4 * p4) * 2;
            const LAS uchar* va = lds + OFF_V + (8 * hh + q4) * VP + (64 * eh + 16 * blk + 4 * p4) * 2;
#pragma unroll
            for (int kk = 0; kk < 4; ++kk) {
                bf16x8 A[2], B[2];
#pragma unroll
                for (int ti = 0; ti < 2; ++ti) A[ti] = cat8(vtr(ka + kk * 16 * KP + ti * 64), vtr(ka + kk * 16 * KP + 4 * KP + ti * 64));
#pragma unroll
                for (int tj = 0; tj < 2; ++tj) B[tj] = cat8(vtr(va + kk * 16 * VP + tj * 64), vtr(va + kk * 16 * VP + 4 * VP + tj * 64));
#pragma unroll
                for (int ti = 0; ti < 2; ++ti)
#pragma unroll
                    for (int tj = 0; tj < 2; ++tj) S[ti][tj] = mfma32(A[ti], B[tj], S[ti][tj]);
                asm volatile("" ::: "memory");
            }
        }
    }
#pragma unroll
    for (int ti = 0; ti < 2; ++ti)
#pragma unroll
        for (int tj = 0; tj < 2; ++tj)
#pragma unroll
            for (int i = 0; i < 16; ++i) __builtin_nontemporal_store(S[ti][tj][i], Sout + (size_t)(64 * dq + 32 * ti + crow(i, hh)) * 512 + 128 * sl + 64 * eh + 32 * tj + r);
    __syncthreads();
}

namespace fox {
constexpr int KPI = 144, VPI = 192, KB = 64 * KPI, VB = 64 * VPI;
constexpr int OFF_K = 0, OFF_V = 3 * KB, OFF_BIAS = OFF_V + 3 * VB, OFF_SCR = OFF_BIAS + 4096 * 4, END = OFF_SCR + 8 * 256;
static_assert(END <= LDS_BYTES, "attention LDS");
}
DI float max3f(float a, float b, float c) { float r; asm("v_max3_f32 %0, %1, %2, %3" : "=v"(r) : "v"(a), "v"(b), "v"(c)); return r; }
DI float fadd_s(float a, float b) { float r; asm("v_add_f32_e32 %0, %1, %2" : "=v"(r) : "v"(a), "v"(b)); return r; }
DI float fsub_s(float a, float b) { float r; asm("v_sub_f32_e32 %0, %1, %2" : "=v"(r) : "v"(a), "v"(b)); return r; }
#define SBAR() __builtin_amdgcn_sched_barrier(0)
DI void fox_init(f32x16& n0, f32x16& n1, const LAS f32x4* bp, float m) {
#pragma unroll
    for (int g = 0; g < 4; ++g) { const f32x4 b0 = bp[2 * g], b1 = bp[2 * g + 8];
#pragma unroll
        for (int j = 0; j < 4; ++j) { n0[4 * g + j] = b0[j] - m; n1[4 * g + j] = b1[j] - m; }
        SBAR(); }
}
DI void fox_qk_plain(f32x16& n0, f32x16& n1, const LAS uchar* kb, const bf16x8 (&qf)[4]) {
#pragma unroll
    for (int kk = 0; kk < 4; ++kk) { n0 = mfma32(ldsv(kb + kk * 32), qf[kk], n0); n1 = mfma32(ldsv(kb + 32 * fox::KPI + kk * 32), qf[kk], n1); }
}
DI void fox_hot(f32x16& c0, f32x16& c1, f32x16& n0, f32x16& n1, f32x16& o0, f32x16& o1, float& l, float m,
                const LAS uchar* kb, const LAS uchar* vb, const LAS f32x4* bpn, const bf16x8 (&qf)[4], bf16x8 x0, bf16x8 x1, bf16x8 x2) {
    using namespace fox;
#define FOX_KF(i) ldsv(kb + ((i) & 1) * 32 * KPI + ((i) >> 1) * 32)
#define FOX_VFR(i) cat8(vtr(vb + (16 * ((i) >> 1)) * VPI + ((i) & 1) * 64), vtr(vb + (16 * ((i) >> 1) + 8) * VPI + ((i) & 1) * 64))
#define FOX_EX4(P, B) do { P[B] = ex2(P[B]); P[B + 1] = ex2(P[B + 1]); P[B + 2] = ex2(P[B + 2]); P[B + 3] = ex2(P[B + 3]); } while (0)
#define FOX_SUM4(P, B) do { sacc = fadd_s(sacc, P[B]); sacc = fadd_s(sacc, P[B + 1]); sacc = fadd_s(sacc, P[B + 2]); sacc = fadd_s(sacc, P[B + 3]); } while (0)
    fox_init(n0, n1, bpn, m);
    n0 = mfma32(x0, qf[0], n0); FOX_EX4(c0, 0);  x0 = FOX_KF(3); SBAR();
    n1 = mfma32(x1, qf[0], n1); FOX_EX4(c0, 4);  x1 = FOX_KF(4); SBAR();
    n0 = mfma32(x2, qf[1], n0); FOX_EX4(c0, 8);  x2 = FOX_KF(5); SBAR();
    n1 = mfma32(x0, qf[1], n1); FOX_EX4(c0, 12); x0 = FOX_KF(6); SBAR();
    n0 = mfma32(x1, qf[2], n0); FOX_EX4(c1, 0);  x1 = FOX_KF(7); SBAR();
    n1 = mfma32(x2, qf[2], n1); FOX_EX4(c1, 4);  x2 = FOX_VFR(0); SBAR();
    n0 = mfma32(x0, qf[3], n0); FOX_EX4(c1, 8);  x0 = FOX_VFR(1); SBAR();
    n1 = mfma32(x1, qf[3], n1); FOX_EX4(c1, 12); x1 = FOX_VFR(2); SBAR();
    float sacc = fadd_s(c0[0], c0[1]);
    bf16x8 a0 = pack8<0>(c0), a1; SBAR();
#define FOX_MOV4(DST, SRC, B) do { DST[B] = SRC[B]; DST[B + 1] = SRC[B + 1]; DST[B + 2] = SRC[B + 2]; DST[B + 3] = SRC[B + 3]; } while (0)
    o0 = mfma32(a0, x2, o0); sacc = fadd_s(sacc, c0[2]); sacc = fadd_s(sacc, c0[3]); FOX_SUM4(c0, 4); a1 = pack8<1>(c0); x2 = FOX_VFR(3); SBAR();
    o1 = mfma32(a0, x0, o1); FOX_SUM4(c0, 8); FOX_SUM4(c0, 12); x0 = FOX_VFR(4); SBAR();
    o0 = mfma32(a1, x1, o0); a0 = pack8<0>(c1); FOX_MOV4(c0, n0, 0); FOX_MOV4(c0, n0, 4); x1 = FOX_VFR(5); SBAR();
    o1 = mfma32(a1, x2, o1); FOX_SUM4(c1, 0); FOX_SUM4(c1, 4); FOX_MOV4(c0, n0, 8); x2 = FOX_VFR(6); SBAR();
    o0 = mfma32(a0, x0, o0); a1 = pack8<1>(c1); FOX_SUM4(c1, 8); FOX_MOV4(c0, n0, 12); x0 = FOX_VFR(7); SBAR();
    o1 = mfma32(a0, x1, o1); FOX_SUM4(c1, 12); FOX_MOV4(c1, n1, 0); FOX_MOV4(c1, n1, 4); SBAR();
    o0 = mfma32(a1, x2, o0); FOX_MOV4(c1, n1, 8); FOX_MOV4(c1, n1, 12); SBAR();
    o1 = mfma32(a1, x0, o1); SBAR();
#undef FOX_MOV4
    l += sacc;
#undef FOX_KF
#undef FOX_VFR
#undef FOX_EX4
#undef FOX_SUM4
}
struct FoxCtx { int nt, qlim, qlim_min, hh, r; bool active; const LAS uchar *kb0, *vb0; const LAS float* biasl; LAS float* scr; LAS uchar* lds; int kdst, vdst; const bf16 *ksrc, *vsrc; };
DI void fox_ring(const FoxCtx& X, int t, int bwr, u32x4& rk, u32x4& rv) {
    using namespace fox;
    *(LAS u32x4*)(X.lds + X.kdst + bwr * KB) = rk; *(LAS u32x4*)(X.lds + X.vdst + bwr * VB) = rv;
    __syncthreads();
    const int tl = t - 3 > 0 ? t - 3 : 0;
    rk = *(const u32x4*)(X.ksrc + (size_t)64 * tl * D); rv = *(const u32x4*)(X.vsrc + (size_t)64 * tl * D);
}
DI void fox_step(const FoxCtx& X, int s, int bcur, int bnext, int bwr, f32x16& c0, f32x16& c1, f32x16& n0, f32x16& n1, f32x16& o0, f32x16& o1, float& l, float& m,
                 const bf16x8 (&qf)[4], u32x4& rk, u32x4& rv) {
    using namespace fox;
    const int nt = X.nt, t = nt - 1 - s, hh = X.hh;
    {
        const bool vis = 64 * t <= X.qlim_min, visn = 64 * (t - 1) <= X.qlim_min;
        const LAS f32x4* bpn = (const LAS f32x4*)(X.biasl + 64 * (t - 1) + 4 * hh);
        if (vis) {
            const LAS uchar* kbn = X.kb0 + bnext * KB;
            const bf16x8 x0 = ldsv(kbn), x1 = ldsv(kbn + 32 * KPI), x2 = ldsv(kbn + 32);
            if (64 * t + 63 > X.qlim_min) {
#pragma unroll
                for (int i = 0; i < 16; ++i) { const int key = 64 * t + crow(i, hh); if (key > X.qlim) c0[i] = -INFINITY; if (key + 32 > X.qlim) c1[i] = -INFINITY; }
            }
            asm volatile("s_nop 15\n\ts_nop 7" : "+v"(c0), "+v"(c1));
            float mx = max3f(c0[0], c1[0], c0[1]), mx2 = max3f(c1[1], c0[2], c1[2]);
#pragma unroll
            for (int i = 3; i < 15; i += 2) { mx = max3f(mx, c0[i], c1[i]); mx2 = max3f(mx2, c0[i + 1], c1[i + 1]); }
            mx = max3f(mx, c0[15], c1[15]); mx = max3f(mx, mx2, mx2);
            { auto rr = __builtin_amdgcn_permlane32_swap(__float_as_uint(mx), __float_as_uint(mx), false, false); mx = max3f(__uint_as_float(rr[0]), __uint_as_float(rr[1]), __uint_as_float(rr[1])); }
            if (__builtin_expect(__any(mx > 16.f), 0)) {
                const float d = fmaxf(mx, 0.f), f = ex2(-d); m += d; l *= f;
#pragma unroll
                for (int i = 0; i < 16; ++i) { c0[i] -= d; c1[i] -= d; }
                if (hh == 0) X.scr[X.r] = f;
                asm volatile("s_waitcnt lgkmcnt(0)" ::: "memory");
#pragma unroll
                for (int g = 0; g < 4; ++g) { const f32x4 fv = *(const LAS f32x4*)(X.scr + 8 * g + 4 * hh);
#pragma unroll
                    for (int j = 0; j < 4; ++j) { o0[4 * g + j] *= fv[j]; o1[4 * g + j] *= fv[j]; } }
                asm volatile("s_waitcnt lgkmcnt(0)" ::: "memory");
            }
            fox_hot(c0, c1, n0, n1, o0, o1, l, m, kbn, X.vb0 + bcur * VB, bpn, qf, x0, x1, x2);
        } else if (visn) {
            fox_init(n0, n1, bpn, m); fox_qk_plain(n0, n1, X.kb0 + bnext * KB, qf); c0 = n0; c1 = n1;
        }
    }
    fox_ring(X, t, bwr, rk, rv);
}
DI void fox_unit(LAS uchar* lds, const bf16* Qg, const bf16* K2B, const bf16* V2B, bf16* Og, size_t qrow0, int nq, size_t krow0, int nt, int qlim0, int h, const float* biasg) {
    using namespace fox;
    int tid_ = threadIdx.x; asm volatile("" : "+v"(tid_));
    const int tid = tid_, lane = tid & 63, w = __builtin_amdgcn_readfirstlane(tid >> 6), r = lane & 31, hh = lane >> 5;
    const int q4 = (lane & 15) >> 2, p4 = lane & 3, blk = (lane >> 4) & 1;
    FoxCtx X;
    X.nt = nt; X.hh = hh; X.r = r; X.lds = lds;
    X.active = 32 * w < nq;
    __syncthreads();
    const bool bp0 = tid < nt * 16, bp1 = tid + NTHR < nt * 16;
    const f32x4 bias0 = bp0 ? ((const f32x4*)biasg)[tid] : (f32x4){0.f, 0.f, 0.f, 0.f}, bias1 = bp1 ? ((const f32x4*)biasg)[tid + NTHR] : (f32x4){0.f, 0.f, 0.f, 0.f};
    X.ksrc = K2B + (krow0 + (tid >> 3)) * D + h * 64 + (tid & 7) * 8;
    X.vsrc = V2B + (krow0 + (tid >> 3)) * D + h * 64 + (tid & 7) * 8;
    X.kdst = OFF_K + (tid >> 3) * KPI + (tid & 7) * 16; X.vdst = OFF_V + (tid >> 3) * VPI + (tid & 7) * 16;
    u32x4 rk = *(const u32x4*)(X.ksrc + (size_t)64 * (nt - 1) * D), rv = *(const u32x4*)(X.vsrc + (size_t)64 * (nt - 1) * D);
    u32x4 rk1 = rk, rv1 = rv;
    if (nt > 1) { rk1 = *(const u32x4*)(X.ksrc + (size_t)64 * (nt - 2) * D); rv1 = *(const u32x4*)(X.vsrc + (size_t)64 * (nt - 2) * D); }
    bf16x8 qf[4];
    {
        const bf16* qp = Qg + (qrow0 + (X.active ? 32 * w + r : 0)) * D + h * 64 + hh * 8;
#pragma unroll
        for (int kk = 0; kk < 4; ++kk) qf[kk] = *(const bf16x8*)(qp + kk * 16);
    }
    if (bp0) *(LAS f32x4*)(lds + OFF_BIAS + tid * 16) = bias0;
    if (bp1) *(LAS f32x4*)(lds + OFF_BIAS + (tid + NTHR) * 16) = bias1;
    *(LAS u32x4*)(lds + X.kdst) = rk; *(LAS u32x4*)(lds + X.vdst) = rv;
    *(LAS u32x4*)(lds + X.kdst + KB) = rk1; *(LAS u32x4*)(lds + X.vdst + VB) = rv1;
    { const int tl = nt > 2 ? nt - 3 : 0; rk = *(const u32x4*)(X.ksrc + (size_t)64 * tl * D); rv = *(const u32x4*)(X.vsrc + (size_t)64 * tl * D); }
    float l = 0.f; f32x16 o0, o1;
#pragma unroll
    for (int i = 0; i < 16; ++i) { o0[i] = 0.f; o1[i] = 0.f; }
    X.qlim = X.active ? qlim0 + 32 * w + r : 0; X.qlim_min = qlim0 + 32 * w;
    X.scr = (LAS float*)(lds + OFF_SCR + w * 256);
    X.kb0 = lds + OFF_K + r * KPI + hh * 16;
    X.vb0 = lds + OFF_V + (4 * hh + q4) * VPI + (16 * blk + 4 * p4) * 2;
    X.biasl = (const LAS float*)(lds + OFF_BIAS);
    __syncthreads();
    float m = X.biasl[X.qlim];
    f32x16 pa0, pa1, pb0, pb1;
#pragma unroll
    for (int i = 0; i < 16; ++i) { pa0[i] = 0.f; pa1[i] = 0.f; pb0[i] = 0.f; pb1[i] = 0.f; }
    if (X.active && 64 * (nt - 1) <= X.qlim_min) { fox_init(pa0, pa1, (const LAS f32x4*)(X.biasl + 64 * (nt - 1) + 4 * hh), m); fox_qk_plain(pa0, pa1, X.kb0, qf); }
    int b0 = 0, b1 = 1, b2 = 2;
    if (w >= 4) __builtin_amdgcn_s_setprio(1);
    if (X.active) {
#pragma unroll 1
        for (int s = 0; s < nt; ++s) {
            fox_step(X, s, b0, b1, b2, pa0, pa1, pb0, pb1, o0, o1, l, m, qf, rk, rv);
            { const int tb = b0; b0 = b1; b1 = b2; b2 = tb; }
        }
    } else {
#pragma unroll 1
        for (int s = 0; s < nt; ++s) { fox_ring(X, nt - 1 - s, b2, rk, rv); { const int tb = b0; b0 = b1; b1 = b2; b2 = tb; } }
    }
    __builtin_amdgcn_s_setprio(0);
    if (X.active) {
        l += __shfl_xor(l, 32);
        if (hh == 0) X.scr[32 + r] = l;
        asm volatile("s_waitcnt lgkmcnt(0)" ::: "memory");
        bf16* op = Og + (qrow0 + 32 * w) * D + h * 64 + r;
#pragma unroll
        for (int g = 0; g < 4; ++g) { const f32x4 lv = *(const LAS f32x4*)(X.scr + 32 + 8 * g + 4 * hh);
#pragma unroll
            for (int j = 0; j < 4; ++j) { const float inv = 1.0f / lv[j]; const int c = 8 * g + 4 * hh + j;
                op[(size_t)c * D] = (bf16)(pk(o0[4 * g + j] * inv, 0.f) & 0xffffu); op[(size_t)c * D + 32] = (bf16)(pk(o1[4 * g + j] * inv, 0.f) & 0xffffu); } }
    }
}

#define XB_TMO      128
#define XB_XCNT(j)  (256  + 64 * (j))
#define XB_XSUB(j)  (1280 + 64 * (j))
#define XB_XGEN(j)  (2304 + 64 * (j))
#define XB_TOP      3328
#define XB_TOPGEN   3392
#define XCD_BAR_WORDS 3456
#define XB_SPIN_CAP (1u << 18)

__device__ __forceinline__ unsigned xb_ld(unsigned* p)              { return __hip_atomic_load(p, __ATOMIC_RELAXED, __HIP_MEMORY_SCOPE_AGENT); }
__device__ __forceinline__ unsigned xb_add(unsigned* p, unsigned v) { return __hip_atomic_fetch_add(p, v, __ATOMIC_RELAXED, __HIP_MEMORY_SCOPE_AGENT); }
__device__ __forceinline__ unsigned xb_xcc_id() { return (unsigned)__builtin_amdgcn_s_getreg((3 << 11) | 20) & 0xFu; }
#define XB_SPIN(cond, bar) do { unsigned _sp = 0; while (cond) { __builtin_amdgcn_s_sleep(1); \
    if ((++_sp & 255u) == 0u) { if (xb_ld(&(bar)[XB_TMO])) break; if (_sp > XB_SPIN_CAP) { atomicAdd(&(bar)[XB_TMO], 1u); break; } } } } while (0)

struct XcdBarrier {
    unsigned* bar; unsigned x;
    volatile LAS unsigned* st;
};

__device__ __forceinline__ XcdBarrier xcd_barrier_post(unsigned* bar, volatile LAS unsigned* st) {
    XcdBarrier b; b.bar = bar; b.x = xb_xcc_id(); b.st = st;
    if (threadIdx.x == 0) (void)xb_add(&bar[XB_XCNT(b.x)], 1u);
    return b;
}
__device__ __forceinline__ void xcd_barrier_complete(unsigned* bar, unsigned x, unsigned& nloc, unsigned& nx) {
    const unsigned G = gridDim.x * gridDim.y * gridDim.z;
    unsigned sum, cnt, mine, sp = 0u;
    for (;;) {
        sum = 0u; cnt = 0u; mine = 0u;
#pragma unroll
        for (unsigned j = 0; j < 16; ++j) { const unsigned c = xb_ld(&bar[XB_XCNT(j)]); sum += c; cnt += (c > 0u) ? 1u : 0u; mine = (j == x) ? c : mine; }
        if (sum == G) break;
        __builtin_amdgcn_s_sleep(1);
        if ((++sp & 255u) == 0u) { if (xb_ld(&bar[XB_TMO])) break; if (sp > XB_SPIN_CAP) { atomicAdd(&bar[XB_TMO], 1u); break; } }
    }
    nloc = mine > 0u ? mine : 1u; nx = cnt > 0u ? cnt : 1u;
}

__device__ __forceinline__ void xcd_barrier(const XcdBarrier& b) {
    asm volatile("s_waitcnt vmcnt(0)" ::: "memory");
    __syncthreads();
    if (threadIdx.x == 0) {
        unsigned* bar = b.bar;
        __builtin_amdgcn_s_waitcnt(0);
        unsigned nloc = b.st[0], nx = b.st[1];
        if (nloc == 0u) { xcd_barrier_complete(bar, b.x, nloc, nx); b.st[0] = nloc; b.st[1] = nx; }
        const unsigned old = xb_add(&bar[XB_XSUB(b.x)], 1u);
        const unsigned gen = old / nloc;
        if (old + 1u == (gen + 1u) * nloc) {
            __builtin_amdgcn_fence(__ATOMIC_RELEASE, "agent");
            asm volatile("s_waitcnt vmcnt(0)" ::: "memory");
            const unsigned og = xb_add(&bar[XB_TOP], 1u);
            const unsigned tg = og / nx;
            if (og + 1u == (tg + 1u) * nx) xb_add(&bar[XB_TOPGEN], 1u);
            else XB_SPIN(xb_ld(&bar[XB_TOPGEN]) == tg, bar);
            __builtin_amdgcn_fence(__ATOMIC_ACQUIRE, "agent");
            xb_add(&bar[XB_XGEN(b.x)], 1u);
            asm volatile("s_waitcnt vmcnt(0)" ::: "memory");
        } else {
            XB_SPIN(xb_ld(&bar[XB_XGEN(b.x)]) == gen, bar);
            __builtin_amdgcn_fence(__ATOMIC_ACQUIRE, "agent");
            asm volatile("s_waitcnt vmcnt(0)" ::: "memory");
        }
    }
    __syncthreads();
}

constexpr int XB_WS_OFF = 65536, XB_LDS_OFF = LDS_BYTES - 64, CTL_ZERO_BYTES = 262144;

template <int ONLY> __global__ void __launch_bounds__(NTHR, 2) yoco_fwd_t(Params P) {
    extern __shared__ __attribute__((aligned(16))) unsigned char lds_raw[];
    LAS uchar* lds = (LAS uchar*)lds_raw;
    if (threadIdx.x < 16) ((LAS unsigned*)(lds + XB_LDS_OFF))[threadIdx.x] = 0u;
    __syncthreads();
    if (P.ph_hi - P.ph_lo > 1) (void)xcd_barrier_post((unsigned*)(P.ws + XB_WS_OFF), (volatile LAS unsigned*)(lds + XB_LDS_OFF));
    if (P.ph_lo == 0) {
        const int lane0 = threadIdx.x & 63, wave0 = threadIdx.x >> 6;
        rope_table(P.ws, blockIdx.x * NWAVES + wave0, gridDim.x * NWAVES, lane0);
    }
    for (int step = P.ph_lo; step < P.ph_hi; ++step) {
        const int ph = P.prog[step] & 0x7f; const bool nobar = (P.prog[step] & 0x80) != 0;
        int tid_ = threadIdx.x; asm volatile("" : "+v"(tid_));
        const int tid = tid_;
#define LWG() const int lane = tid & 63, wave = __builtin_amdgcn_readfirstlane(tid >> 6); const int gw = bx * NWAVES + wave, NGW = G * NWAVES; (void)lane; (void)gw; (void)NGW
        int G_ = gridDim.x, bx_ = blockIdx.x; asm volatile("" : "+s"(G_), "+s"(bx_));
        const int G = G_, bx = bx_;
        uchar* ws = P.ws; float* out = P.out; int zz = 0;
        asm volatile("" : "+s"(ws), "+s"(out), "+s"(zz));
#define PIN(i) (P.in[(i) + zz])
        float* H = out + O_Y; bf16* HB = (bf16*)(ws + WS_HB); float* ssq = (float*)(ws + WS_SSQ);
        bf16* HID = (bf16*)(ws + WS_R + R_HID);
        bf16* RQ = (bf16*)(out + O_KP); bf16* RK = RQ + (size_t)T * D;
        bf16* VO = (bf16*)(ws + WS_R + R_VO); bf16* GG = (bf16*)(ws + WS_R + R_G);
        bf16* QF = (bf16*)(ws + WS_R + R_QF); bf16* K2B = (bf16*)(ws + WS_R + R_K2B); bf16* V2B = (bf16*)(ws + WS_R + R_V2B);
        float* biasP = (float*)(ws + WS_BIASP); float* biasS = (float*)(ws + WS_BIASS);
        const float* rope = (const float*)(ws + WS_ROPE);
        int kind, f = 0;
        switch (ph) {
            case 0: kind = 0; break;          case 22: kind = 0; break;
            case 1: kind = 1; f = 0; break;   case 2: kind = 2; f = 0; break;
            case 3: kind = 3; break;          case 4: kind = 4; break;        case 5: kind = 5; break;
            case 6: kind = 2; f = 4; break;
            case 7: kind = 1; f = 1; break;   case 8: kind = 2; f = 1; break;
            case 9: kind = 1; f = 2; break;   case 10: kind = 7; break;
            case 11: kind = 1; f = 2; break;  case 12: kind = 2; f = 2; break;
            case 13: kind = 8; break;         case 14: kind = 9; break;
            case 15: kind = 2; f = 5; break;
            case 16: kind = 1; f = 3; break;  case 17: kind = 2; f = 3; break;
            case 20: kind = 11; break;
            case 19: kind = 2; f = 8; break;
            default: kind = 10; break;
        }
        if (KSEL(0) && kind == 0) {
            LWG();
            const int mode = ph == 22;
            const int nwg = (T / 256) * (D / 256), rounds = (nwg + G - 1) / G, nfull = nwg - (rounds - 1) * G, nidle = G - nfull;
            const bool remap = mode && nidle > 0;
            if (!remap || bx >= nfull) phase_prologue(P, ws, out, lds, remap ? (bx - nfull) * NWAVES + wave : gw, remap ? nidle * NWAVES : NGW, wave, lane, mode);
        } else if (KSEL(1) && kind == 1) {
            const int N = f == 2 ? 2 * FF + 2304 : 2 * FF;
            pg8::Gemm g{HB, (const bf16*)(ws + WS_WIN + win_slot(f) * SZ_WIN), T, N, D}; pg8::StaticOrder S; S.init(T, N, G, bx);
            rstd_prepass(lds, ssq, S, tid);
            const LAS _Float16* rl = (const LAS _Float16*)(lds + RL_OFF);
            pg8::EpiSwiKVF E{pg8::EpiSwiGLU{HID, rl}, pg8::EpiKVF{out, K2B, V2B, rl, PIN(18)}};
            pg8::gemm_phase<pg8::EpiSwiKVF, pg8::StaticOrder, true, true>(lds, g, S, E);
        } else if (KSEL(2) && kind == 2) {
            const bf16* A; const bf16* Bt; int K; float alpha;
            if (f == 8) { A = HID; Bt = (const bf16*)(ws + WS_WOUT); K = FF; alpha = 0.0f; }
            else if (f < 4) { A = HID; Bt = (const bf16*)(ws + WS_WOUT + f * SZ_WOUT); K = FF; alpha = 0.5f; }
            else if (f == 4) { A = VO; Bt = (const bf16*)(ws + WS_ROUT); K = 2048; alpha = 1.0f; }
            else { A = QF; Bt = (const bf16*)(ws + WS_WO); K = D; alpha = 1.0f; }
            pg8::Gemm g{A, Bt, T, D, K}; pg8::StaticOrder S; S.init(T, D, G, bx);
            pg8::EpiRes E{HB, ssq, alpha};
            pg8::gemm_phase<pg8::EpiRes, pg8::StaticOrder, true, true>(lds, g, S, E);
            if (f == 4 || f == 1) {
                const int nwg = (T / 256) * (D / 256), rounds = (nwg + G - 1) / G, nfull = nwg - (rounds - 1) * G;
                const int nidle = G - nfull;
                const int gt = nidle > 0 ? (bx - nfull) * NTHR + tid : bx * NTHR + tid, NGT = (nidle > 0 ? nidle : G) * NTHR;
                if (nidle == 0 || bx >= nfull) cache_convert(f == 4 ? PIN(3) : PIN(4), f == 4 ? K2B : V2B, gt, NGT);
            }
        } else if (KSEL(3) && kind == 3) {
            pg8::Gemm g{HB, (const bf16*)(ws + WS_RIN), T, 6144, D}; pg8::StaticOrder S; S.init(T, 6144, G, bx);
            rstd_prepass(lds, ssq, S, tid); pg8::EpiRetIn E{RQ, RK, VO, GG, (const LAS _Float16*)(lds + RL_OFF), rope};
            pg8::gemm_phase<pg8::EpiRetIn, pg8::StaticOrder, true, true>(lds, g, S, E);
        } else if (KSEL(4) && kind == 4) {
            for (int it = bx; it < 256 + 512; it += G) {
                const bool samp = it >= 256; const int q = samp ? it - 256 : it;
                const int sl = q & 3, h = (q >> 2) & 3, b = q >> 4;
                const float lg2 = h == 0 ? -0.04580368961312479f : h == 1 ? -0.02272007650008353f : h == 2 ? -0.011315313227834146f : -0.005646563141142063f;
                const size_t rowbase = samp ? (size_t)TP + (size_t)b * DSEQ : (size_t)b * SEQ;
                const float* S0 = samp ? PIN(2) + (size_t)(b * 4 + h) * 256 * 512 : nullptr;
                float* Sout = out + (samp ? O_SRS : O_SRP) + (size_t)(b * 4 + h) * 256 * 512;
                ret_item(lds, RQ, RK, VO, rowbase, h, sl, samp ? 1 : 64, S0, Sout, lg2);
            }
        } else if (KSEL(5) && kind == 5) {
            LWG();
            const float* gn = PIN(14); (void)gn;
            constexpr int NR = 4;
            for (int row0 = gw; row0 < T; row0 += NR * NGW) {
                u32x4 ov[NR][4], gv[NR][4];
#pragma unroll
                for (int u = 0; u < NR; ++u) { const int row = row0 + u * NGW < T ? row0 + u * NGW : row0;
                    const u32x4* op = (const u32x4*)(VO + (size_t)row * 2048 + lane * 32); const u32x4* gp = (const u32x4*)(GG + (size_t)row * 2048 + lane * 32);
#pragma unroll
                    for (int i = 0; i < 4; ++i) { ov[u][i] = op[i]; gv[u][i] = gp[i]; } }
#pragma unroll
                for (int u = 0; u < NR; ++u) {
                    const int row = row0 + u * NGW; if (row >= T) break;
                    float s = 0.f, s2 = 0.f;
#pragma unroll
                    for (int i = 0; i < 4; ++i)
#pragma unroll
                        for (int j = 0; j < 4; ++j) { const float a = bflo(ov[u][i][j]), bq = bfhi(ov[u][i][j]); s += a + bq; s2 += a * a + bq * bq; }
#pragma unroll
                    for (int o = 1; o < 16; o <<= 1) { s += __shfl_xor(s, o); s2 += __shfl_xor(s2, o); }
                    const float mu = s * (1.f / 512.f), var = fmaxf(s2 * (1.f / 512.f) - mu * mu, 0.f), rstd = __builtin_amdgcn_rsqf(var + EPS);
                    u32x4* op = (u32x4*)(VO + (size_t)row * 2048 + lane * 32);
#pragma unroll
                    for (int i = 0; i < 4; ++i) { u32x4 w;
#pragma unroll
                        for (int j = 0; j < 4; ++j) w[j] = pk((bflo(ov[u][i][j]) - mu) * rstd * bflo(gv[u][i][j]), (bfhi(ov[u][i][j]) - mu) * rstd * bfhi(gv[u][i][j]));
                        op[i] = w; }
                }
            }
        } else if (KSEL(7) && kind == 7) {
            LWG();
            for (int seq = bx; seq < 768; seq += G) {
                const bool samp = seq >= 256; const int ss = samp ? seq - 256 : seq; const int b_ = ss >> 4, h = ss & 15;
                const int L = samp ? KSAMP : SEQ, n = samp ? 3 : 8, s0 = tid * n;
                float* dst = samp ? biasS + (size_t)ss * KSAMP : biasP + (size_t)ss * SEQ;
                float v[8]; float sum = 0.f;
#pragma unroll
                for (int i = 0; i < 8; ++i) { const int s = s0 + i; float x = 0.f;
                    if (i < n && s < L) x = samp ? (s < PAST ? PIN(5)[((size_t)b_ * PAST + s) * 16 + h] : out[O_LFS + ((size_t)b_ * DSEQ + (s - PAST)) * 16 + h]) : out[O_LFP + ((size_t)b_ * SEQ + s) * 16 + h];
                    sum += x; v[i] = sum; }
                float inc = sum;
#pragma unroll
                for (int o = 1; o < 64; o <<= 1) { const float t = __shfl_up(inc, o); if (lane >= o) inc += t; }
                LAS float* wt = (LAS float*)lds;
                __syncthreads();
                if (lane == 63) wt[wave] = inc;
                __syncthreads();
                float base = inc - sum;
#pragma unroll
                for (int w2 = 0; w2 < 8; ++w2) if (w2 < wave) base += wt[w2];
#pragma unroll
                for (int i = 0; i < 8; ++i) { const int s = s0 + i; if (i < n && s < L) dst[s] = -(base + v[i]) * LOG2E; }
            }
        } else if (KSEL(8) && kind == 8) {
            pg8::Gemm g{HB, (const bf16*)(ws + WS_WQ), T, D, D}; pg8::StaticOrder S; S.init(T, D, G, bx);
            rstd_prepass(lds, ssq, S, tid); pg8::EpiQ E{QF, (const LAS _Float16*)(lds + RL_OFF)};
            pg8::gemm_phase<pg8::EpiQ, pg8::StaticOrder, true, true>(lds, g, S, E);
        } else if (KSEL(9) && kind == 9) {
            for (int u = bx; u < 4096 + 512; u += G) {
                const bool samp = u >= 4096; const int us = u - 4096;
                int bh = samp ? us : (u & 255), qb = 15 - (u >> 8);
                if (!samp && G == 256) {
                    const int k = u >> 8, xcd = bx & 7, idx = bx >> 3, g = idx >> 2, mem = idx & 3, rr = k >> 2, kk = k & 3;
                    bh = xcd * 32 + rr * 8 + g; qb = kk == 0 ? 15 - mem : kk == 1 ? 11 - mem : kk == 2 ? mem + 4 : mem;
                }
                const int b_ = bh >> 4, h = bh & 15;
                const size_t qrow0 = samp ? (size_t)TP + b_ * DSEQ : (size_t)b_ * SEQ + qb * 256;
                const size_t krow0 = samp ? (size_t)TP + (size_t)b_ * KSAMP : (size_t)b_ * SEQ;
                fox_unit(lds, QF, K2B, V2B, QF, qrow0, samp ? 64 : 256, krow0, samp ? 17 : 4 * (qb + 1), samp ? PAST : qb * 256, h,
                         samp ? biasS + (size_t)us * KSAMP : biasP + (size_t)bh * SEQ);
            }
        } else if (KSEL(10) && kind == 10) {
            LWG();
            const float* fg = PIN(21);
            constexpr int NR = 4;
            for (int row0 = gw; row0 < T; row0 += NR * NGW) {
                u32x2 hv[NR][4]; float rsv[NR];
#pragma unroll
                for (int u = 0; u < NR; ++u) { const int row = row0 + u * NGW < T ? row0 + u * NGW : row0; const u32x2* bp = (const u32x2*)(HB + (size_t)row * D);
#pragma unroll
                    for (int j = 0; j < 4; ++j) hv[u][j] = bp[lane + 64 * j];
                    rsv[u] = row_rstd(ssq, row); }
#pragma unroll
                for (int u = 0; u < NR; ++u) {
                    const int row = row0 + u * NGW; if (row >= T) break;
                    f32x4* hp = (f32x4*)(H + (size_t)row * D); const float rs = rsv[u];
#pragma unroll
                    for (int j = 0; j < 4; ++j) { const u32x2 x = hv[u][j]; const f32x4 v = {bflo(x[0]), bfhi(x[0]), bflo(x[1]), bfhi(x[1])}, gq = ((const f32x4*)fg)[lane + 64 * j]; __builtin_nontemporal_store(v * rs * gq, hp + lane + 64 * j); }
                }
            }
        }
        if (step + 1 < P.ph_hi && !nobar) { if (P.ph_lo < 0) cg::this_grid().sync(); else { XcdBarrier xb; xb.bar = (unsigned*)(ws + XB_WS_OFF); xb.x = xb_xcc_id(); xb.st = (volatile LAS unsigned*)(lds + XB_LDS_OFF); xcd_barrier(xb); } }
    }
}

#ifdef DIAG
template __global__ void yoco_fwd_t<0>(Params); template __global__ void yoco_fwd_t<1>(Params); template __global__ void yoco_fwd_t<2>(Params); template __global__ void yoco_fwd_t<3>(Params);
template __global__ void yoco_fwd_t<4>(Params); template __global__ void yoco_fwd_t<5>(Params); template __global__ void yoco_fwd_t<6>(Params); template __global__ void yoco_fwd_t<7>(Params);
template __global__ void yoco_fwd_t<8>(Params); template __global__ void yoco_fwd_t<9>(Params); template __global__ void yoco_fwd_t<10>(Params);
#endif
#define yoco_fwd yoco_fwd_t<-1>
#ifndef MK_ONE_LAUNCH
#define MK_ONE_LAUNCH 1
#endif
constexpr int N_PHASES = 19;
extern "C" void kernel_launch(void* const* d_in, const int* in_sizes, int n_in, void* d_out, int out_size, void* d_ws, size_t ws_size, hipStream_t stream) {
    static int grid = 0;
    if (grid == 0) {
        if (n_in != 22 || ws_size < WS_END) { fprintf(stderr, "kernel_launch: unexpected n_in %d / ws %zu\n", n_in, ws_size); grid = -1; return; }
        int dev = 0, cus = 0, per_cu = 0;
        hipGetDevice(&dev); hipDeviceGetAttribute(&cus, hipDeviceAttributeMultiprocessorCount, dev);
        if (hipFuncSetAttribute((const void*)yoco_fwd, hipFuncAttributeMaxDynamicSharedMemorySize, LDS_BYTES) != hipSuccess) { fprintf(stderr, "kernel_launch: hipFuncSetAttribute failed\n"); grid = -1; return; }
        if (hipOccupancyMaxActiveBlocksPerMultiprocessor(&per_cu, (const void*)yoco_fwd, NTHR, LDS_BYTES) != hipSuccess || per_cu < 1) { fprintf(stderr, "kernel_launch: occupancy query says %d\n", per_cu); per_cu = 1; }
        (void)hipGetLastError();
        grid = cus * 1;
    }
    if (grid < 0) return;
    Params p{};
    for (int i = 0; i < 22; ++i) p.in[i] = (const float*)d_in[i];
    p.out = (float*)d_out; p.ws = (unsigned char*)d_ws;
#ifndef MK_PROG
#define MK_PROG 0,1,2|0x80,22,3,4,5,6,7,8,9,10,12,13,14,15,16,17,18
#endif
    const unsigned char prog[] = {MK_PROG}; const int nprog = (int)sizeof(prog);
    for (int i = 0; i < nprog && i < 32; ++i) p.prog[i] = prog[i];
#if MK_ONE_LAUNCH
    if (hipMemsetAsync(d_ws, 0, CTL_ZERO_BYTES, stream) != hipSuccess) { fprintf(stderr, "kernel_launch: hipMemsetAsync failed\n"); return; }
    p.ph_lo = 0; p.ph_hi = nprog;
    void* args[] = {&p};
    hipError_t e = hipLaunchCooperativeKernel((const void*)yoco_fwd, dim3(grid), dim3(NTHR), args, LDS_BYTES, stream);
    if (e != hipSuccess) fprintf(stderr, "cooperative launch failed: %s (grid %d)\n", hipGetErrorString(e), grid);
#else
    for (int ph = 0; ph < nprog; ++ph) { p.ph_lo = ph; p.ph_hi = ph + 1; hipLaunchKernelGGL(yoco_fwd, dim3(grid), dim3(NTHR), LDS_BYTES, stream, p); }
#endif
}
```

```cpp
#include <hip/hip_runtime.h>
#include <cstdio>
#include <cstdint>
namespace pg8 {
#define PG8_LAS __attribute__((address_space(3)))
typedef unsigned short bf16_t;
typedef short bf16x8 __attribute__((ext_vector_type(8)));
typedef float f32x4 __attribute__((ext_vector_type(4)));
typedef unsigned u32x4 __attribute__((ext_vector_type(4)));
constexpr int BM = 256, BK = 64, HALF = 128, HTB = HALF * BK * 2  , STAGE_BYTES = 8 * HTB, NXCD = 8, WGM = 8;

__host__ __device__ __forceinline__ int lds_byte(int r, int c) { const int st = (r >> 4) * 2 + (c >> 5), rr = r & 15, cc = c & 31, ob = rr * 64 + cc * 2; return st * 1024 + (ob ^ (((ob >> 9) & 1) << 5)); }
__host__ __device__ __forceinline__ void stage_rc(int b, int& R, int& C) { const int st = b / 1024, sb = b % 1024, swz = sb ^ (((sb >> 9) & 1) << 5); R = (st >> 1) * 16 + swz / 64; C = (st & 1) * 32 + (swz % 64) / 2; }
__host__ __device__ __forceinline__ int perm32(int rho) { const int n = rho >> 4, i = rho & 15; return 8 * (i >> 2) + 4 * n + (i & 3); }

struct Unit { int pm, pn; };
struct Gemm { const bf16_t* A; const bf16_t* Bt; int M, N, K; };

struct StaticOrder {
    int nM, nN, nwg, G, c;
    __host__ __device__ void init(int M, int N, int G_, int c_) { nM = M / BM; nN = N / BM; nwg = nM * nN; G = G_; c = c_; }
    __host__ __device__ bool next(int i, Unit& u) const {
        const long L = (long)i * G + c; if (L >= nwg) return false;
        int wgid = (int)L; { const int q = nwg / NXCD, r = nwg % NXCD, xcd = wgid % NXCD, off = wgid / NXCD; wgid = (xcd < r ? xcd * (q + 1) : r * (q + 1) + (xcd - r) * q) + off; }
        const int nig = WGM * nN, gid = wgid / nig, fm = gid * WGM, gsz = (nM - fm) < WGM ? (nM - fm) : WGM;
        u.pm = fm + ((wgid % nig) % gsz); u.pn = (wgid % nig) / gsz; return true;
    }
    __device__ __forceinline__ void a_ready(const Unit&) const {}
    __device__ __forceinline__ void done(const Unit&) const {}
};

__device__ __forceinline__ unsigned cvt_pk_bf16(float lo, float hi) { unsigned r; asm volatile("v_cvt_pk_bf16_f32 %0, %1, %2" : "=v"(r) : "v"(lo), "v"(hi)); return r; }
typedef float f32x2 __attribute__((ext_vector_type(2)));
template <class Epi, class Sched, bool ALIGN_EPI = false, bool SP2 = false>
__device__ __forceinline__ void gemm_phase(PG8_LAS unsigned char* lds, const Gemm g, const Sched& S, const Epi& E) {
    int tid_ = threadIdx.x; asm volatile("" : "+v"(tid_));
    const int tid = tid_, wid = __builtin_amdgcn_readfirstlane(tid >> 6), lane = tid & 63, wr = wid >> 2, wc = wid & 3, fr = lane & 15, fq = lane >> 4;
    const int K = g.K, nt = K / BK;
    unsigned voffA[2], voffB[2];
#pragma unroll
    for (int i = 0; i < 2; ++i) { int R, C; stage_rc(tid * 16 + i * 8192, R, C); const int Rb = Epi::PERM ? ((R & ~31) + perm32(R & 31)) : R;
        voffA[i] = (unsigned)(R * K + C) * 2u; voffB[i] = (unsigned)(Rb * K + C) * 2u; }
    const size_t kstep = (size_t)(BK * 2);
    const size_t hstep = (size_t)HALF * K * 2;
    const size_t tstep = 2 * hstep;
    const unsigned ldsw = (unsigned)wid * 1024u;
    const int aoff = lds_byte(wr * 64 + fr, fq * 8), boff = lds_byte(wc * 32 + fr, fq * 8);
#define PG8_SA(b, h) (((b) * 2 + (h)) * HTB)
#define PG8_SB(b, h) ((4 + (b) * 2 + (h)) * HTB)
#define PG8_STAGE(bufoff, gbase, voff) do { _Pragma("unroll") for (int _i = 0; _i < 2; ++_i) \
        __builtin_amdgcn_global_load_lds((const unsigned*)((const char*)(gbase) + (voff)[_i]), (PG8_LAS unsigned*)(lds + (bufoff) + ldsw + _i * 8192), 16, 0, 0); } while (0)
#define PG8_LDA(dst, b, h) do { _Pragma("unroll") for (int m = 0; m < 4; ++m) _Pragma("unroll") for (int k = 0; k < 2; ++k) dst[m][k] = *(const PG8_LAS bf16x8*)(lds + PG8_SA(b, h) + aoff + m * 2048 + k * 1024); } while (0)
#define PG8_LDB(dst, b, h) do { _Pragma("unroll") for (int n = 0; n < 2; ++n) _Pragma("unroll") for (int k = 0; k < 2; ++k) dst[n][k] = *(const PG8_LAS bf16x8*)(lds + PG8_SB(b, h) + boff + n * 2048 + k * 1024); } while (0)
#define PG8_MMA(ai, bj, At, Bt) do { __builtin_amdgcn_s_setprio(1); _Pragma("unroll") for (int m = 0; m < 4; ++m) _Pragma("unroll") for (int n = 0; n < 2; ++n) _Pragma("unroll") for (int k = 0; k < 2; ++k) \
        acc[ai][bj][m][n] = __builtin_amdgcn_mfma_f32_16x16x32_bf16(Bt[n][k], At[m][k], acc[ai][bj][m][n], 0, 0, 0); __builtin_amdgcn_s_setprio(0); } while (0)
#define PG8_WAIT_V(n) asm volatile("s_waitcnt vmcnt(" #n ")" ::: "memory")
#define PG8_WAIT_L(n) asm volatile("s_waitcnt lgkmcnt(" #n ")" ::: "memory")
#define PG8_BAR __builtin_amdgcn_s_barrier()
#define PG8_SCHED __builtin_amdgcn_sched_barrier(0)
    Unit cur, nxt; int ui = 0;
    if (!S.next(0, cur)) return;
    f32x4 acc[2][2][4][2];
#pragma unroll
    for (int a = 0; a < 2; ++a)
#pragma unroll
        for (int b = 0; b < 2; ++b)
#pragma unroll
            for (int m = 0; m < 4; ++m)
#pragma unroll
                for (int n = 0; n < 2; ++n) acc[a][b][m][n] = (f32x4){0.f, 0.f, 0.f, 0.f};
    bf16x8 At[4][2], B0[2][2], B1[2][2];
    const char* cA = (const char*)g.A + (size_t)cur.pm * tstep; const char* cB = (const char*)g.Bt + (size_t)cur.pn * tstep;
    S.a_ready(cur);
    if constexpr (SP2) {
        PG8_STAGE(PG8_SB(0, 0), cB, voffB); PG8_STAGE(PG8_SB(0, 1), cB + hstep, voffB); PG8_STAGE(PG8_SA(0, 0), cA, voffA); PG8_STAGE(PG8_SA(0, 1), cA + hstep, voffA);
        if (wr == 1) PG8_BAR;
        PG8_WAIT_V(2); PG8_BAR;
        PG8_STAGE(PG8_SB(1, 0), cB + kstep, voffB); PG8_STAGE(PG8_SA(1, 0), cA + kstep, voffA); PG8_STAGE(PG8_SB(1, 1), cB + hstep + kstep, voffB);
        PG8_WAIT_V(6); PG8_BAR;
    } else {
        PG8_STAGE(PG8_SB(0, 0), cB, voffB); PG8_STAGE(PG8_SA(0, 0), cA, voffA); PG8_STAGE(PG8_SB(0, 1), cB + hstep, voffB); PG8_STAGE(PG8_SA(0, 1), cA + hstep, voffA);
        if (wr == 1) PG8_BAR;
        PG8_WAIT_V(4); PG8_BAR;
        PG8_STAGE(PG8_SB(1, 0), cB + kstep, voffB); PG8_STAGE(PG8_SA(1, 0), cA + kstep, voffA); PG8_STAGE(PG8_SB(1, 1), cB + hstep + kstep, voffB);
        PG8_WAIT_V(6); PG8_BAR;
    }
    for (;;) {
        const bool has_next = S.next(ui + 1, nxt);
        const char* nA = has_next ? (const char*)g.A + (size_t)nxt.pm * tstep : cA; const char* nB = has_next ? (const char*)g.Bt + (size_t)nxt.pn * tstep : cB;
        for (int t = 0; t < nt; t += 2) {
            const bool last = (t == nt - 2);
            const char* a1 = cA + (size_t)(t + 1) * kstep;
            const char* a2 = last ? nA : cA + (size_t)(t + 2) * kstep; const char* b2 = last ? nB : cB + (size_t)(t + 2) * kstep;
            const char* a3 = a2 + kstep; const char* b3 = b2 + kstep;
            if (last && has_next) S.a_ready(nxt);
            if constexpr (SP2) {
            PG8_LDB(B0, 0, 0); PG8_LDB(B1, 0, 1); PG8_SCHED; PG8_LDA(At, 0, 0); PG8_STAGE(PG8_SA(1, 1), a1 + hstep, voffA);
            PG8_WAIT_V(8); PG8_WAIT_L(0); PG8_BAR; PG8_MMA(0, 0, At, B0); PG8_MMA(0, 1, At, B1); PG8_BAR; PG8_SCHED;
            PG8_LDA(At, 0, 1); PG8_STAGE(PG8_SB(0, 0), b2, voffB); PG8_STAGE(PG8_SB(0, 1), b2 + hstep, voffB); PG8_STAGE(PG8_SA(0, 0), a2, voffA);
            PG8_WAIT_V(8); PG8_WAIT_L(0); PG8_BAR; PG8_MMA(1, 0, At, B0); PG8_MMA(1, 1, At, B1); PG8_BAR; PG8_SCHED;
            PG8_LDB(B0, 1, 0); PG8_LDB(B1, 1, 1); PG8_SCHED; PG8_LDA(At, 1, 0); PG8_STAGE(PG8_SA(0, 1), a2 + hstep, voffA);
            PG8_WAIT_V(8); PG8_WAIT_L(0); PG8_BAR; PG8_MMA(0, 0, At, B0); PG8_MMA(0, 1, At, B1); PG8_BAR; PG8_SCHED;
            PG8_LDA(At, 1, 1); PG8_STAGE(PG8_SB(1, 0), b3, voffB); PG8_STAGE(PG8_SB(1, 1), b3 + hstep, voffB); PG8_STAGE(PG8_SA(1, 0), a3, voffA);
            PG8_WAIT_V(8); PG8_WAIT_L(0); PG8_BAR; PG8_MMA(1, 0, At, B0); PG8_MMA(1, 1, At, B1); PG8_BAR; PG8_SCHED;
            } else {
            PG8_LDB(B0, 0, 0); PG8_SCHED; PG8_LDA(At, 0, 0); PG8_STAGE(PG8_SA(1, 1), a1 + hstep, voffA);
            PG8_WAIT_L(8); PG8_BAR; PG8_WAIT_L(0); PG8_MMA(0, 0, At, B0); PG8_BAR; PG8_SCHED;
            PG8_LDB(B1, 0, 1); PG8_STAGE(PG8_SB(0, 0), b2, voffB);
            PG8_BAR; PG8_WAIT_L(0); PG8_MMA(0, 1, At, B1); PG8_BAR;
            PG8_LDA(At, 0, 1); PG8_STAGE(PG8_SA(0, 0), a2, voffA);
            PG8_BAR; PG8_WAIT_L(0); PG8_MMA(1, 0, At, B0); PG8_BAR; PG8_SCHED;
            PG8_STAGE(PG8_SB(0, 1), b2 + hstep, voffB);
            PG8_WAIT_V(6); PG8_BAR; PG8_MMA(1, 1, At, B1); PG8_BAR;
            PG8_LDB(B0, 1, 0); PG8_SCHED; PG8_LDA(At, 1, 0); PG8_STAGE(PG8_SA(0, 1), a2 + hstep, voffA);
            PG8_WAIT_L(8); PG8_BAR; PG8_WAIT_L(0); PG8_MMA(0, 0, At, B0); PG8_BAR; PG8_SCHED;
            PG8_LDB(B1, 1, 1); PG8_STAGE(PG8_SB(1, 0), b3, voffB);
            PG8_BAR; PG8_WAIT_L(0); PG8_MMA(0, 1, At, B1); PG8_BAR;
            PG8_LDA(At, 1, 1); PG8_STAGE(PG8_SA(1, 0), a3, voffA);
            PG8_BAR; PG8_WAIT_L(0); PG8_MMA(1, 0, At, B0); PG8_BAR; PG8_SCHED;
            PG8_STAGE(PG8_SB(1, 1), b3 + hstep, voffB);
            PG8_WAIT_V(6); PG8_BAR; PG8_MMA(1, 1, At, B1); PG8_BAR;
            }
        }
        if constexpr (ALIGN_EPI) { if (wr == 0) PG8_BAR; }
        if constexpr (!Epi::AFTER_DRAIN) { E(acc, cur, wr, wc, fr, fq, ui); S.done(cur); }
        if (!has_next) break;
#pragma unroll
        for (int a = 0; a < 2; ++a)
#pragma unroll
            for (int b = 0; b < 2; ++b)
#pragma unroll
                for (int m = 0; m < 4; ++m)
#pragma unroll
                    for (int n = 0; n < 2; ++n) acc[a][b][m][n] = (f32x4){0.f, 0.f, 0.f, 0.f};
        cur = nxt; cA = nA; cB = nB; ++ui;
        if constexpr (ALIGN_EPI) { if (wr == 1) PG8_BAR; }
    }
    PG8_WAIT_V(0);
    if constexpr (!ALIGN_EPI) { if (wr == 0) PG8_BAR; }
    PG8_BAR;
    if constexpr (Epi::AFTER_DRAIN) { E.fused(acc, cur, wr, wc, fr, fq, lds, wid, lane); S.done(cur); }
#undef PG8_SA
#undef PG8_SB
#undef PG8_STAGE
#undef PG8_LDA
#undef PG8_LDB
#undef PG8_MMA
#undef PG8_WAIT_V
#undef PG8_WAIT_L
#undef PG8_BAR
#undef PG8_SCHED
}
}
static __device__ const double INVF[128] = {
  1.0, 0.930572040929699, 0.8659643233600653, 0.8058421877614819,
  0.7498942093324559, 0.6978305848598664, 0.6493816315762113, 0.6042963902381329,
  0.5623413251903491, 0.5232991146814947, 0.4869675251658631, 0.4531583637600818,
  0.4216965034285822, 0.3924189758484536, 0.3651741272548377, 0.33982083289425596,
  0.31622776601683794, 0.29427271762092816, 0.27384196342643613, 0.25482967479793467,
  0.23713737056616552, 0.220673406908459, 0.2053525026457146, 0.19109529749704404,
  0.1778279410038923, 0.16548170999431813, 0.1539926526059492, 0.14330125702369628,
  0.1333521432163324, 0.12409377607517195, 0.11547819846894582, 0.10746078283213174,
  0.1, 0.0930572040929699, 0.08659643233600653, 0.08058421877614819,
  0.07498942093324558, 0.06978305848598663, 0.06493816315762113, 0.060429639023813285,
  0.05623413251903491, 0.05232991146814947, 0.04869675251658631, 0.04531583637600818,
  0.042169650342858224, 0.03924189758484536, 0.03651741272548377, 0.03398208328942559,
  0.03162277660168379, 0.029427271762092817, 0.027384196342643614, 0.025482967479793464,
  0.023713737056616554, 0.0220673406908459, 0.02053525026457146, 0.019109529749704406,
  0.01778279410038923, 0.016548170999431813, 0.01539926526059492, 0.014330125702369627,
  0.01333521432163324, 0.012409377607517195, 0.011547819846894581, 0.010746078283213174,
  0.01, 0.00930572040929699, 0.008659643233600654, 0.008058421877614819,
  0.007498942093324558, 0.006978305848598663, 0.006493816315762113, 0.006042963902381328,
  0.005623413251903491, 0.005232991146814947, 0.004869675251658631, 0.004531583637600818,
  0.004216965034285823, 0.003924189758484536, 0.003651741272548377, 0.003398208328942559,
  0.0031622776601683794, 0.002942727176209282, 0.0027384196342643613, 0.0025482967479793467,
  0.0023713737056616554, 0.0022067340690845897, 0.002053525026457146, 0.0019109529749704406,
  0.0017782794100389228, 0.0016548170999431814, 0.001539926526059492, 0.0014330125702369627,
  0.001333521432163324, 0.0012409377607517195, 0.0011547819846894581, 0.0010746078283213176,
  0.001, 0.0009305720409296989, 0.0008659643233600654, 0.0008058421877614818,
  0.0007498942093324559, 0.0006978305848598664, 0.0006493816315762113, 0.0006042963902381329,
  0.0005623413251903491, 0.0005232991146814947, 0.0004869675251658631, 0.0004531583637600818,
  0.00042169650342858224, 0.0003924189758484536, 0.0003651741272548377, 0.00033982083289425596,
  0.00031622776601683794, 0.00029427271762092817, 0.0002738419634264361, 0.00025482967479793463,
  0.00023713737056616554, 0.00022067340690845897, 0.0002053525026457146, 0.00019109529749704405,
  0.00017782794100389227, 0.00016548170999431815, 0.0001539926526059492, 0.00014330125702369627,
  0.0001333521432163324, 0.00012409377607517196, 0.00011547819846894582, 0.00010746078283213175
};

#include <hip/hip_cooperative_groups.h>
namespace cg = cooperative_groups;
#define LAS __attribute__((address_space(3)))
#define DI __device__ __forceinline__
typedef unsigned short bf16;
typedef short bf16x8 __attribute__((ext_vector_type(8)));
typedef short s16x4 __attribute__((ext_vector_type(4)));
typedef short v4i16_t __attribute__((ext_vector_type(4)));
typedef float f32x4 __attribute__((ext_vector_type(4)));
typedef float f32x16 __attribute__((ext_vector_type(16)));
typedef unsigned u32x4 __attribute__((ext_vector_type(4)));
typedef unsigned u32x2 __attribute__((ext_vector_type(2)));
typedef float f32x2_t __attribute__((ext_vector_type(2)));
typedef __bf16 bf16x2_t __attribute__((ext_vector_type(2)));
typedef unsigned char uchar;

constexpr int NWAVES = 8, NTHR = 512;
constexpr int D = 1024, TP = 65536, TS = 2048, T = TP + TS, FF = 2816, SEQ = 4096, DSEQ = 64, PAST = 1024, KSAMP = PAST + DSEQ;
constexpr int NB_P = 16, NB_S = 32;
constexpr float EPS = 1e-6f;
constexpr float LOG2E = 1.4426950408889634f;
constexpr int LDS_BYTES = 159744;

constexpr size_t O_Y = 0, O_SRP = 69206016, O_KP = 77594624, O_VP = 144703488, O_LFP = 211812352, O_SRS = 212860928,
                 O_KS = 229638144, O_VS = 231735296, O_LFS = 233832448;
constexpr size_t SZ_WIN = (size_t)5632 * 1024 * 2, SZ_WOUT = (size_t)1024 * 2816 * 2, SZ_ACT = (size_t)T * 1024 * 2;
constexpr size_t WS_WIN = 1u << 20;
constexpr size_t WS_KVF = WS_WIN + 4 * SZ_WIN;
constexpr size_t WS_WOUT = WS_KVF + (size_t)2304 * 1024 * 2;
constexpr size_t WS_RIN = WS_WOUT + 4 * SZ_WOUT;
constexpr size_t WS_ROUT = WS_RIN + (size_t)6144 * 1024 * 2;
constexpr size_t WS_WQ = WS_ROUT + (size_t)1024 * 2048 * 2;
__host__ __device__ constexpr int win_slot(int f) { return f == 2 ? 3 : (f == 3 ? 2 : f); }
constexpr size_t WS_WO = WS_WQ + (size_t)1024 * 1024 * 2;
constexpr size_t WS_ROPE = WS_WO + (size_t)1024 * 1024 * 2;
constexpr size_t WS_SSQ = WS_ROPE + (size_t)4096 * 256 * 4;
constexpr size_t WS_BIASP = WS_SSQ + (size_t)T * 16 * 4;
constexpr size_t WS_BIASS = WS_BIASP + (size_t)256 * 4096 * 4;
constexpr size_t WS_HB = WS_BIASS + (size_t)512 * KSAMP * 4;
constexpr size_t WS_R = WS_HB + SZ_ACT;
constexpr size_t SZ_HID = (size_t)T * FF * 2, K2B_BYTES = (size_t)(TP + NB_S * KSAMP) * 1024 * 2;
constexpr size_t R_HID = 0, R_VO = 0, R_G = 2 * SZ_ACT, R_QF = 0, R_K2B = SZ_HID, R_V2B = R_K2B + K2B_BYTES;
constexpr size_t WS_END = WS_R + R_V2B + K2B_BYTES;
static_assert(R_G + 2 * SZ_ACT <= R_V2B + K2B_BYTES, "retention overlay");
static_assert(SZ_ACT <= SZ_HID && SZ_HID % 256 == 0, "qf overlay");
static_assert(WS_END <= (size_t)1073741824, "ws size");
static_assert(WS_HB % 256 == 0 && WS_R % 256 == 0 && WS_ROPE % 256 == 0 && WS_SSQ % 256 == 0, "align");

DI unsigned pk(float lo, float hi) { f32x2_t v = {lo, hi}; bf16x2_t b = __builtin_convertvector(v, bf16x2_t); return __builtin_bit_cast(unsigned, b); }
DI float bflo(unsigned w) { return __uint_as_float(w << 16); }
DI float bfhi(unsigned w) { return __uint_as_float(w & 0xffff0000u); }
DI float ex2(float x) { return __builtin_amdgcn_exp2f(x); }
DI float silu_f(float x) { return x * __builtin_amdgcn_rcpf(1.0f + __expf(-x)); }
DI float wave_sum(float v) {
#pragma unroll
    for (int o = 1; o < 64; o <<= 1) v += __shfl_xor(v, o);
    return v;
}
DI float row_rstd(const float* ssq, int row) {
    const f32x4* p = (const f32x4*)(ssq + (size_t)row * 16);
    const f32x4 a = p[0], b = p[1], c = p[2], d = p[3];
    const float s = (((a[0] + a[1]) + (a[2] + a[3])) + ((b[0] + b[1]) + (b[2] + b[3]))) + (((c[0] + c[1]) + (c[2] + c[3])) + ((d[0] + d[1]) + (d[2] + d[3])));
    return __builtin_amdgcn_rsqf(s * (1.0f / 1024.0f) + EPS);
}

namespace pg8 {
struct EpiSwiGLU {
    static constexpr bool PERM = true, AFTER_DRAIN = false;
    bf16_t* O; const LAS _Float16* rl;
    __device__ __forceinline__ void operator()(const f32x4 (&acc)[2][2][4][2], const Unit& u, int wr, int wc, int fr, int fq, int ui) const {
        const int row0 = u.pm * BM + wr * 64 + fr, col0 = u.pn * 128 + wc * 32 + 8 * fq;
        const LAS _Float16* rlu = rl + ui * 256 + wr * 64 + fr;
#pragma unroll
        for (int ai = 0; ai < 2; ++ai)
#pragma unroll
            for (int m = 0; m < 4; ++m) {
                const int row = row0 + ai * HALF + m * 16; const float rs = (float)rlu[ai * HALF + m * 16];
                u32x4 w;
#pragma unroll
                for (int n = 0; n < 2; ++n) {
                    const f32x4 g = acc[ai][0][m][n] * rs, up = acc[ai][1][m][n] * rs;
                    const float h0 = silu_f(g[0]) * up[0], h1 = silu_f(g[1]) * up[1], h2 = silu_f(g[2]) * up[2], h3 = silu_f(g[3]) * up[3];
                    w[2 * n] = pk(h0, h1); w[2 * n + 1] = pk(h2, h3);
                }
                *(u32x4*)(O + (size_t)row * FF + col0) = w;
            }
    }
};
struct EpiRes {
    static constexpr bool PERM = true, AFTER_DRAIN = false;
    bf16_t* HB; float* ssq; float alpha;
    __device__ __forceinline__ void operator()(const f32x4 (&acc)[2][2][4][2], const Unit& u, int wr, int wc, int fr, int fq, int ui) const {
        const int row0 = u.pm * BM + wr * 64 + fr, col0 = u.pn * BM + wc * 32 + 8 * fq;
#pragma unroll
        for (int ai = 0; ai < 2; ++ai) {
            asm volatile("" ::: "memory");
            u32x4 pre[4][2];
#pragma unroll
            for (int m = 0; m < 4; ++m)
#pragma unroll
                for (int bj = 0; bj < 2; ++bj) pre[m][bj] = *(const u32x4*)(HB + (size_t)(row0 + ai * HALF + m * 16) * D + col0 + bj * HALF);
#pragma unroll
            for (int m = 0; m < 4; ++m) {
                const int row = row0 + ai * HALF + m * 16; float s = 0.f;
#pragma unroll
                for (int bj = 0; bj < 2; ++bj) {
                    const u32x4 pv = pre[m][bj];
                    const f32x4 h0 = {bflo(pv[0]), bfhi(pv[0]), bflo(pv[1]), bfhi(pv[1])}, h1 = {bflo(pv[2]), bfhi(pv[2]), bflo(pv[3]), bfhi(pv[3])};
                    const f32x4 o0 = h0 + acc[ai][bj][m][0] * alpha, o1 = h1 + acc[ai][bj][m][1] * alpha;
                    u32x4 w; w[0] = pk(o0[0], o0[1]); w[1] = pk(o0[2], o0[3]); w[2] = pk(o1[0], o1[1]); w[3] = pk(o1[2], o1[3]);
                    *(u32x4*)(HB + (size_t)row * D + col0 + bj * HALF) = w;
                    s += (o0[0] * o0[0] + o0[1] * o0[1]) + (o0[2] * o0[2] + o0[3] * o0[3]) + (o1[0] * o1[0] + o1[1] * o1[1]) + (o1[2] * o1[2] + o1[3] * o1[3]);
                }
                s += __shfl_xor(s, 16); s += __shfl_xor(s, 32);
                if (fq == 0) ssq[(size_t)row * 16 + u.pn * 4 + wc] = s;
            }
        }
    }
};
struct EpiRetIn {
    static constexpr bool PERM = true, AFTER_DRAIN = false;
    bf16_t *Q, *K, *V, *G; const LAS _Float16* rl; const float* rope;
    __device__ __forceinline__ void operator()(const f32x4 (&acc)[2][2][4][2], const Unit& u, int wr, int wc, int fr, int fq, int ui) const {
        const int row0 = u.pm * BM + wr * 64 + fr, d0 = wc * 32 + 8 * fq;
        const int pn = u.pn;
        const LAS _Float16* rlu = rl + ui * 256 + wr * 64 + fr;
#pragma unroll
        for (int ai = 0; ai < 2; ++ai)
#pragma unroll
            for (int m = 0; m < 4; ++m) {
                if (pn < 8 && (m & 1) == 0) asm volatile("" ::: "memory");
                const int row = row0 + ai * HALF + m * 16; const float rs = (float)rlu[ai * HALF + m * 16];
                if (pn < 8) {
                    const int pos = row < TP ? (row & (SEQ - 1)) : PAST + ((row - TP) & (DSEQ - 1));
                    const float* cs = rope + (size_t)pos * 256 + d0;
                    const float sc = pn < 4 ? rs * 0.0625f : rs;
                    bf16_t* dst = (pn < 4 ? Q : K) + (size_t)row * D + (pn & 3) * 256 + d0;
                    u32x4 w1, w2;
#pragma unroll
                    for (int n = 0; n < 2; ++n) {
                        const f32x4 c = *(const f32x4*)(cs + 4 * n), s = *(const f32x4*)(cs + 128 + 4 * n);
                        const f32x4 x1 = acc[ai][0][m][n] * sc, x2 = acc[ai][1][m][n] * sc;
                        const f32x4 y1 = x1 * c - x2 * s, y2 = x1 * s + x2 * c;
                        w1[2 * n] = pk(y1[0], y1[1]); w1[2 * n + 1] = pk(y1[2], y1[3]);
                        w2[2 * n] = pk(y2[0], y2[1]); w2[2 * n + 1] = pk(y2[2], y2[3]);
                    }
                    *(u32x4*)dst = w1; *(u32x4*)(dst + 128) = w2;
                } else {
                    const bool isg = pn >= 16;
                    bf16_t* dst = (isg ? G : V) + (size_t)row * 2048 + ((pn - 8) & 7) * 256 + d0;
#pragma unroll
                    for (int bj = 0; bj < 2; ++bj) {
                        f32x4 a = acc[ai][bj][m][0] * rs, b = acc[ai][bj][m][1] * rs;
                        if (isg) { a = (f32x4){silu_f(a[0]), silu_f(a[1]), silu_f(a[2]), silu_f(a[3])}; b = (f32x4){silu_f(b[0]), silu_f(b[1]), silu_f(b[2]), silu_f(b[3])}; }
                        u32x4 w; w[0] = pk(a[0], a[1]); w[1] = pk(a[2], a[3]); w[2] = pk(b[0], b[1]); w[3] = pk(b[2], b[3]);
                        *(u32x4*)(dst + bj * HALF) = w;
                    }
                }
            }
    }
};
struct EpiKVF {
    static constexpr bool PERM = true, AFTER_DRAIN = false;
    float* out; bf16_t *K2B, *V2B; const LAS _Float16* rl; const float* bf;
    __device__ __forceinline__ void operator()(const f32x4 (&acc)[2][2][4][2], const Unit& u, int wr, int wc, int fr, int fq, int ui) const {
        const int row0 = u.pm * BM + wr * 64 + fr, d0 = wc * 32 + 8 * fq;
        const int pn = u.pn; const bool samp = u.pm >= TP / BM;
        const LAS _Float16* rlu = rl + ui * 256 + wr * 64 + fr;
        if (pn < 8) {
            const bool isv = pn >= 4;
            float* fbase = out + (samp ? (isv ? O_VS : O_KS) - (size_t)TP * D : (isv ? O_VP : O_KP)) + (pn & 3) * 256 + d0;
            bf16_t* bbase = (isv ? V2B : K2B) + (pn & 3) * 256 + d0;
#pragma unroll
            for (int ai = 0; ai < 2; ++ai)
#pragma unroll
                for (int m = 0; m < 4; ++m) {
                    const int row = row0 + ai * HALF + m * 16; const float rs = (float)rlu[ai * HALF + m * 16];
                    const int brow = row + (samp ? (((row - TP) >> 6) + 1) * 1024 : 0);
                    float* fo = fbase + (size_t)row * D; bf16_t* bo = bbase + (size_t)brow * D;
#pragma unroll
                    for (int bj = 0; bj < 2; ++bj) {
                        const f32x4 a = acc[ai][bj][m][0] * rs, b = acc[ai][bj][m][1] * rs;
                        __builtin_nontemporal_store(a, (f32x4*)(fo + bj * HALF)); __builtin_nontemporal_store(b, (f32x4*)(fo + bj * HALF + 4));
                        u32x4 w; w[0] = pk(a[0], a[1]); w[1] = pk(a[2], a[3]); w[2] = pk(b[0], b[1]); w[3] = pk(b[2], b[3]);
                        *(u32x4*)(bo + bj * HALF) = w;
                    }
                }
        } else if (wc == 0 && fq < 2) {
            float* lbase = out + (samp ? O_LFS - (size_t)TP * 16 : O_LFP) + 8 * fq;
            const f32x4 bb0 = *(const f32x4*)(bf + 8 * fq), bb1 = *(const f32x4*)(bf + 8 * fq + 4);
#pragma unroll
            for (int ai = 0; ai < 2; ++ai)
#pragma unroll
                for (int m = 0; m < 4; ++m) {
                    const int row = row0 + ai * HALF + m * 16; const float rs = (float)rlu[ai * HALF + m * 16];
                    float* lo = lbase + (size_t)row * 16;
#pragma unroll
                    for (int n = 0; n < 2; ++n) {
                        const f32x4 x = acc[ai][0][m][n] * rs + (n ? bb1 : bb0); f32x4 y;
#pragma unroll
                        for (int j = 0; j < 4; ++j) y[j] = fminf(x[j], 0.f) - __logf(1.0f + __expf(-fabsf(x[j])));
                        *(f32x4*)(lo + 4 * n) = y;
                    }
                }
        }
    }
};
struct EpiSwiKVF {
    static constexpr bool PERM = true, AFTER_DRAIN = false;
    EpiSwiGLU swi; EpiKVF kvf;
    __device__ __forceinline__ void operator()(const f32x4 (&acc)[2][2][4][2], const Unit& u, int wr, int wc, int fr, int fq, int ui) const {
        if (u.pn < 22) swi(acc, u, wr, wc, fr, fq, ui);
        else { Unit u2; u2.pm = u.pm; u2.pn = u.pn - 22; kvf(acc, u2, wr, wc, fr, fq, ui); }
    }
};
struct EpiQ {
    static constexpr bool PERM = true, AFTER_DRAIN = false;
    bf16_t* O; const LAS _Float16* rl;
    __device__ __forceinline__ void operator()(const f32x4 (&acc)[2][2][4][2], const Unit& u, int wr, int wc, int fr, int fq, int ui) const {
        const int row0 = u.pm * BM + wr * 64 + fr, col0 = u.pn * BM + wc * 32 + 8 * fq;
        const LAS _Float16* rlu = rl + ui * 256 + wr * 64 + fr;
#pragma unroll
        for (int ai = 0; ai < 2; ++ai)
#pragma unroll
            for (int m = 0; m < 4; ++m) {
                const int row = row0 + ai * HALF + m * 16; const float rs = (float)rlu[ai * HALF + m * 16] * (0.125f * LOG2E);
#pragma unroll
                for (int bj = 0; bj < 2; ++bj) {
                    const f32x4 a = acc[ai][bj][m][0] * rs, b = acc[ai][bj][m][1] * rs;
                    u32x4 w; w[0] = pk(a[0], a[1]); w[1] = pk(a[2], a[3]); w[2] = pk(b[0], b[1]); w[3] = pk(b[2], b[3]);
                    *(u32x4*)(O + (size_t)row * D + col0 + bj * HALF) = w;
                }
            }
    }
};
}

DI void tr_item(const float* W, int K, int N, bf16* WT, int drow0, const float* g, LAS float* scr, int k0, int n0, int lane) {
    const int n = n0 + 4 * (lane & 7);
    f32x4 v[8];
#pragma unroll
    for (int i = 0; i < 8; ++i) { const int kk = 8 * i + (lane >> 3); v[i] = (n < N) ? __builtin_nontemporal_load((const f32x4*)(W + (size_t)(k0 + kk) * N + n)) : (f32x4){0.f, 0.f, 0.f, 0.f}; }
#pragma unroll
    for (int i = 0; i < 8; ++i) { const int kk = 8 * i + (lane >> 3); const float gs = g ? g[k0 + kk] : 1.0f; LAS float* d = scr + kk * 33 + 4 * (lane & 7);
        d[0] = v[i][0] * gs; d[1] = v[i][1] * gs; d[2] = v[i][2] * gs; d[3] = v[i][3] * gs; }
    asm volatile("s_waitcnt lgkmcnt(0)" ::: "memory");
    const int c = lane & 7;
#pragma unroll
    for (int j = 0; j < 4; ++j) { const int nn = (lane >> 3) + 8 * j; const LAS float* s = scr + (8 * c) * 33 + nn;
        u32x4 o; o[0] = pk(s[0 * 33], s[1 * 33]); o[1] = pk(s[2 * 33], s[3 * 33]); o[2] = pk(s[4 * 33], s[5 * 33]); o[3] = pk(s[6 * 33], s[7 * 33]);
        *(u32x4*)(WT + (size_t)(drow0 + nn) * K + k0 + 8 * c) = o; }
    asm volatile("s_waitcnt lgkmcnt(0)" ::: "memory");
}
DI bool tr_matrix(int& r, const float* W, int K, int N, int nblk, bf16* WT, const float* g, int mode, LAS float* scr, int lane) {
    const int items = (K / 64) * nblk;
    if (r >= items) { r -= items; return false; }
    const int kb = r / nblk, nb = r % nblk, n0 = 32 * nb;
    int drow0 = n0;
    if (mode == 1) { const int bj = n0 / FF, rem = n0 % FF; drow0 = 256 * (rem / 128) + 128 * bj + (rem % 128); }
    tr_item(W, K, N, WT, drow0, g, scr, 64 * kb, n0, lane);
    return true;
}
DI void sincos_d(double x, float& s, float& c) {
    const double n = __builtin_rint(x * 0.63661977236758134308);
    double r = __builtin_fma(-n, 1.57079632679489655800e+00, x); r = __builtin_fma(-n, 6.12323399573676603587e-17, r);
    const double r2 = r * r;
    double sp = -1.0 / 1307674368000.0; sp = sp * r2 + 1.0 / 6227020800.0; sp = sp * r2 - 1.0 / 39916800.0; sp = sp * r2 + 1.0 / 362880.0; sp = sp * r2 - 1.0 / 5040.0; sp = sp * r2 + 1.0 / 120.0; sp = sp * r2 - 1.0 / 6.0; sp = sp * r2 * r + r;
    double cp = 1.0 / 20922789888000.0; cp = cp * r2 - 1.0 / 87178291200.0; cp = cp * r2 + 1.0 / 479001600.0; cp = cp * r2 - 1.0 / 3628800.0; cp = cp * r2 + 1.0 / 40320.0; cp = cp * r2 - 1.0 / 720.0; cp = cp * r2 + 1.0 / 24.0; cp = cp * r2 - 0.5; cp = cp * r2 + 1.0;
    const int q = ((int)n) & 3;
    const double ss = (q == 0) ? sp : (q == 1) ? cp : (q == 2) ? -sp : -cp;
    const double cc = (q == 0) ? cp : (q == 1) ? -sp : (q == 2) ? -cp : sp;
    s = (float)ss; c = (float)cc;
}

DI void cache_convert(const float* src0, bf16* dst, int gt, int NGT) {
    constexpr int NPIECE = NB_S * PAST * D / 8;
    for (int p0 = gt; p0 < NPIECE; p0 += 4 * NGT) {
        f32x4 a[4], bq[4];
#pragma unroll
        for (int u = 0; u < 4; ++u) { const int q = p0 + u * NGT < NPIECE ? p0 + u * NGT : p0;
            const float* src = src0 + (size_t)(q >> 7) * D + (q & 127) * 8; a[u] = __builtin_nontemporal_load((const f32x4*)src); bq[u] = __builtin_nontemporal_load((const f32x4*)(src + 4)); }
#pragma unroll
        for (int u = 0; u < 4; ++u) { const int q = p0 + u * NGT; if (q >= NPIECE) break;
            const int row = q >> 7, c8 = q & 127; const int b_ = row >> 10, s = row & 1023;
            u32x4 w; w[0] = pk(a[u][0], a[u][1]); w[1] = pk(a[u][2], a[u][3]); w[2] = pk(bq[u][0], bq[u][1]); w[3] = pk(bq[u][2], bq[u][3]);
            *(u32x4*)(dst + ((size_t)TP + (size_t)b_ * KSAMP + s) * D + c8 * 8) = w; }
    }
}
constexpr int RL_OFF = 131072;
static_assert(RL_OFF + 32 * 512 <= LDS_BYTES - 64, "rstd table (fp16, up to 32 units per block)");
DI void rstd_prepass(LAS uchar* lds, const float* ssq, const pg8::StaticOrder& S, int tid) {
    LAS _Float16* rl = (LAS _Float16*)(lds + RL_OFF);
    pg8::Unit u; int nun = 0;
    while (nun < 32 && S.next(nun, u)) ++nun;
#pragma unroll 4
    for (int e = tid; e < nun * 256; e += NTHR) { S.next(e >> 8, u); rl[e] = (_Float16)row_rstd(ssq, u.pm * 256 + (e & 255)); }
    __syncthreads();
}
#define KSEL(k) (ONLY < 0 || ONLY == (k))
struct Params { const float* in[22]; float* out; unsigned char* ws; int ph_lo, ph_hi; unsigned char prog[32]; };

DI void phase_prologue(const Params& P, uchar* ws, float* out, LAS uchar* lds, int gw, int NGW, int wave, int lane, int mode) {
    LAS float* scr = (LAS float*)(lds + wave * 16384);
    constexpr int I_IN = 16 * 176, I_OUT = 44 * 32;
    constexpr int NITEMS = 4 * I_IN + 4 * I_OUT + 16 * 192 + 32 * 32 + 16 * 72 + 2 * 16 * 32, NEARLY = I_IN + I_OUT;
    const int count = mode ? NITEMS - NEARLY : NEARLY;
    for (int e = gw; e < count; e += NGW) {
        const int it = mode ? (e < 3 * I_IN ? I_IN + e : 4 * I_IN + I_OUT + (e - 3 * I_IN)) : (e < I_IN ? e : 4 * I_IN + (e - I_IN));
        int r = it; bool done = false;
#pragma unroll
        for (int f = 0; f < 4; ++f) {
            if (done) break;
            const int l = f >> 1; const bool second = f & 1;
            done = tr_matrix(r, P.in[second ? 11 : 7] + (size_t)l * 1024 * 5632, 1024, 5632, 176, (bf16*)(ws + WS_WIN + win_slot(f) * SZ_WIN), P.in[second ? 10 : 6] + l * 1024, 1, scr, lane);
        }
#pragma unroll
        for (int f = 0; f < 4; ++f) {
            if (done) break;
            const int l = f >> 1; const bool second = f & 1;
            done = tr_matrix(r, P.in[second ? 12 : 8] + (size_t)l * 2816 * 1024, 2816, 1024, 32, (bf16*)(ws + WS_WOUT + f * SZ_WOUT), nullptr, 0, scr, lane);
        }
        if (!done) done = tr_matrix(r, P.in[13], 1024, 6144, 192, (bf16*)(ws + WS_RIN), P.in[9], 0, scr, lane);
        if (!done) done = tr_matrix(r, P.in[15], 2048, 1024, 32, (bf16*)(ws + WS_ROUT), P.in[14], 0, scr, lane);
        if (!done) done = tr_matrix(r, P.in[17], 1024, 2064, 72, (bf16*)(ws + WS_KVF), P.in[16], 0, scr, lane);
        if (!done) done = tr_matrix(r, P.in[19], 1024, 1024, 32, (bf16*)(ws + WS_WQ), P.in[9] + 1024, 0, scr, lane);
        if (!done) done = tr_matrix(r, P.in[20], 1024, 1024, 32, (bf16*)(ws + WS_WO), nullptr, 0, scr, lane);
    }
    if (mode == 0) {
        bf16* HB = (bf16*)(ws + WS_HB); float* ssq = (float*)(ws + WS_SSQ);
        constexpr int NR = 8;
        for (int m0 = gw; m0 < T; m0 += NR * NGW) {
            f32x4 v[NR][4];
#pragma unroll
            for (int u = 0; u < NR; ++u) { const int m = m0 + u * NGW < T ? m0 + u * NGW : m0;
                const float* src = m < TP ? P.in[0] + (size_t)m * D : P.in[1] + (size_t)(m - TP) * D;
#pragma unroll
                for (int j = 0; j < 4; ++j) v[u][j] = __builtin_nontemporal_load((const f32x4*)src + lane + 64 * j); }
#pragma unroll
            for (int u = 0; u < NR; ++u) {
                const int m = m0 + u * NGW; if (m >= T) break;
                float s = 0.f;
#pragma unroll
                for (int j = 0; j < 4; ++j) s += (v[u][j][0] * v[u][j][0] + v[u][j][1] * v[u][j][1]) + (v[u][j][2] * v[u][j][2] + v[u][j][3] * v[u][j][3]);
                s = wave_sum(s);
#pragma unroll
                for (int j = 0; j < 4; ++j) { u32x2 w; w[0] = pk(v[u][j][0], v[u][j][1]); w[1] = pk(v[u][j][2], v[u][j][3]); ((u32x2*)(HB + (size_t)m * D))[lane + 64 * j] = w; }
                if (lane < 16) ssq[(size_t)m * 16 + lane] = lane == 0 ? s : 0.f;
            }
        }
    }
}

DI void rope_table(uchar* ws, int gw, int NGW, int lane) {
    {
        const int gt = gw * 64 + lane, NGT = NGW * 64; float* rope = (float*)(ws + WS_ROPE);
        for (int e = gt; e < 4096 * 128; e += NGT) { const int pos = e >> 7, j = e & 127; float s, c; sincos_d((double)pos * INVF[j], s, c); rope[(size_t)pos * 256 + j] = c; rope[(size_t)pos * 256 + 128 + j] = s; }
    }
}

DI f32x16 mfma32(bf16x8 a, bf16x8 b, f32x16 c) { return __builtin_amdgcn_mfma_f32_32x32x16_bf16(a, b, c, 0, 0, 0); }
DI int crow(int i, int hh) { return (i & 3) + 8 * (i >> 2) + 4 * hh; }
DI s16x4 vtr(const LAS uchar* p) { return __builtin_bit_cast(s16x4, __builtin_amdgcn_ds_read_tr16_b64_v4i16((LAS v4i16_t*)p)); }
DI bf16x8 cat8(s16x4 lo, s16x4 hi) { return __builtin_shufflevector(lo, hi, 0, 1, 2, 3, 4, 5, 6, 7); }
DI bf16x8 ldsv(const LAS uchar* p) { return *(const LAS bf16x8*)p; }
template <int S> DI bf16x8 pack8(const f32x16& x) { u32x4 p; p[0] = pk(x[8 * S], x[8 * S + 1]); p[1] = pk(x[8 * S + 2], x[8 * S + 3]); p[2] = pk(x[8 * S + 4], x[8 * S + 5]); p[3] = pk(x[8 * S + 6], x[8 * S + 7]); return __builtin_bit_cast(bf16x8, p); }
DI s16x4 scale4(s16x4 v, float f0, float f1, float f2, float f3) {
    const u32x2 w = __builtin_bit_cast(u32x2, v); u32x2 o;
    o[0] = pk(bflo(w[0]) * f0, bfhi(w[0]) * f1); o[1] = pk(bflo(w[1]) * f2, bfhi(w[1]) * f3);
    return __builtin_bit_cast(s16x4, o);
}
namespace ret {
constexpr int QP = 528, KP = 528, VP = 320, SP = 528;
constexpr int OFF_Q = 0, OFF_K = 64 * QP, OFF_V = OFF_K + 64 * KP, OFF_ST = OFF_V + 64 * VP, END = OFF_ST + 128 * SP;
static_assert(END <= LDS_BYTES, "retention LDS");
}
DI void ret_item(LAS uchar* lds, const bf16* Qg, const bf16* Kg, bf16* Vg, size_t rowbase, int h, int sl, int nch, const float* S0, float* Sout, float lg2) {
    using namespace ret;
    int tid_ = threadIdx.x; asm volatile("" : "+v"(tid_));
    const int tid = tid_, lane = tid & 63, w = __builtin_amdgcn_readfirstlane(tid >> 6), r = lane & 31, hh = lane >> 5;
    const int ci = w >> 2, ei = w & 3, dq = w >> 1, eh = w & 1;
    const int q4 = (lane & 15) >> 2, p4 = lane & 3, blk = (lane >> 4) & 1;
    f32x16 S[2][2];
    if (S0) {
#pragma unroll
        for (int ti = 0; ti < 2; ++ti)
#pragma unroll
            for (int tj = 0; tj < 2; ++tj)
#pragma unroll
                for (int i = 0; i < 16; ++i) S[ti][tj][i] = S0[(size_t)(64 * dq + 32 * ti + crow(i, hh)) * 512 + 128 * sl + 64 * eh + 32 * tj + r];
    } else {
#pragma unroll
        for (int ti = 0; ti < 2; ++ti)
#pragma unroll
            for (int tj = 0; tj < 2; ++tj)
#pragma unroll
                for (int i = 0; i < 16; ++i) S[ti][tj][i] = 0.f;
    }
    const float g64 = ex2(lg2 * 64.f);
    const bf16* qsrc = Qg + (rowbase + (tid >> 5)) * D + h * 256 + (tid & 31) * 8;
    const bf16* ksrc = Kg + (rowbase + (tid >> 5)) * D + h * 256 + (tid & 31) * 8;
    bf16* vsrc = Vg + (rowbase + (tid >> 4)) * 2048 + h * 512 + sl * 128 + (tid & 15) * 8;
    const int qdst = (tid >> 5) * QP + (tid & 31) * 16, vdst = (tid >> 4) * VP + (tid & 15) * 16;
    const float lg2_inv = lg2;
#pragma unroll 1
    for (int n = 0; n < nch; ++n) {
        float lg2 = lg2_inv; asm volatile("" : "+v"(lg2));
        u32x4 rq[4], rk[4], rv[2];
        {
            const size_t adv = (size_t)64 * n;
#pragma unroll
            for (int i = 0; i < 4; ++i) { rq[i] = *(const u32x4*)(qsrc + (adv + 16 * i) * D); rk[i] = *(const u32x4*)(ksrc + (adv + 16 * i) * D); }
#pragma unroll
            for (int i = 0; i < 2; ++i) rv[i] = *(const u32x4*)(vsrc + (adv + 32 * i) * 2048);
        }
        __syncthreads();
#pragma unroll
        for (int i = 0; i < 4; ++i) { *(LAS u32x4*)(lds + OFF_Q + qdst + 16 * i * QP) = rq[i]; *(LAS u32x4*)(lds + OFF_K + qdst + 16 * i * KP) = rk[i]; }
        asm volatile("" ::: "memory");
#pragma unroll
        for (int i = 0; i < 2; ++i) {
            const float f = ex2(lg2 * (float)(63 - 32 * i - (tid >> 4))); u32x4 w;
#pragma unroll
            for (int j = 0; j < 4; ++j) w[j] = pk(bflo(rv[i][j]) * f, bfhi(rv[i][j]) * f);
            *(LAS u32x4*)(lds + OFF_V + vdst + 32 * i * VP) = w;
        }
        asm volatile("" ::: "memory");
#pragma unroll
        for (int ti = 0; ti < 2; ++ti)
#pragma unroll
            for (int tj = 0; tj < 2; ++tj)
#pragma unroll
                for (int g = 0; g < 4; ++g) { u32x2 v; v[0] = pk(S[ti][tj][4 * g], S[ti][tj][4 * g + 1]); v[1] = pk(S[ti][tj][4 * g + 2], S[ti][tj][4 * g + 3]);
                    *(LAS u32x2*)(lds + OFF_ST + (64 * eh + 32 * tj + r) * SP + (64 * dq + 32 * ti + 8 * g + 4 * hh) * 2) = v; }
        __syncthreads();
        f32x16 sc0, sc1;
#pragma unroll
        for (int i = 0; i < 16; ++i) { sc0[i] = 0.f; sc1[i] = 0.f; }
        const LAS uchar* qrow = lds + OFF_Q + (32 * ci + r) * QP + hh * 16;
        {
            const LAS uchar* krow = lds + OFF_K + r * KP + hh * 16;
#pragma unroll
            for (int kk = 0; kk < 16; ++kk) { const bf16x8 qf = ldsv(qrow + kk * 32); sc0 = mfma32(ldsv(krow + kk * 32), qf, sc0); sc1 = mfma32(ldsv(krow + 32 * KP + kk * 32), qf, sc1);
                if ((kk & 3) == 3) asm volatile("" ::: "memory"); }
        }
        {
            const float a0 = (float)(32 * ci + r - 4 * hh), a1 = a0 - 32.f;
#pragma unroll
            for (int i = 0; i < 16; ++i) { const float cc = (float)((i & 3) + 8 * (i >> 2)); const float sm = cc + (float)(4 * hh - 63);
                sc0[i] *= ex2(lg2 * (fabsf(a0 - cc) + sm)); sc1[i] *= ex2(lg2 * (fabsf(a1 - cc) + sm + 32.f)); }
        }
        f32x16 o;
#pragma unroll
        for (int i = 0; i < 16; ++i) o[i] = 0.f;
        {
            const LAS uchar* vb = lds + OFF_V + (4 * hh + q4) * VP + (32 * ei + 16 * blk + 4 * p4) * 2;
            o = mfma32(pack8<0>(sc0), cat8(vtr(vb), vtr(vb + 8 * VP)), o);
            o = mfma32(pack8<1>(sc0), cat8(vtr(vb + 16 * VP), vtr(vb + 24 * VP)), o);
            o = mfma32(pack8<0>(sc1), cat8(vtr(vb + 32 * VP), vtr(vb + 40 * VP)), o);
            o = mfma32(pack8<1>(sc1), cat8(vtr(vb + 48 * VP), vtr(vb + 56 * VP)), o);
        }
        f32x16 o2;
#pragma unroll
        for (int i = 0; i < 16; ++i) o2[i] = 0.f;
        {
            const LAS uchar* strow = lds + OFF_ST + (32 * ei + r) * SP + hh * 16;
#pragma unroll
            for (int kk = 0; kk < 16; ++kk) { o2 = mfma32(ldsv(qrow + kk * 32), ldsv(strow + kk * 32), o2); if ((kk & 3) == 3) asm volatile("" ::: "memory"); }
        }
        {
            bf16* op = Vg + (rowbase + (size_t)64 * n + 32 * ci) * 2048 + h * 512 + sl * 128 + 32 * ei + r;
#pragma unroll
            for (int i = 0; i < 16; ++i) { const int c = crow(i, hh); const float val = o[i] + o2[i] * ex2(lg2 * (float)(32 * ci + c + 1));
                op[(size_t)c * 2048] = (bf16)(pk(val, 0.f) & 0xffffu); }
        }
        asm volatile("" ::: "memory");
#pragma unroll
        for (int ti = 0; ti < 2; ++ti)
#pragma unroll
            for (int tj = 0; tj < 2; ++tj) S[ti][tj] = S[ti][tj] * g64;
        {
            const LAS uchar* ka = lds + OFF_K + (8 * hh + q4) * KP + (64 * dq + 16 * blk + 4 * p4) * 2;
            const LAS uchar* va = lds + OFF_V + (8 * hh + q4) * VP + (64 * eh + 16 * blk + 4 * p4) * 2;
#pragma unroll
            for (int kk = 0; kk < 4; ++kk) {
                bf16x8 A[2], B[2];
#pragma unroll
                for (int ti = 0; ti < 2; ++ti) A[ti] = cat8(vtr(ka + kk * 16 * KP + ti * 64), vtr(ka + kk * 16 * KP + 4 * KP + ti * 64));
#pragma unroll
                for (int tj = 0; tj < 2; ++tj) B[tj] = cat8(vtr(va + kk * 16 * VP + tj * 64), vtr(va + kk * 16 * VP + 4 * VP + tj * 64));
#pragma unroll
                for (int ti = 0; ti < 2; ++ti)
#pragma unroll
                    for (int tj = 0; tj < 2; ++tj) S[ti][tj] = mfma32(A[ti], B[tj], S[ti][tj]);
                asm volatile("" ::: "memory");
            }
        }
    }
#pragma unroll
    for (int ti = 0; ti < 2; ++ti)
#pragma unroll
        for (int tj = 0; tj < 2; ++tj)
#pragma unroll
            for (int i = 0; i < 16; ++i) __builtin_nontemporal_store(S[ti][tj][i], Sout + (size_t)(64 * dq + 32 * ti + crow(i, hh)) * 512 + 128 * sl + 64 * eh + 32 * tj + r);
    __syncthreads();
}

namespace fox {
constexpr int KPI = 144, VPI = 192, KB = 64 * KPI, VB = 64 * VPI;
constexpr int OFF_K = 0, OFF_V = 3 * KB, OFF_BIAS = OFF_V + 3 * VB, OFF_SCR = OFF_BIAS + 4096 * 4, END = OFF_SCR + 8 * 256;
static_assert(END <= LDS_BYTES, "attention LDS");
}
DI float max3f(float a, float b, float c) { float r; asm("v_max3_f32 %0, %1, %2, %3" : "=v"(r) : "v"(a), "v"(b), "v"(c)); return r; }
DI float fadd_s(float a, float b) { float r; asm("v_add_f32_e32 %0, %1, %2" : "=v"(r) : "v"(a), "v"(b)); return r; }
DI float fsub_s(float a, float b) { float r; asm("v_sub_f32_e32 %0, %1, %2" : "=v"(r) : "v"(a), "v"(b)); return r; }
#define SBAR() __builtin_amdgcn_sched_barrier(0)
DI void fox_init(f32x16& n0, f32x16& n1, const LAS f32x4* bp, float m) {
#pragma unroll
    for (int g = 0; g < 4; ++g) { const f32x4 b0 = bp[2 * g], b1 = bp[2 * g + 8];
#pragma unroll
        for (int j = 0; j < 4; ++j) { n0[4 * g + j] = b0[j] - m; n1[4 * g + j] = b1[j] - m; }
        SBAR(); }
}
DI void fox_qk_plain(f32x16& n0, f32x16& n1, const LAS uchar* kb, const bf16x8 (&qf)[4]) {
#pragma unroll
    for (int kk = 0; kk < 4; ++kk) { n0 = mfma32(ldsv(kb + kk * 32), qf[kk], n0); n1 = mfma32(ldsv(kb + 32 * fox::KPI + kk * 32), qf[kk], n1); }
}
DI void fox_hot(f32x16& c0, f32x16& c1, f32x16& n0, f32x16& n1, f32x16& o0, f32x16& o1, float& l, float m,
                const LAS uchar* kb, const LAS uchar* vb, const LAS f32x4* bpn, const bf16x8 (&qf)[4], bf16x8 x0, bf16x8 x1, bf16x8 x2) {
    using namespace fox;
#define FOX_KF(i) ldsv(kb + ((i) & 1) * 32 * KPI + ((i) >> 1) * 32)
#define FOX_VFR(i) cat8(vtr(vb + (16 * ((i) >> 1)) * VPI + ((i) & 1) * 64), vtr(vb + (16 * ((i) >> 1) + 8) * VPI + ((i) & 1) * 64))
#define FOX_EX4(P, B) do { P[B] = ex2(P[B]); P[B + 1] = ex2(P[B + 1]); P[B + 2] = ex2(P[B + 2]); P[B + 3] = ex2(P[B + 3]); } while (0)
#define FOX_SUM4(P, B) do { sacc = fadd_s(sacc, P[B]); sacc = fadd_s(sacc, P[B + 1]); sacc = fadd_s(sacc, P[B + 2]); sacc = fadd_s(sacc, P[B + 3]); } while (0)
    fox_init(n0, n1, bpn, m);
    n0 = mfma32(x0, qf[0], n0); FOX_EX4(c0, 0);  x0 = FOX_KF(3); SBAR();
    n1 = mfma32(x1, qf[0], n1); FOX_EX4(c0, 4);  x1 = FOX_KF(4); SBAR();
    n0 = mfma32(x2, qf[1], n0); FOX_EX4(c0, 8);  x2 = FOX_KF(5); SBAR();
    n1 = mfma32(x0, qf[1], n1); FOX_EX4(c0, 12); x0 = FOX_KF(6); SBAR();
    n0 = mfma32(x1, qf[2], n0); FOX_EX4(c1, 0);  x1 = FOX_KF(7); SBAR();
    n1 = mfma32(x2, qf[2], n1); FOX_EX4(c1, 4);  x2 = FOX_VFR(0); SBAR();
    n0 = mfma32(x0, qf[3], n0); FOX_EX4(c1, 8);  x0 = FOX_VFR(1); SBAR();
    n1 = mfma32(x1, qf[3], n1); FOX_EX4(c1, 12); x1 = FOX_VFR(2); SBAR();
    float sacc = fadd_s(c0[0], c0[1]);
    bf16x8 a0 = pack8<0>(c0), a1; SBAR();
#define FOX_MOV4(DST, SRC, B) do { DST[B] = SRC[B]; DST[B + 1] = SRC[B + 1]; DST[B + 2] = SRC[B + 2]; DST[B + 3] = SRC[B + 3]; } while (0)
    o0 = mfma32(a0, x2, o0); sacc = fadd_s(sacc, c0[2]); sacc = fadd_s(sacc, c0[3]); FOX_SUM4(c0, 4); a1 = pack8<1>(c0); x2 = FOX_VFR(3); SBAR();
    o1 = mfma32(a0, x0, o1); FOX_SUM4(c0, 8); FOX_SUM4(c0, 12); x0 = FOX_VFR(4); SBAR();
    o0 = mfma32(a1, x1, o0); a0 = pack8<0>(c1); FOX_MOV4(c0, n0, 0); FOX_MOV4(c0, n0, 4); x1 = FOX_VFR(5); SBAR();
    o1 = mfma32(a1, x2, o1); FOX_SUM4(c1, 0); FOX_SUM4(c1, 4); FOX_MOV4(c0, n0, 8); x2 = FOX_VFR(6); SBAR();
    o0 = mfma32(a0, x0, o0); a1 = pack8<1>(c1); FOX_SUM4(c1, 8); FOX_MOV4(c0, n0, 12); x0 = FOX_VFR(7); SBAR();
    o1 = mfma32(a0, x1, o1); FOX_SUM4(c1, 12); FOX_MOV4(c1, n1, 0); FOX_MOV4(c1, n1, 4); SBAR();
    o0 = mfma32(a1, x2, o0); FOX_MOV4(c1, n1, 8); FOX_MOV4(c1, n1, 12); SBAR();
    o1 = mfma32(a1, x0, o1); SBAR();
#undef FOX_MOV4
    l += sacc;
#undef FOX_KF
#undef FOX_VFR
#undef FOX_EX4
#undef FOX_SUM4
}
struct FoxCtx { int nt, qlim, qlim_min, hh, r; bool active; const LAS uchar *kb0, *vb0; const LAS float* biasl; LAS float* scr; LAS uchar* lds; int kdst, vdst; const bf16 *ksrc, *vsrc; };
DI void fox_ring(const FoxCtx& X, int t, int bwr, u32x4& rk, u32x4& rv) {
    using namespace fox;
    *(LAS u32x4*)(X.lds + X.kdst + bwr * KB) = rk; *(LAS u32x4*)(X.lds + X.vdst + bwr * VB) = rv;
    __syncthreads();
    const int tl = t - 3 > 0 ? t - 3 : 0;
    rk = *(const u32x4*)(X.ksrc + (size_t)64 * tl * D); rv = *(const u32x4*)(X.vsrc + (size_t)64 * tl * D);
}
DI void fox_step(const FoxCtx& X, int s, int bcur, int bnext, int bwr, f32x16& c0, f32x16& c1, f32x16& n0, f32x16& n1, f32x16& o0, f32x16& o1, float& l, float& m,
                 const bf16x8 (&qf)[4], u32x4& rk, u32x4& rv) {
    using namespace fox;
    const int nt = X.nt, t = nt - 1 - s, hh = X.hh;
    {
        const bool vis = 64 * t <= X.qlim_min, visn = 64 * (t - 1) <= X.qlim_min;
        const LAS f32x4* bpn = (const LAS f32x4*)(X.biasl + 64 * (t - 1) + 4 * hh);
        if (vis) {
            const LAS uchar* kbn = X.kb0 + bnext * KB;
            const bf16x8 x0 = ldsv(kbn), x1 = ldsv(kbn + 32 * KPI), x2 = ldsv(kbn + 32);
            if (64 * t + 63 > X.qlim_min) {
#pragma unroll
                for (int i = 0; i < 16; ++i) { const int key = 64 * t + crow(i, hh); if (key > X.qlim) c0[i] = -INFINITY; if (key + 32 > X.qlim) c1[i] = -INFINITY; }
            }
            asm volatile("s_nop 15\n\ts_nop 7" : "+v"(c0), "+v"(c1));
            float mx = max3f(c0[0], c1[0], c0[1]), mx2 = max3f(c1[1], c0[2], c1[2]);
#pragma unroll
            for (int i = 3; i < 15; i += 2) { mx = max3f(mx, c0[i], c1[i]); mx2 = max3f(mx2, c0[i + 1], c1[i + 1]); }
            mx = max3f(mx, c0[15], c1[15]); mx = max3f(mx, mx2, mx2);
            { auto rr = __builtin_amdgcn_permlane32_swap(__float_as_uint(mx), __float_as_uint(mx), false, false); mx = max3f(__uint_as_float(rr[0]), __uint_as_float(rr[1]), __uint_as_float(rr[1])); }
            if (__builtin_expect(__any(mx > 16.f), 0)) {
                const float d = fmaxf(mx, 0.f), f = ex2(-d); m += d; l *= f;
#pragma unroll
                for (int i = 0; i < 16; ++i) { c0[i] -= d; c1[i] -= d; }
                if (hh == 0) X.scr[X.r] = f;
                asm volatile("s_waitcnt lgkmcnt(0)" ::: "memory");
#pragma unroll
                for (int g = 0; g < 4; ++g) { const f32x4 fv = *(const LAS f32x4*)(X.scr + 8 * g + 4 * hh);
#pragma unroll
                    for (int j = 0; j < 4; ++j) { o0[4 * g + j] *= fv[j]; o1[4 * g + j] *= fv[j]; } }
                asm volatile("s_waitcnt lgkmcnt(0)" ::: "memory");
            }
            fox_hot(c0, c1, n0, n1, o0, o1, l, m, kbn, X.vb0 + bcur * VB, bpn, qf, x0, x1, x2);
        } else if (visn) {
            fox_init(n0, n1, bpn, m); fox_qk_plain(n0, n1, X.kb0 + bnext * KB, qf); c0 = n0; c1 = n1;
        }
    }
    fox_ring(X, t, bwr, rk, rv);
}
DI void fox_unit(LAS uchar* lds, const bf16* Qg, const bf16* K2B, const bf16* V2B, bf16* Og, size_t qrow0, int nq, size_t krow0, int nt, int qlim0, int h, const float* biasg) {
    using namespace fox;
    int tid_ = threadIdx.x; asm volatile("" : "+v"(tid_));
    const int tid = tid_, lane = tid & 63, w = __builtin_amdgcn_readfirstlane(tid >> 6), r = lane & 31, hh = lane >> 5;
    const int q4 = (lane & 15) >> 2, p4 = lane & 3, blk = (lane >> 4) & 1;
    FoxCtx X;
    X.nt = nt; X.hh = hh; X.r = r; X.lds = lds;
    X.active = 32 * w < nq;
    __syncthreads();
    const bool bp0 = tid < nt * 16, bp1 = tid + NTHR < nt * 16;
    const f32x4 bias0 = bp0 ? ((const f32x4*)biasg)[tid] : (f32x4){0.f, 0.f, 0.f, 0.f}, bias1 = bp1 ? ((const f32x4*)biasg)[tid + NTHR] : (f32x4){0.f, 0.f, 0.f, 0.f};
    X.ksrc = K2B + (krow0 + (tid >> 3)) * D + h * 64 + (tid & 7) * 8;
    X.vsrc = V2B + (krow0 + (tid >> 3)) * D + h * 64 + (tid & 7) * 8;
    X.kdst = OFF_K + (tid >> 3) * KPI + (tid & 7) * 16; X.vdst = OFF_V + (tid >> 3) * VPI + (tid & 7) * 16;
    u32x4 rk = *(const u32x4*)(X.ksrc + (size_t)64 * (nt - 1) * D), rv = *(const u32x4*)(X.vsrc + (size_t)64 * (nt - 1) * D);
    u32x4 rk1 = rk, rv1 = rv;
    if (nt > 1) { rk1 = *(const u32x4*)(X.ksrc + (size_t)64 * (nt - 2) * D); rv1 = *(const u32x4*)(X.vsrc + (size_t)64 * (nt - 2) * D); }
    bf16x8 qf[4];
    {
        const bf16* qp = Qg + (qrow0 + (X.active ? 32 * w + r : 0)) * D + h * 64 + hh * 8;
#pragma unroll
        for (int kk = 0; kk < 4; ++kk) qf[kk] = *(const bf16x8*)(qp + kk * 16);
    }
    if (bp0) *(LAS f32x4*)(lds + OFF_BIAS + tid * 16) = bias0;
    if (bp1) *(LAS f32x4*)(lds + OFF_BIAS + (tid + NTHR) * 16) = bias1;
    *(LAS u32x4*)(lds + X.kdst) = rk; *(LAS u32x4*)(lds + X.vdst) = rv;
    *(LAS u32x4*)(lds + X.kdst + KB) = rk1; *(LAS u32x4*)(lds + X.vdst + VB) = rv1;
    { const int tl = nt > 2 ? nt - 3 : 0; rk = *(const u32x4*)(X.ksrc + (size_t)64 * tl * D); rv = *(const u32x4*)(X.vsrc + (size_t)64 * tl * D); }
    float l = 0.f; f32x16 o0, o1;
#pragma unroll
    for (int i = 0; i < 16; ++i) { o0[i] = 0.f; o1[i] = 0.f; }
    X.qlim = X.active ? qlim0 + 32 * w + r : 0; X.qlim_min = qlim0 + 32 * w;
    X.scr = (LAS float*)(lds + OFF_SCR + w * 256);
    X.kb0 = lds + OFF_K + r * KPI + hh * 16;
    X.vb0 = lds + OFF_V + (4 * hh + q4) * VPI + (16 * blk + 4 * p4) * 2;
    X.biasl = (const LAS float*)(lds + OFF_BIAS);
    __syncthreads();
    float m = X.biasl[X.qlim];
    f32x16 pa0, pa1, pb0, pb1;
#pragma unroll
    for (int i = 0; i < 16; ++i) { pa0[i] = 0.f; pa1[i] = 0.f; pb0[i] = 0.f; pb1[i] = 0.f; }
    if (X.active && 64 * (nt - 1) <= X.qlim_min) { fox_init(pa0, pa1, (const LAS f32x4*)(X.biasl + 64 * (nt - 1) + 4 * hh), m); fox_qk_plain(pa0, pa1, X.kb0, qf); }
    int b0 = 0, b1 = 1, b2 = 2;
    if (w >= 4) __builtin_amdgcn_s_setprio(1);
    if (X.active) {
#pragma unroll 1
        for (int s = 0; s < nt; ++s) {
            fox_step(X, s, b0, b1, b2, pa0, pa1, pb0, pb1, o0, o1, l, m, qf, rk, rv);
            { const int tb = b0; b0 = b1; b1 = b2; b2 = tb; }
        }
    } else {
#pragma unroll 1
        for (int s = 0; s < nt; ++s) { fox_ring(X, nt - 1 - s, b2, rk, rv); { const int tb = b0; b0 = b1; b1 = b2; b2 = tb; } }
    }
    __builtin_amdgcn_s_setprio(0);
    if (X.active) {
        l += __shfl_xor(l, 32);
        if (hh == 0) X.scr[32 + r] = l;
        asm volatile("s_waitcnt lgkmcnt(0)" ::: "memory");
        bf16* op = Og + (qrow0 + 32 * w) * D + h * 64 + r;
#pragma unroll
        for (int g = 0; g < 4; ++g) { const f32x4 lv = *(const LAS f32x4*)(X.scr + 32 + 8 * g + 4 * hh);
#pragma unroll
            for (int j = 0; j < 4; ++j) { const float inv = 1.0f / lv[j]; const int c = 8 * g + 4 * hh + j;
                op[(size_t)c * D] = (bf16)(pk(o0[4 * g + j] * inv, 0.f) & 0xffffu); op[(size_t)c * D + 32] = (bf16)(pk(o1[4 * g + j] * inv, 0.f) & 0xffffu); } }
    }
}

#define XB_TMO      128
#define XB_XCNT(j)  (256  + 64 * (j))
#define XB_XSUB(j)  (1280 + 64 * (j))
#define XB_XGEN(j)  (2304 + 64 * (j))
#define XB_TOP      3328
#define XB_TOPGEN   3392
#define XCD_BAR_WORDS 3456
#define XB_SPIN_CAP (1u << 18)

__device__ __forceinline__ unsigned xb_ld(unsigned* p)              { return __hip_atomic_load(p, __ATOMIC_RELAXED, __HIP_MEMORY_SCOPE_AGENT); }
__device__ __forceinline__ unsigned xb_add(unsigned* p, unsigned v) { return __hip_atomic_fetch_add(p, v, __ATOMIC_RELAXED, __HIP_MEMORY_SCOPE_AGENT); }
__device__ __forceinline__ unsigned xb_xcc_id() { return (unsigned)__builtin_amdgcn_s_getreg((3 << 11) | 20) & 0xFu; }
#define XB_SPIN(cond, bar) do { unsigned _sp = 0; while (cond) { __builtin_amdgcn_s_sleep(1); \
    if ((++_sp & 255u) == 0u) { if (xb_ld(&(bar)[XB_TMO])) break; if (_sp > XB_SPIN_CAP) { atomicAdd(&(bar)[XB_TMO], 1u); break; } } } } while (0)

struct XcdBarrier {
    unsigned* bar; unsigned x;
    volatile LAS unsigned* st;
};

__device__ __forceinline__ XcdBarrier xcd_barrier_post(unsigned* bar, volatile LAS unsigned* st) {
    XcdBarrier b; b.bar = bar; b.x = xb_xcc_id(); b.st = st;
    if (threadIdx.x == 0) (void)xb_add(&bar[XB_XCNT(b.x)], 1u);
    return b;
}
__device__ __forceinline__ void xcd_barrier_complete(unsigned* bar, unsigned x, unsigned& nloc, unsigned& nx) {
    const unsigned G = gridDim.x * gridDim.y * gridDim.z;
    unsigned sum, cnt, mine, sp = 0u;
    for (;;) {
        sum = 0u; cnt = 0u; mine = 0u;
#pragma unroll
        for (unsigned j = 0; j < 16; ++j) { const unsigned c = xb_ld(&bar[XB_XCNT(j)]); sum += c; cnt += (c > 0u) ? 1u : 0u; mine = (j == x) ? c : mine; }
        if (sum == G) break;
        __builtin_amdgcn_s_sleep(1);
        if ((++sp & 255u) == 0u) { if (xb_ld(&bar[XB_TMO])) break; if (sp > XB_SPIN_CAP) { atomicAdd(&bar[XB_TMO], 1u); break; } }
    }
    nloc = mine > 0u ? mine : 1u; nx = cnt > 0u ? cnt : 1u;
}

__device__ __forceinline__ void xcd_barrier(const XcdBarrier& b) {
    asm volatile("s_waitcnt vmcnt(0)" ::: "memory");
    __syncthreads();
    if (threadIdx.x == 0) {
        unsigned* bar = b.bar;
        __builtin_amdgcn_s_waitcnt(0);
        unsigned nloc = b.st[0], nx = b.st[1];
        if (nloc == 0u) { xcd_barrier_complete(bar, b.x, nloc, nx); b.st[0] = nloc; b.st[1] = nx; }
        const unsigned old = xb_add(&bar[XB_XSUB(b.x)], 1u);
        const unsigned gen = old / nloc;
        if (old + 1u == (gen + 1u) * nloc) {
            __builtin_amdgcn_fence(__ATOMIC_RELEASE, "agent");
            asm volatile("s_waitcnt vmcnt(0)" ::: "memory");
            const unsigned og = xb_add(&bar[XB_TOP], 1u);
            const unsigned tg = og / nx;
            if (og + 1u == (tg + 1u) * nx) xb_add(&bar[XB_TOPGEN], 1u);
            else XB_SPIN(xb_ld(&bar[XB_TOPGEN]) == tg, bar);
            __builtin_amdgcn_fence(__ATOMIC_ACQUIRE, "agent");
            xb_add(&bar[XB_XGEN(b.x)], 1u);
            asm volatile("s_waitcnt vmcnt(0)" ::: "memory");
        } else {
            XB_SPIN(xb_ld(&bar[XB_XGEN(b.x)]) == gen, bar);
            __builtin_amdgcn_fence(__ATOMIC_ACQUIRE, "agent");
            asm volatile("s_waitcnt vmcnt(0)" ::: "memory");
        }
    }
    __syncthreads();
}

constexpr int XB_WS_OFF = 65536, XB_LDS_OFF = LDS_BYTES - 64, CTL_ZERO_BYTES = 262144;

template <int ONLY> __global__ void __launch_bounds__(NTHR, 2) yoco_fwd_t(Params P) {
    extern __shared__ __attribute__((aligned(16))) unsigned char lds_raw[];
    LAS uchar* lds = (LAS uchar*)lds_raw;
    if (threadIdx.x < 16) ((LAS unsigned*)(lds + XB_LDS_OFF))[threadIdx.x] = 0u;
    __syncthreads();
    if (P.ph_hi - P.ph_lo > 1) (void)xcd_barrier_post((unsigned*)(P.ws + XB_WS_OFF), (volatile LAS unsigned*)(lds + XB_LDS_OFF));
    if (P.ph_lo == 0) {
        const int lane0 = threadIdx.x & 63, wave0 = threadIdx.x >> 6;
        rope_table(P.ws, blockIdx.x * NWAVES + wave0, gridDim.x * NWAVES, lane0);
    }
    for (int step = P.ph_lo; step < P.ph_hi; ++step) {
        const int ph = P.prog[step] & 0x7f; const bool nobar = (P.prog[step] & 0x80) != 0;
        int tid_ = threadIdx.x; asm volatile("" : "+v"(tid_));
        const int tid = tid_;
#define LWG() const int lane = tid & 63, wave = __builtin_amdgcn_readfirstlane(tid >> 6); const int gw = bx * NWAVES + wave, NGW = G * NWAVES; (void)lane; (void)gw; (void)NGW
        int G_ = gridDim.x, bx_ = blockIdx.x; asm volatile("" : "+s"(G_), "+s"(bx_));
        const int G = G_, bx = bx_;
        uchar* ws = P.ws; float* out = P.out; int zz = 0;
        asm volatile("" : "+s"(ws), "+s"(out), "+s"(zz));
#define PIN(i) (P.in[(i) + zz])
        float* H = out + O_Y; bf16* HB = (bf16*)(ws + WS_HB); float* ssq = (float*)(ws + WS_SSQ);
        bf16* HID = (bf16*)(ws + WS_R + R_HID);
        bf16* RQ = (bf16*)(out + O_KP); bf16* RK = RQ + (size_t)T * D;
        bf16* VO = (bf16*)(ws + WS_R + R_VO); bf16* GG = (bf16*)(ws + WS_R + R_G);
        bf16* QF = (bf16*)(ws + WS_R + R_QF); bf16* K2B = (bf16*)(ws + WS_R + R_K2B); bf16* V2B = (bf16*)(ws + WS_R + R_V2B);
        float* biasP = (float*)(ws + WS_BIASP); float* biasS = (float*)(ws + WS_BIASS);
        const float* rope = (const float*)(ws + WS_ROPE);
        int kind, f = 0;
        switch (ph) {
            case 0: kind = 0; break;          case 22: kind = 0; break;
            case 1: kind = 1; f = 0; break;   case 2: kind = 2; f = 0; break;
            case 3: kind = 3; break;          case 4: kind = 4; break;        case 5: kind = 5; break;
            case 6: kind = 2; f = 4; break;
            case 7: kind = 1; f = 1; break;   case 8: kind = 2; f = 1; break;
            case 9: kind = 1; f = 2; break;   case 10: kind = 7; break;
            case 11: kind = 1; f = 2; break;  case 12: kind = 2; f = 2; break;
            case 13: kind = 8; break;         case 14: kind = 9; break;
            case 15: kind = 2; f = 5; break;
            case 16: kind = 1; f = 3; break;  case 17: kind = 2; f = 3; break;
            case 20: kind = 11; break;
            case 19: kind = 2; f = 8; break;
            default: kind = 10; break;
        }
        if (KSEL(0) && kind == 0) {
            LWG();
            const int mode = ph == 22;
            const int nwg = (T / 256) * (D / 256), rounds = (nwg + G - 1) / G, nfull = nwg - (rounds - 1) * G, nidle = G - nfull;
            const bool remap = mode && nidle > 0;
            if (!remap || bx >= nfull) phase_prologue(P, ws, out, lds, remap ? (bx - nfull) * NWAVES + wave : gw, remap ? nidle * NWAVES : NGW, wave, lane, mode);
        } else if (KSEL(1) && kind == 1) {
            const int N = f == 2 ? 2 * FF + 2304 : 2 * FF;
            pg8::Gemm g{HB, (const bf16*)(ws + WS_WIN + win_slot(f) * SZ_WIN), T, N, D}; pg8::StaticOrder S; S.init(T, N, G, bx);
            rstd_prepass(lds, ssq, S, tid);
            const LAS _Float16* rl = (const LAS _Float16*)(lds + RL_OFF);
            pg8::EpiSwiKVF E{pg8::EpiSwiGLU{HID, rl}, pg8::EpiKVF{out, K2B, V2B, rl, PIN(18)}};
            pg8::gemm_phase<pg8::EpiSwiKVF, pg8::StaticOrder, true, true>(lds, g, S, E);
        } else if (KSEL(2) && kind == 2) {
            const bf16* A; const bf16* Bt; int K; float alpha;
            if (f == 8) { A = HID; Bt = (const bf16*)(ws + WS_WOUT); K = FF; alpha = 0.0f; }
            else if (f < 4) { A = HID; Bt = (const bf16*)(ws + WS_WOUT + f * SZ_WOUT); K = FF; alpha = 0.5f; }
            else if (f == 4) { A = VO; Bt = (const bf16*)(ws + WS_ROUT); K = 2048; alpha = 1.0f; }
            else { A = QF; Bt = (const bf16*)(ws + WS_WO); K = D; alpha = 1.0f; }
            pg8::Gemm g{A, Bt, T, D, K}; pg8::StaticOrder S; S.init(T, D, G, bx);
            pg8::EpiRes E{HB, ssq, alpha};
            pg8::gemm_phase<pg8::EpiRes, pg8::StaticOrder, true, true>(lds, g, S, E);
            if (f == 4 || f == 1) {
                const int nwg = (T / 256) * (D / 256), rounds = (nwg + G - 1) / G, nfull = nwg - (rounds - 1) * G;
                const int nidle = G - nfull;
                const int gt = nidle > 0 ? (bx - nfull) * NTHR + tid : bx * NTHR + tid, NGT = (nidle > 0 ? nidle : G) * NTHR;
                if (nidle == 0 || bx >= nfull) cache_convert(f == 4 ? PIN(3) : PIN(4), f == 4 ? K2B : V2B, gt, NGT);
            }
        } else if (KSEL(3) && kind == 3) {
            pg8::Gemm g{HB, (const bf16*)(ws + WS_RIN), T, 6144, D}; pg8::StaticOrder S; S.init(T, 6144, G, bx);
            rstd_prepass(lds, ssq, S, tid); pg8::EpiRetIn E{RQ, RK, VO, GG, (const LAS _Float16*)(lds + RL_OFF), rope};
            pg8::gemm_phase<pg8::EpiRetIn, pg8::StaticOrder, true, true>(lds, g, S, E);
        } else if (KSEL(4) && kind == 4) {
            for (int it = bx; it < 256 + 512; it += G) {
                const bool samp = it >= 256; const int q = samp ? it - 256 : it;
                const int sl = q & 3, h = (q >> 2) & 3, b = q >> 4;
                const float lg2 = h == 0 ? -0.04580368961312479f : h == 1 ? -0.02272007650008353f : h == 2 ? -0.011315313227834146f : -0.005646563141142063f;
                const size_t rowbase = samp ? (size_t)TP + (size_t)b * DSEQ : (size_t)b * SEQ;
                const float* S0 = samp ? PIN(2) + (size_t)(b * 4 + h) * 256 * 512 : nullptr;
                float* Sout = out + (samp ? O_SRS : O_SRP) + (size_t)(b * 4 + h) * 256 * 512;
                ret_item(lds, RQ, RK, VO, rowbase, h, sl, samp ? 1 : 64, S0, Sout, lg2);
            }
        } else if (KSEL(5) && kind == 5) {
            LWG();
            const float* gn = PIN(14); (void)gn;
            constexpr int NR = 4;
            for (int row0 = gw; row0 < T; row0 += NR * NGW) {
                u32x4 ov[NR][4], gv[NR][4];
#pragma unroll
                for (int u = 0; u < NR; ++u) { const int row = row0 + u * NGW < T ? row0 + u * NGW : row0;
                    const u32x4* op = (const u32x4*)(VO + (size_t)row * 2048 + lane * 32); const u32x4* gp = (const u32x4*)(GG + (size_t)row * 2048 + lane * 32);
#pragma unroll
                    for (int i = 0; i < 4; ++i) { ov[u][i] = op[i]; gv[u][i] = gp[i]; } }
#pragma unroll
                for (int u = 0; u < NR; ++u) {
                    const int row = row0 + u * NGW; if (row >= T) break;
                    float s = 0.f, s2 = 0.f;
#pragma unroll
                    for (int i = 0; i < 4; ++i)
#pragma unroll
                        for (int j = 0; j < 4; ++j) { const float a = bflo(ov[u][i][j]), bq = bfhi(ov[u][i][j]); s += a + bq; s2 += a * a + bq * bq; }
#pragma unroll
                    for (int o = 1; o < 16; o <<= 1) { s += __shfl_xor(s, o); s2 += __shfl_xor(s2, o); }
                    const float mu = s * (1.f / 512.f), var = fmaxf(s2 * (1.f / 512.f) - mu * mu, 0.f), rstd = __builtin_amdgcn_rsqf(var + EPS);
                    u32x4* op = (u32x4*)(VO + (size_t)row * 2048 + lane * 32);
#pragma unroll
                    for (int i = 0; i < 4; ++i) { u32x4 w;
#pragma unroll
                        for (int j = 0; j < 4; ++j) w[j] = pk((bflo(ov[u][i][j]) - mu) * rstd * bflo(gv[u][i][j]), (bfhi(ov[u][i][j]) - mu) * rstd * bfhi(gv[u][i][j]));
                        op[i] = w; }
                }
            }
        } else if (KSEL(7) && kind == 7) {
            LWG();
            for (int seq = bx; seq < 768; seq += G) {
                const bool samp = seq >= 256; const int ss = samp ? seq - 256 : seq; const int b_ = ss >> 4, h = ss & 15;
                const int L = samp ? KSAMP : SEQ, n = samp ? 3 : 8, s0 = tid * n;
                float* dst = samp ? biasS + (size_t)ss * KSAMP : biasP + (size_t)ss * SEQ;
                float v[8]; float sum = 0.f;
#pragma unroll
                for (int i = 0; i < 8; ++i) { const int s = s0 + i; float x = 0.f;
                    if (i < n && s < L) x = samp ? (s < PAST ? PIN(5)[((size_t)b_ * PAST + s) * 16 + h] : out[O_LFS + ((size_t)b_ * DSEQ + (s - PAST)) * 16 + h]) : out[O_LFP + ((size_t)b_ * SEQ + s) * 16 + h];
                    sum += x; v[i] = sum; }
                float inc = sum;
#pragma unroll
                for (int o = 1; o < 64; o <<= 1) { const float t = __shfl_up(inc, o); if (lane >= o) inc += t; }
                LAS float* wt = (LAS float*)lds;
                __syncthreads();
                if (lane == 63) wt[wave] = inc;
                __syncthreads();
                float base = inc - sum;
#pragma unroll
                for (int w2 = 0; w2 < 8; ++w2) if (w2 < wave) base += wt[w2];
#pragma unroll
                for (int i = 0; i < 8; ++i) { const int s = s0 + i; if (i < n && s < L) dst[s] = -(base + v[i]) * LOG2E; }
            }
        } else if (KSEL(8) && kind == 8) {
            pg8::Gemm g{HB, (const bf16*)(ws + WS_WQ), T, D, D}; pg8::StaticOrder S; S.init(T, D, G, bx);
            rstd_prepass(lds, ssq, S, tid); pg8::EpiQ E{QF, (const LAS _Float16*)(lds + RL_OFF)};
            pg8::gemm_phase<pg8::EpiQ, pg8::StaticOrder, true, true>(lds, g, S, E);
        } else if (KSEL(9) && kind == 9) {
            for (int u = bx; u < 4096 + 512; u += G) {
                const bool samp = u >= 4096; const int us = u - 4096;
                int bh = samp ? us : (u & 255), qb = 15 - (u >> 8);
                if (!samp && G == 256) {
                    const int k = u >> 8, xcd = bx & 7, idx = bx >> 3, g = idx >> 2, mem = idx & 3, rr = k >> 2, kk = k & 3;
                    bh = xcd * 32 + rr * 8 + g; qb = kk == 0 ? 15 - mem : kk == 1 ? 11 - mem : kk == 2 ? mem + 4 : mem;
                }
                const int b_ = bh >> 4, h = bh & 15;
                const size_t qrow0 = samp ? (size_t)TP + b_ * DSEQ : (size_t)b_ * SEQ + qb * 256;
                const size_t krow0 = samp ? (size_t)TP + (size_t)b_ * KSAMP : (size_t)b_ * SEQ;
                fox_unit(lds, QF, K2B, V2B, QF, qrow0, samp ? 64 : 256, krow0, samp ? 17 : 4 * (qb + 1), samp ? PAST : qb * 256, h,
                         samp ? biasS + (size_t)us * KSAMP : biasP + (size_t)bh * SEQ);
            }
        } else if (KSEL(10) && kind == 10) {
            LWG();
            const float* fg = PIN(21);
            constexpr int NR = 8;
            for (int row0 = gw; row0 < T; row0 += NR * NGW) {
                u32x2 hv[NR][4]; float rsv[NR];
#pragma unroll
                for (int u = 0; u < NR; ++u) { const int row = row0 + u * NGW < T ? row0 + u * NGW : row0; const u32x2* bp = (const u32x2*)(HB + (size_t)row * D);
#pragma unroll
                    for (int j = 0; j < 4; ++j) hv[u][j] = bp[lane + 64 * j];
                    rsv[u] = row_rstd(ssq, row); }
#pragma unroll
                for (int u = 0; u < NR; ++u) {
                    const int row = row0 + u * NGW; if (row >= T) break;
                    f32x4* hp = (f32x4*)(H + (size_t)row * D); const float rs = rsv[u];
#pragma unroll
                    for (int j = 0; j < 4; ++j) { const u32x2 x = hv[u][j]; const f32x4 v = {bflo(x[0]), bfhi(x[0]), bflo(x[1]), bfhi(x[1])}, gq = ((const f32x4*)fg)[lane + 64 * j]; __builtin_nontemporal_store(v * rs * gq, hp + lane + 64 * j); }
                }
            }
        }
        if (step + 1 < P.ph_hi && !nobar) { if (P.ph_lo < 0) cg::this_grid().sync(); else { XcdBarrier xb; xb.bar = (unsigned*)(ws + XB_WS_OFF); xb.x = xb_xcc_id(); xb.st = (volatile LAS unsigned*)(lds + XB_LDS_OFF); xcd_barrier(xb); } }
    }
}

#ifdef DIAG
template __global__ void yoco_fwd_t<0>(Params); template __global__ void yoco_fwd_t<1>(Params); template __global__ void yoco_fwd_t<2>(Params); template __global__ void yoco_fwd_t<3>(Params);
template __global__ void yoco_fwd_t<4>(Params); template __global__ void yoco_fwd_t<5>(Params); template __global__ void yoco_fwd_t<6>(Params); template __global__ void yoco_fwd_t<7>(Params);
template __global__ void yoco_fwd_t<8>(Params); template __global__ void yoco_fwd_t<9>(Params); template __global__ void yoco_fwd_t<10>(Params);
#endif
#define yoco_fwd yoco_fwd_t<-1>
#ifndef MK_ONE_LAUNCH
#define MK_ONE_LAUNCH 1
#endif
constexpr int N_PHASES = 19;
extern "C" void kernel_launch(void* const* d_in, const int* in_sizes, int n_in, void* d_out, int out_size, void* d_ws, size_t ws_size, hipStream_t stream) {
    static int grid = 0;
    if (grid == 0) {
        if (n_in != 22 || ws_size < WS_END) { fprintf(stderr, "kernel_launch: unexpected n_in %d / ws %zu\n", n_in, ws_size); grid = -1; return; }
        int dev = 0, cus = 0, per_cu = 0;
        hipGetDevice(&dev); hipDeviceGetAttribute(&cus, hipDeviceAttributeMultiprocessorCount, dev);
        if (hipFuncSetAttribute((const void*)yoco_fwd, hipFuncAttributeMaxDynamicSharedMemorySize, LDS_BYTES) != hipSuccess) { fprintf(stderr, "kernel_launch: hipFuncSetAttribute failed\n"); grid = -1; return; }
        if (hipOccupancyMaxActiveBlocksPerMultiprocessor(&per_cu, (const void*)yoco_fwd, NTHR, LDS_BYTES) != hipSuccess || per_cu < 1) { fprintf(stderr, "kernel_launch: occupancy query says %d\n", per_cu); per_cu = 1; }
        (void)hipGetLastError();
        grid = cus * 1;
    }
    if (grid < 0) return;
    Params p{};
    for (int i = 0; i < 22; ++i) p.in[i] = (const float*)d_in[i];
    p.out = (float*)d_out; p.ws = (unsigned char*)d_ws;
#ifndef MK_PROG
#define MK_PROG 0,1,2|0x80,22,3,4,5,6,7,8,9,10,12,13,14,15,16,17,18
#endif
    const unsigned char prog[] = {MK_PROG}; const int nprog = (int)sizeof(prog);
    for (int i = 0; i < nprog && i < 32; ++i) p.prog[i] = prog[i];
#if MK_ONE_LAUNCH
    if (hipMemsetAsync(d_ws, 0, CTL_ZERO_BYTES, stream) != hipSuccess) { fprintf(stderr, "kernel_launch: hipMemsetAsync failed\n"); return; }
    p.ph_lo = 0; p.ph_hi = nprog;
    void* args[] = {&p};
    hipError_t e = hipLaunchCooperativeKernel((const void*)yoco_fwd, dim3(grid), dim3(NTHR), args, LDS_BYTES, stream);
    if (e != hipSuccess) fprintf(stderr, "cooperative launch failed: %s (grid %d)\n", hipGetErrorString(e), grid);
#else
    for (int ph = 0; ph < nprog; ++ph) { p.ph_lo = ph; p.ph_hi = ph + 1; hipLaunchKernelGGL(yoco_fwd, dim3(grid), dim3(NTHR), LDS_BYTES, stream, p); }
#endif
}
```
